# Optimizing an MI355X kernel written in HIP

```python
import math
import jax, jax.numpy as jnp
from jax import lax
import numpy as np

D_MODEL = 2048
BATCH = 4
SEQ = 4096
DEPTH = 4

N_MIXERS = 2
N_A_LAYERS = (DEPTH + 1) // 2
N_B_LAYERS = DEPTH // 2
DA_HEAD_DIM = 128
DA_HEADS = D_MODEL // (2 * DA_HEAD_DIM)
SW_HEAD_DIM = 64
SW_HEADS = D_MODEL // SW_HEAD_DIM
SW_KV_HEADS = SW_HEADS // 8
SW_GROUP = SW_HEADS // SW_KV_HEADS
SW_QKV_WIDTH = (SW_HEADS + 2 * SW_KV_HEADS) * SW_HEAD_DIM
WINDOW = 128
Q_BLOCK = 128
D_FF = 4 * D_MODEL
ROPE_THETA = 10000.0
LN_EPS = 1e-5
ALPHA = (2 * DEPTH) ** 0.25
BETA = (8 * DEPTH) ** -0.25
N_MOD = 6

kernel_name = "hybrid_diffattn_swa_sink_deepnorm_adaln"


def rope_tables(seq, dim):
    inv = 1.0 / (ROPE_THETA ** (jnp.arange(0, dim, 2, dtype=jnp.float32) / dim))
    ang = jnp.arange(seq, dtype=jnp.float32)[:, None] * inv[None, :]
    return jnp.cos(ang), jnp.sin(ang)


def apply_rope(x, cos, sin):
    bshape = (x.shape[1],) + (1,) * (x.ndim - 3) + (cos.shape[-1],)
    cs = cos.reshape(bshape).astype(x.dtype)
    sn = sin.reshape(bshape).astype(x.dtype)
    x1, x2 = jnp.split(x, 2, axis=-1)
    return jnp.concatenate([x1 * cs - x2 * sn, x2 * cs + x1 * sn], axis=-1)


def layer_norm(x, g, b):
    xf = x.astype(jnp.float32)
    mu = jnp.mean(xf, axis=-1, keepdims=True)
    var = jnp.mean(jnp.square(xf - mu), axis=-1, keepdims=True)
    y = (xf - mu) * lax.rsqrt(var + LN_EPS)
    return (y * g.astype(jnp.float32) + b.astype(jnp.float32)).astype(x.dtype)


def diff_attention(h, w_qkv, w_o, lq1, lk1, lq2, lk2, subln_g, layer_idx, cos, sin):
    B, S, _ = h.shape
    H, d = DA_HEADS, DA_HEAD_DIM
    q, k, v = jnp.split(h @ w_qkv, 3, axis=-1)
    q = apply_rope(q.reshape(B, S, 2 * H, d), cos, sin) * (d ** -0.5)
    k = apply_rope(k.reshape(B, S, 2 * H, d), cos, sin)
    v = v.reshape(B, S, H, 2 * d)
    lam_init = 0.8 - 0.6 * math.exp(-0.3 * layer_idx)
    f32 = jnp.float32
    lam = (jnp.exp(jnp.sum(lq1.astype(f32) * lk1.astype(f32)))
           - jnp.exp(jnp.sum(lq2.astype(f32) * lk2.astype(f32))) + lam_init)
    nb = S // Q_BLOCK
    q_blocks = q.reshape(B, nb, Q_BLOCK, 2 * H, d).transpose(1, 0, 2, 3, 4)
    kpos = jnp.arange(S)

    def block(args):
        qb, n = args
        s = jnp.einsum('bqhd,bkhd->bhqk', qb, k).astype(f32)
        qpos = n * Q_BLOCK + jnp.arange(Q_BLOCK)
        s = jnp.where(kpos[None, :] <= qpos[:, None], s, -jnp.inf)
        p = jax.nn.softmax(s, axis=-1).reshape(B, H, 2, Q_BLOCK, S)
        a = (p[:, :, 0] - lam * p[:, :, 1]).astype(v.dtype)
        return jnp.einsum('bhqk,bkhe->bqhe', a, v)

    o = lax.map(block, (q_blocks, jnp.arange(nb)))
    o = o.transpose(1, 0, 2, 3, 4).reshape(B, S, H, 2 * d)
    of = o.astype(f32)
    of = of * lax.rsqrt(jnp.mean(of * of, axis=-1, keepdims=True) + LN_EPS)
    o = (of * subln_g.astype(f32) * (1.0 - lam_init)).astype(h.dtype)
    return o.reshape(B, S, H * 2 * d) @ w_o


def sliding_window_attention(h, w_qkv, b_qkv, sinks, w_o, b_o, cos, sin):
    B, S, _ = h.shape
    H, KV, G, d = SW_HEADS, SW_KV_HEADS, SW_GROUP, SW_HEAD_DIM
    qkv = h @ w_qkv + b_qkv
    q = qkv[..., :H * d].reshape(B, S, KV, G, d)
    k = qkv[..., H * d:(H + KV) * d].reshape(B, S, KV, d)
    v = qkv[..., (H + KV) * d:].reshape(B, S, KV, d)
    q = apply_rope(q, cos, sin) * (d ** -0.5)
    k = apply_rope(k, cos, sin)
    nb = S // Q_BLOCK
    qb = q.reshape(B, nb, Q_BLOCK, KV, G, d)
    kb = k.reshape(B, nb, Q_BLOCK, KV, d)
    vb = v.reshape(B, nb, Q_BLOCK, KV, d)
    pad = ((0, 0), (1, 0), (0, 0), (0, 0), (0, 0))
    kw = jnp.concatenate([jnp.pad(kb, pad)[:, :-1], kb], axis=2)
    vw = jnp.concatenate([jnp.pad(vb, pad)[:, :-1], vb], axis=2)
    f32 = jnp.float32
    s = jnp.einsum('bnqkgd,bnjkd->bnkgqj', qb, kw).astype(f32)
    blk = jnp.arange(nb)[:, None]
    qpos = blk * Q_BLOCK + jnp.arange(Q_BLOCK)[None, :]
    kpos = blk * Q_BLOCK - Q_BLOCK + jnp.arange(2 * Q_BLOCK)[None, :]
    diff = qpos[:, :, None] - kpos[:, None, :]
    valid = (diff >= 0) & (diff < WINDOW) & (kpos[:, None, :] >= 0)
    s = jnp.where(valid[None, :, None, None], s, -jnp.inf)
    sink = sinks.astype(f32).reshape(1, 1, KV, G, 1, 1)
    m = jnp.maximum(jnp.max(s, axis=-1, keepdims=True), sink)
    e = jnp.exp(s - m)
    p = e / (jnp.sum(e, axis=-1, keepdims=True) + jnp.exp(sink - m))
    o = jnp.einsum('bnkgqj,bnjkd->bnqkgd', p.astype(v.dtype), vw)
    return o.reshape(B, S, H * d) @ w_o + b_o


def squared_relu_mlp(h, w_up, w_down):
    return jnp.square(jax.nn.relu(h @ w_up)) @ w_down


def setup_inputs(seed: int = 0) -> dict:
    key = jax.random.key(seed)
    ks = jax.random.split(key, 24)
    f32 = jnp.float32

    def nrm(k, shape, s):
        return jax.random.normal(k, shape, f32) * s

    D = D_MODEL
    return {
        "x": nrm(ks[0], (BATCH, SEQ, D), 1.0),
        "c": nrm(ks[1], (BATCH, D), 1.0),
        "w_ada": nrm(ks[2], (DEPTH, D, N_MOD * D), 0.2 * D ** -0.5),
        "b_ada": nrm(ks[3], (DEPTH, N_MOD * D), 0.02),
        "ln_mix_g": 1.0 + nrm(ks[4], (DEPTH, D), 0.02),
        "ln_mix_b": nrm(ks[5], (DEPTH, D), 0.02),
        "ln_mlp_g": 1.0 + nrm(ks[6], (DEPTH, D), 0.02),
        "ln_mlp_b": nrm(ks[7], (DEPTH, D), 0.02),
        "w_up": nrm(ks[8], (DEPTH, D, D_FF), D ** -0.5),
        "w_down": nrm(ks[9], (DEPTH, D_FF, D), BETA * D_FF ** -0.5),
        "a_w_qkv": nrm(ks[10], (N_A_LAYERS, D, 3 * D), D ** -0.5),
        "a_w_o": nrm(ks[11], (N_A_LAYERS, D, D), BETA * D ** -0.5),
        "a_lambda_q1": nrm(ks[12], (N_A_LAYERS, DA_HEAD_DIM), 0.1),
        "a_lambda_k1": nrm(ks[13], (N_A_LAYERS, DA_HEAD_DIM), 0.1),
        "a_lambda_q2": nrm(ks[14], (N_A_LAYERS, DA_HEAD_DIM), 0.1),
        "a_lambda_k2": nrm(ks[15], (N_A_LAYERS, DA_HEAD_DIM), 0.1),
        "a_subln_g": 1.0 + nrm(ks[16], (N_A_LAYERS, 2 * DA_HEAD_DIM), 0.02),
        "b_w_qkv": nrm(ks[17], (N_B_LAYERS, D, SW_QKV_WIDTH), D ** -0.5),
        "b_b_qkv": nrm(ks[18], (N_B_LAYERS, SW_QKV_WIDTH), 0.02),
        "b_sinks": nrm(ks[19], (N_B_LAYERS, SW_HEADS), 0.5),
        "b_w_o": nrm(ks[20], (N_B_LAYERS, D, D), BETA * D ** -0.5),
        "b_b_o": nrm(ks[21], (N_B_LAYERS, D), 0.02),
    }


def reference(x, c, w_ada, b_ada, ln_mix_g, ln_mix_b, ln_mlp_g, ln_mlp_b, w_up, w_down,
              a_w_qkv, a_w_o, a_lambda_q1, a_lambda_k1, a_lambda_q2, a_lambda_k2, a_subln_g,
              b_w_qkv, b_b_qkv, b_sinks, b_w_o, b_b_o):
    S = x.shape[1]
    cos_a, sin_a = rope_tables(S, DA_HEAD_DIM)
    cos_b, sin_b = rope_tables(S, SW_HEAD_DIM)
    c_act = jax.nn.silu(c)
    for i in range(DEPTH):
        mod = (c_act @ w_ada[i] + b_ada[i])[:, None, :]
        sh_a, sc_a, g_a, sh_m, sc_m, g_m = jnp.split(mod, N_MOD, axis=-1)
        h = x * (1.0 + sc_a) + sh_a
        if i % N_MIXERS == 0:
            j = i // N_MIXERS
            y = diff_attention(h, a_w_qkv[j], a_w_o[j], a_lambda_q1[j], a_lambda_k1[j],
                               a_lambda_q2[j], a_lambda_k2[j], a_subln_g[j], i, cos_a, sin_a)
        else:
            j = i // N_MIXERS
            y = sliding_window_attention(h, b_w_qkv[j], b_b_qkv[j], b_sinks[j], b_w_o[j],
                                         b_b_o[j], cos_b, sin_b)
        x = layer_norm(ALPHA * x + (1.0 + g_a) * y, ln_mix_g[i], ln_mix_b[i])
        h = x * (1.0 + sc_m) + sh_m
        y = squared_relu_mlp(h, w_up[i], w_down[i])
        x = layer_norm(ALPHA * x + (1.0 + g_m) * y, ln_mlp_g[i], ln_mlp_b[i])
    return x
```

```cpp
#include <hip/hip_runtime.h>
#include <hip/hip_bf16.h>
#include <cstdio>
#include <cstdint>

constexpr int DM = 2048, NB = 4, SEQ = 4096, DEPTH = 4, MTOK = NB * SEQ, DFF = 8192;
constexpr int NQKV_A = 3 * DM;
constexpr int NQKV_B = 2560;
constexpr float LN_EPS = 1e-5f;
constexpr float ALPHA = 1.681792830507429f;
constexpr int NMOD = 6;
__device__ __forceinline__ int opaque_tid() { int t = (int)threadIdx.x; asm volatile("" : "+v"(t)); return t; }

#define GAS __attribute__((address_space(1)))
#define LAS __attribute__((address_space(3)))
typedef unsigned short bf16;
typedef unsigned v4u __attribute__((ext_vector_type(4)));
typedef float f32x4 __attribute__((ext_vector_type(4)));
typedef short bf16x8 __attribute__((ext_vector_type(8)));
typedef GAS unsigned gu32;
typedef GAS unsigned long long gu64;
#define RLX_AGENT __ATOMIC_RELAXED, __HIP_MEMORY_SCOPE_AGENT
#define LDS_WAIT() asm volatile("s_waitcnt lgkmcnt(0)" ::: "memory")
#define VM_WAIT() asm volatile("s_waitcnt vmcnt(0)" ::: "memory")
__device__ __forceinline__ unsigned long long rt() { return __builtin_amdgcn_s_memrealtime(); }
__device__ __forceinline__ unsigned f2bf(float f) { unsigned u = __builtin_bit_cast(unsigned, f); return (u + 0x7fffu + ((u >> 16) & 1u)) >> 16; }
__device__ __forceinline__ unsigned pk2(float lo, float hi) { return f2bf(lo) | (f2bf(hi) << 16); }

#define XB_TMO      128
#define XB_XCNT(j)  (256  + 64 * (j))
#define XB_XSUB(j)  (1280 + 64 * (j))
#define XB_XGEN(j)  (2304 + 64 * (j))
#define XB_TOP      3328
#define XB_TOPGEN   3392
#define XCD_BAR_WORDS 3456
#define XB_SPIN_CAP (1u << 18)

__device__ __forceinline__ unsigned xb_ld(unsigned* p)              { return __hip_atomic_load(p, __ATOMIC_RELAXED, __HIP_MEMORY_SCOPE_AGENT); }
__device__ __forceinline__ unsigned xb_add(unsigned* p, unsigned v) { return __hip_atomic_fetch_add(p, v, __ATOMIC_RELAXED, __HIP_MEMORY_SCOPE_AGENT); }
__device__ __forceinline__ unsigned xb_xcc_id() { return (unsigned)__builtin_amdgcn_s_getreg((3 << 11) | 20) & 0xFu; }
#define XB_SPIN(cond, bar) do { unsigned _sp = 0; while (cond) { __builtin_amdgcn_s_sleep(1); \
    if ((++_sp & 255u) == 0u) { if (xb_ld(&(bar)[XB_TMO])) break; if (_sp > XB_SPIN_CAP) { atomicAdd(&(bar)[XB_TMO], 1u); break; } } } } while (0)

struct XcdBarrier {
    unsigned* bar; unsigned x;
    volatile LAS unsigned* st;
};

__device__ __forceinline__ XcdBarrier xcd_barrier_post(unsigned* bar, volatile LAS unsigned* st) {
    XcdBarrier b; b.bar = bar; b.x = xb_xcc_id(); b.st = st;
    if (threadIdx.x == 0) (void)xb_add(&bar[XB_XCNT(b.x)], 1u);
    return b;
}
__device__ __forceinline__ void xcd_barrier_complete(unsigned* bar, unsigned x, unsigned& nloc, unsigned& nx) {
    const unsigned G = gridDim.x * gridDim.y * gridDim.z;
    unsigned sum, cnt, mine, sp = 0u;
    for (;;) {
        sum = 0u; cnt = 0u; mine = 0u;
#pragma unroll
        for (unsigned j = 0; j < 16; ++j) { const unsigned c = xb_ld(&bar[XB_XCNT(j)]); sum += c; cnt += (c > 0u) ? 1u : 0u; mine = (j == x) ? c : mine; }
        if (sum == G) break;
        __builtin_amdgcn_s_sleep(1);
        if ((++sp & 255u) == 0u) { if (xb_ld(&bar[XB_TMO])) break; if (sp > XB_SPIN_CAP) { atomicAdd(&bar[XB_TMO], 1u); break; } }
    }
    nloc = mine > 0u ? mine : 1u; nx = cnt > 0u ? cnt : 1u;
}

__device__ __forceinline__ void xcd_barrier(const XcdBarrier& b) {
    asm volatile("s_waitcnt vmcnt(0)" ::: "memory");
    __syncthreads();
    if (threadIdx.x == 0) {
        unsigned* bar = b.bar;
        __builtin_amdgcn_s_waitcnt(0);
        unsigned nloc = b.st[0], nx = b.st[1];
        unsigned bx = b.x; asm volatile("" : "+s"(bx));
        if (nloc == 0u) { xcd_barrier_complete(bar, bx, nloc, nx); b.st[0] = nloc; b.st[1] = nx; }
        const unsigned old = xb_add(&bar[XB_XSUB(bx)], 1u);
        const unsigned gen = old / nloc;
        if (old + 1u == (gen + 1u) * nloc) {
            __builtin_amdgcn_fence(__ATOMIC_RELEASE, "agent");
            asm volatile("s_waitcnt vmcnt(0)" ::: "memory");
            const unsigned og = xb_add(&bar[XB_TOP], 1u);
            const unsigned tg = og / nx;
            if (og + 1u == (tg + 1u) * nx) xb_add(&bar[XB_TOPGEN], 1u);
            else XB_SPIN(xb_ld(&bar[XB_TOPGEN]) == tg, bar);
            __builtin_amdgcn_fence(__ATOMIC_ACQUIRE, "agent");
            xb_add(&bar[XB_XGEN(bx)], 1u);
            asm volatile("s_waitcnt vmcnt(0)" ::: "memory");
        } else {
            XB_SPIN(xb_ld(&bar[XB_XGEN(bx)]) == gen, bar);
            __builtin_amdgcn_fence(__ATOMIC_ACQUIRE, "agent");
            asm volatile("s_waitcnt vmcnt(0)" ::: "memory");
        }
    }
    __syncthreads();
}

namespace pg8 {
#define PG8_LAS __attribute__((address_space(3)))
typedef unsigned short bf16_t;
typedef short bf16x8 __attribute__((ext_vector_type(8)));
typedef float f32x4 __attribute__((ext_vector_type(4)));
typedef unsigned u32x4 __attribute__((ext_vector_type(4)));
constexpr int BM = 256, BK = 64, HALF = 128, HTB = HALF * BK * 2  , STAGE_BYTES = 8 * HTB, NXCD = 8, WGM = 8;

__host__ __device__ __forceinline__ int lds_byte(int r, int c) { const int st = (r >> 4) * 2 + (c >> 5), rr = r & 15, cc = c & 31, ob = rr * 64 + cc * 2; return st * 1024 + (ob ^ (((ob >> 9) & 1) << 5)); }
__host__ __device__ __forceinline__ void stage_rc(int b, int& R, int& C) { const int st = b / 1024, sb = b % 1024, swz = sb ^ (((sb >> 9) & 1) << 5); R = (st >> 1) * 16 + swz / 64; C = (st & 1) * 32 + (swz % 64) / 2; }
__host__ __device__ __forceinline__ int perm32(int rho) { const int n = rho >> 4, i = rho & 15; return 8 * (i >> 2) + 4 * n + (i & 3); }

struct Unit { int pm, pn; };
struct Gemm { const bf16_t* A; const bf16_t* Bt; int M, N, K; };

struct StaticOrder {
    int nM, nN, nwg, G, c;
    __host__ __device__ void init(int M, int N, int G_, int c_) { nM = M / BM; nN = N / BM; nwg = nM * nN; G = G_; c = c_; }
    __host__ __device__ bool next(int i, Unit& u) const {
        const long L = (long)i * G + c; if (L >= nwg) return false;
        int wgid = (int)L; { const int q = nwg / NXCD, r = nwg % NXCD, xcd = wgid % NXCD, off = wgid / NXCD; wgid = (xcd < r ? xcd * (q + 1) : r * (q + 1) + (xcd - r) * q) + off; }
        const int nig = WGM * nN, gid = wgid / nig, fm = gid * WGM, gsz = (nM - fm) < WGM ? (nM - fm) : WGM;
        u.pm = fm + ((wgid % nig) % gsz); u.pn = (wgid % nig) / gsz; return true;
    }
    __device__ __forceinline__ void a_ready(const Unit&) const {}
    __device__ __forceinline__ void done(const Unit&) const {}
};

__device__ __forceinline__ unsigned cvt_pk_bf16(float lo, float hi) { unsigned r; asm volatile("v_cvt_pk_bf16_f32 %0, %1, %2" : "=v"(r) : "v"(lo), "v"(hi)); return r; }
typedef float f32x2 __attribute__((ext_vector_type(2)));

__device__ __forceinline__ u32x4 pack_bf16x8(const f32x4 v0, const f32x4 v1) { u32x4 w; w.x = cvt_pk_bf16(v0[0], v0[1]); w.y = cvt_pk_bf16(v0[2], v0[3]); w.z = cvt_pk_bf16(v1[0], v1[1]); w.w = cvt_pk_bf16(v1[2], v1[3]); return w; }
template <int HD> struct EpiQKV {
    static constexpr bool PERM = true, AFTER_DRAIN = false;
    bf16_t* O; int ldc; const float* bias; const float* tab; int rope_tiles; int seq_mask;
    __device__ __forceinline__ void operator()(const f32x4 (&acc)[2][2][4][2], const Unit& u, int wr, int wc, int fr, int fq) const {
        const int row0 = u.pm * BM + wr * 64 + fr, col0 = u.pn * BM + wc * 32 + 8 * fq;
        const bool rope = u.pn < rope_tiles;
        f32x4 bv[2][2];
#pragma unroll
        for (int bj = 0; bj < 2; ++bj)
#pragma unroll
            for (int n = 0; n < 2; ++n) bv[bj][n] = bias ? *(const f32x4*)(bias + col0 + bj * HALF + 4 * n) : (f32x4){0.f, 0.f, 0.f, 0.f};
#pragma unroll
        for (int ai = 0; ai < 2; ++ai)
#pragma unroll
            for (int m = 0; m < 4; ++m) { const int row = row0 + ai * HALF + m * 16; const int s = row & seq_mask; bf16_t* rowp = O + (size_t)row * ldc + col0;
#pragma unroll
                for (int bj = 0; bj < 2; ++bj) { f32x4 v0 = acc[ai][bj][m][0] + bv[bj][0], v1 = acc[ai][bj][m][1] + bv[bj][1];
                    if (rope) { const int j0 = ((col0 + bj * HALF) & (HD - 1)) >> 1; const f32x4* tp = (const f32x4*)(tab + ((size_t)s * (HD / 2) + j0) * 2);
                        const f32x4 t0 = tp[0], t1 = tp[1];
                        const f32x4 r0 = {v0[0] * t0[0] - v0[1] * t0[1], v0[1] * t0[0] + v0[0] * t0[1], v0[2] * t0[2] - v0[3] * t0[3], v0[3] * t0[2] + v0[2] * t0[3]};
                        const f32x4 r1 = {v1[0] * t1[0] - v1[1] * t1[1], v1[1] * t1[0] + v1[0] * t1[1], v1[2] * t1[2] - v1[3] * t1[3], v1[3] * t1[2] + v1[2] * t1[3]};
                        v0 = r0; v1 = r1; }
                    *(u32x4*)(rowp + bj * HALF) = pack_bf16x8(v0, v1); }
                if (m & 1) asm volatile("" ::: "memory"); }
    }
};
struct EpiRelu2 {
    static constexpr bool PERM = true, AFTER_DRAIN = false;
    bf16_t* O; int ldc;
    __device__ __forceinline__ void operator()(const f32x4 (&acc)[2][2][4][2], const Unit& u, int wr, int wc, int fr, int fq) const {
        const int row0 = u.pm * BM + wr * 64 + fr, col0 = u.pn * BM + wc * 32 + 8 * fq;
#pragma unroll
        for (int ai = 0; ai < 2; ++ai)
#pragma unroll
            for (int m = 0; m < 4; ++m) { bf16_t* rowp = O + (size_t)(row0 + ai * HALF + m * 16) * ldc + col0;
#pragma unroll
                for (int bj = 0; bj < 2; ++bj) { f32x4 v0 = acc[ai][bj][m][0], v1 = acc[ai][bj][m][1];
#pragma unroll
                    for (int e = 0; e < 4; ++e) { const float a = fmaxf(v0[e], 0.f), b = fmaxf(v1[e], 0.f); v0[e] = a * a; v1[e] = b * b; }
                    *(u32x4*)(rowp + bj * HALF) = pack_bf16x8(v0, v1); } }
    }
};
struct EpiResid {
    static constexpr bool PERM = false, AFTER_DRAIN = false;
    const float* res; float* out; int ldc; const float* gate; int gstride; const float* bias; float alpha; int seq_shift;
    __device__ __forceinline__ void operator()(const f32x4 (&acc)[2][2][4][2], const Unit& u, int wr, int wc, int fr, int fq) const {
        const int row0 = u.pm * BM + wr * 64 + fr, col0 = u.pn * BM + wc * 32 + 4 * fq;
        const float* gb = gate + (size_t)((u.pm * BM) >> seq_shift) * gstride;
        f32x4 gv[2][2], bv[2][2];
#pragma unroll
        for (int bj = 0; bj < 2; ++bj)
#pragma unroll
            for (int n = 0; n < 2; ++n) { gv[bj][n] = *(const f32x4*)(gb + col0 + bj * HALF + n * 16) + 1.0f;
                bv[bj][n] = bias ? *(const f32x4*)(bias + col0 + bj * HALF + n * 16) : (f32x4){0.f, 0.f, 0.f, 0.f}; }
#pragma unroll
        for (int ai = 0; ai < 2; ++ai)
#pragma unroll
            for (int m = 0; m < 4; ++m) { const size_t off = (size_t)(row0 + ai * HALF + m * 16) * ldc + col0;
#pragma unroll
                for (int bj = 0; bj < 2; ++bj)
#pragma unroll
                    for (int n = 0; n < 2; ++n) { const f32x4 x = *(const f32x4*)(res + off + bj * HALF + n * 16);
                        *(f32x4*)(out + off + bj * HALF + n * 16) = x * alpha + gv[bj][n] * (acc[ai][bj][m][n] + bv[bj][n]); }
                if (m & 1) asm volatile("" ::: "memory"); }
    }
};

template <class Epi, class Sched, bool ALIGN_EPI = false, bool SP2 = false>
__device__ __forceinline__ void gemm_phase(PG8_LAS unsigned char* lds, const Gemm g, const Sched& S, const Epi& E) {
    const int tid = opaque_tid(), wid = __builtin_amdgcn_readfirstlane(tid >> 6), lane = tid & 63, wr = wid >> 2, wc = wid & 3, fr = lane & 15, fq = lane >> 4;
    const int K = g.K, nt = K / BK;
    unsigned voffA[2], voffB[2];
#pragma unroll
    for (int i = 0; i < 2; ++i) { int R, C; stage_rc(tid * 16 + i * 8192, R, C); const int Rb = Epi::PERM ? ((R & ~31) + perm32(R & 31)) : R;
        voffA[i] = (unsigned)(R * K + C) * 2u; voffB[i] = (unsigned)(Rb * K + C) * 2u; }
    const size_t kstep = (size_t)(BK * 2);
    const size_t hstep = (size_t)HALF * K * 2;
    const size_t tstep = 2 * hstep;
    const unsigned ldsw = (unsigned)wid * 1024u;
    const int aoff = lds_byte(wr * 64 + fr, fq * 8), boff = lds_byte(wc * 32 + fr, fq * 8);
#define PG8_SA(b, h) (((b) * 2 + (h)) * HTB)
#define PG8_SB(b, h) ((4 + (b) * 2 + (h)) * HTB)
#define PG8_STAGE(bufoff, gbase, voff) do { _Pragma("unroll") for (int _i = 0; _i < 2; ++_i) \
        __builtin_amdgcn_global_load_lds((const unsigned*)((const char*)(gbase) + (voff)[_i]), (PG8_LAS unsigned*)(lds + (bufoff) + ldsw + _i * 8192), 16, 0, 0); } while (0)
#define PG8_LDA(dst, b, h) do { _Pragma("unroll") for (int m = 0; m < 4; ++m) _Pragma("unroll") for (int k = 0; k < 2; ++k) dst[m][k] = *(const PG8_LAS bf16x8*)(lds + PG8_SA(b, h) + aoff + m * 2048 + k * 1024); } while (0)
#define PG8_LDB(dst, b, h) do { _Pragma("unroll") for (int n = 0; n < 2; ++n) _Pragma("unroll") for (int k = 0; k < 2; ++k) dst[n][k] = *(const PG8_LAS bf16x8*)(lds + PG8_SB(b, h) + boff + n * 2048 + k * 1024); } while (0)
#define PG8_MMA(ai, bj, At, Bt) do { __builtin_amdgcn_s_setprio(1); _Pragma("unroll") for (int m = 0; m < 4; ++m) _Pragma("unroll") for (int n = 0; n < 2; ++n) _Pragma("unroll") for (int k = 0; k < 2; ++k) \
        acc[ai][bj][m][n] = __builtin_amdgcn_mfma_f32_16x16x32_bf16(Bt[n][k], At[m][k], acc[ai][bj][m][n], 0, 0, 0); __builtin_amdgcn_s_setprio(0); } while (0)
#define PG8_WAIT_V(n) asm volatile("s_waitcnt vmcnt(" #n ")" ::: "memory")
#define PG8_WAIT_L(n) asm volatile("s_waitcnt lgkmcnt(" #n ")" ::: "memory")
#define PG8_BAR __builtin_amdgcn_s_barrier()
#define PG8_SCHED __builtin_amdgcn_sched_barrier(0)
    Unit cur, nxt; int ui = 0;
    if (!S.next(0, cur)) return;
    f32x4 acc[2][2][4][2];
#pragma unroll
    for (int a = 0; a < 2; ++a)
#pragma unroll
        for (int b = 0; b < 2; ++b)
#pragma unroll
            for (int m = 0; m < 4; ++m)
#pragma unroll
                for (int n = 0; n < 2; ++n) acc[a][b][m][n] = (f32x4){0.f, 0.f, 0.f, 0.f};
    bf16x8 At[4][2], B0[2][2], B1[2][2];
    const char* cA = (const char*)g.A + (size_t)cur.pm * tstep; const char* cB = (const char*)g.Bt + (size_t)cur.pn * tstep;
    S.a_ready(cur);
    if constexpr (SP2) {
        PG8_STAGE(PG8_SB(0, 0), cB, voffB); PG8_STAGE(PG8_SB(0, 1), cB + hstep, voffB); PG8_STAGE(PG8_SA(0, 0), cA, voffA); PG8_STAGE(PG8_SA(0, 1), cA + hstep, voffA);
        if (wr == 1) PG8_BAR;
        PG8_WAIT_V(2); PG8_BAR;
        PG8_STAGE(PG8_SB(1, 0), cB + kstep, voffB); PG8_STAGE(PG8_SA(1, 0), cA + kstep, voffA); PG8_STAGE(PG8_SB(1, 1), cB + hstep + kstep, voffB);
        PG8_WAIT_V(6); PG8_BAR;
    } else {
        PG8_STAGE(PG8_SB(0, 0), cB, voffB); PG8_STAGE(PG8_SA(0, 0), cA, voffA); PG8_STAGE(PG8_SB(0, 1), cB + hstep, voffB); PG8_STAGE(PG8_SA(0, 1), cA + hstep, voffA);
        if (wr == 1) PG8_BAR;
        PG8_WAIT_V(4); PG8_BAR;
        PG8_STAGE(PG8_SB(1, 0), cB + kstep, voffB); PG8_STAGE(PG8_SA(1, 0), cA + kstep, voffA); PG8_STAGE(PG8_SB(1, 1), cB + hstep + kstep, voffB);
        PG8_WAIT_V(6); PG8_BAR;
    }
    for (;;) {
        const bool has_next = S.next(ui + 1, nxt);
        const char* nA = has_next ? (const char*)g.A + (size_t)nxt.pm * tstep : cA; const char* nB = has_next ? (const char*)g.Bt + (size_t)nxt.pn * tstep : cB;
        for (int t = 0; t < nt; t += 2) {
            const bool last = (t == nt - 2);
            const char* a1 = cA + (size_t)(t + 1) * kstep;
            const char* a2 = last ? nA : cA + (size_t)(t + 2) * kstep; const char* b2 = last ? nB : cB + (size_t)(t + 2) * kstep;
            const char* a3 = a2 + kstep; const char* b3 = b2 + kstep;
            if (last && has_next) S.a_ready(nxt);
            if constexpr (SP2) {
            PG8_LDB(B0, 0, 0); PG8_LDB(B1, 0, 1); PG8_SCHED; PG8_LDA(At, 0, 0); PG8_STAGE(PG8_SA(1, 1), a1 + hstep, voffA);
            PG8_WAIT_V(8); PG8_WAIT_L(0); PG8_BAR; PG8_MMA(0, 0, At, B0); PG8_MMA(0, 1, At, B1); PG8_BAR; PG8_SCHED;
            PG8_LDA(At, 0, 1); PG8_STAGE(PG8_SB(0, 0), b2, voffB); PG8_STAGE(PG8_SB(0, 1), b2 + hstep, voffB); PG8_STAGE(PG8_SA(0, 0), a2, voffA);
            PG8_WAIT_V(8); PG8_WAIT_L(0); PG8_BAR; PG8_MMA(1, 0, At, B0); PG8_MMA(1, 1, At, B1); PG8_BAR; PG8_SCHED;
            PG8_LDB(B0, 1, 0); PG8_LDB(B1, 1, 1); PG8_SCHED; PG8_LDA(At, 1, 0); PG8_STAGE(PG8_SA(0, 1), a2 + hstep, voffA);
            PG8_WAIT_V(8); PG8_WAIT_L(0); PG8_BAR; PG8_MMA(0, 0, At, B0); PG8_MMA(0, 1, At, B1); PG8_BAR; PG8_SCHED;
            PG8_LDA(At, 1, 1); PG8_STAGE(PG8_SB(1, 0), b3, voffB); PG8_STAGE(PG8_SB(1, 1), b3 + hstep, voffB); PG8_STAGE(PG8_SA(1, 0), a3, voffA);
            PG8_WAIT_V(8); PG8_WAIT_L(0); PG8_BAR; PG8_MMA(1, 0, At, B0); PG8_MMA(1, 1, At, B1); PG8_BAR; PG8_SCHED;
            } else {
            PG8_LDB(B0, 0, 0); PG8_SCHED; PG8_LDA(At, 0, 0); PG8_STAGE(PG8_SA(1, 1), a1 + hstep, voffA);
            PG8_WAIT_L(8); PG8_BAR; PG8_WAIT_L(0); PG8_MMA(0, 0, At, B0); PG8_BAR; PG8_SCHED;
            PG8_LDB(B1, 0, 1); PG8_STAGE(PG8_SB(0, 0), b2, voffB);
            PG8_BAR; PG8_WAIT_L(0); PG8_MMA(0, 1, At, B1); PG8_BAR;
            PG8_LDA(At, 0, 1); PG8_STAGE(PG8_SA(0, 0), a2, voffA);
            PG8_BAR; PG8_WAIT_L(0); PG8_MMA(1, 0, At, B0); PG8_BAR; PG8_SCHED;
            PG8_STAGE(PG8_SB(0, 1), b2 + hstep, voffB);
            PG8_WAIT_V(6); PG8_BAR; PG8_MMA(1, 1, At, B1); PG8_BAR;
            PG8_LDB(B0, 1, 0); PG8_SCHED; PG8_LDA(At, 1, 0); PG8_STAGE(PG8_SA(0, 1), a2 + hstep, voffA);
            PG8_WAIT_L(8); PG8_BAR; PG8_WAIT_L(0); PG8_MMA(0, 0, At, B0); PG8_BAR; PG8_SCHED;
            PG8_LDB(B1, 1, 1); PG8_STAGE(PG8_SB(1, 0), b3, voffB);
            PG8_BAR; PG8_WAIT_L(0); PG8_MMA(0, 1, At, B1); PG8_BAR;
            PG8_LDA(At, 1, 1); PG8_STAGE(PG8_SA(1, 0), a3, voffA);
            PG8_BAR; PG8_WAIT_L(0); PG8_MMA(1, 0, At, B0); PG8_BAR; PG8_SCHED;
            PG8_STAGE(PG8_SB(1, 1), b3 + hstep, voffB);
            PG8_WAIT_V(6); PG8_BAR; PG8_MMA(1, 1, At, B1); PG8_BAR;
            }
        }
        if constexpr (ALIGN_EPI) { if (wr == 0) PG8_BAR; }
        if constexpr (!Epi::AFTER_DRAIN) { E(acc, cur, wr, wc, fr, fq); S.done(cur); }
        if (!has_next) break;
#pragma unroll
        for (int a = 0; a < 2; ++a)
#pragma unroll
            for (int b = 0; b < 2; ++b)
#pragma unroll
                for (int m = 0; m < 4; ++m)
#pragma unroll
                    for (int n = 0; n < 2; ++n) acc[a][b][m][n] = (f32x4){0.f, 0.f, 0.f, 0.f};
        cur = nxt; cA = nA; cB = nB; ++ui;
        if constexpr (ALIGN_EPI) { if (wr == 1) PG8_BAR; }
    }
    PG8_WAIT_V(0);
    if constexpr (!ALIGN_EPI) { if (wr == 0) PG8_BAR; }
    PG8_BAR;
    if constexpr (Epi::AFTER_DRAIN) { E.fused(acc, cur, wr, wc, fr, fq, lds, wid, lane); S.done(cur); }
#undef PG8_SA
#undef PG8_SB
#undef PG8_STAGE
#undef PG8_LDA
#undef PG8_LDB
#undef PG8_MMA
#undef PG8_WAIT_V
#undef PG8_WAIT_L
#undef PG8_BAR
#undef PG8_SCHED
}
}

namespace attA {
constexpr int D = 128;
constexpr int LDQ = NQKV_A, LDKV = NQKV_A, LDO = 2 * DM;
constexpr float THR = 8.f;
constexpr bool WSKIP = false;
constexpr float SCALE = 0.08838834764831845f;
constexpr int NW = 8, QBLK = 32, KVBLK = 64, QB = NW * QBLK;
constexpr int SHM_V = KVBLK * D * 2, SHM_K = KVBLK * D * 2;
constexpr int LDS_BYTES = 2 * SHM_V + 2 * SHM_K + NW * 64 * 4;
using bf16 = __hip_bfloat16;
typedef short bf16x8 __attribute__((ext_vector_type(8)));
typedef short s16x4 __attribute__((ext_vector_type(4)));
typedef float f32x16 __attribute__((ext_vector_type(16)));
typedef float f32x4 __attribute__((ext_vector_type(4)));
typedef unsigned u32x4 __attribute__((ext_vector_type(4)));
template <class A, class Bt> struct same_t { static constexpr bool v = false; };
template <class A> struct same_t<A, A> { static constexpr bool v = true; };

#define KSWZ(row, colB) ((row) * 256 + ((colB) ^ (((row) & 7) << 4)))
#define SBAR() __builtin_amdgcn_sched_barrier(0)
__device__ __forceinline__ int v_st(int k, int c) { const int kk = (k & ~0xC) | ((k & 4) << 1) | ((k & 8) >> 1); return ((kk >> 3) * 4 + (c >> 5)) * 512 + ((kk & 7) * 32 + (c & 31)) * 2; }
__device__ __forceinline__ int v_rd_base(int lane) { return ((lane & 3) << 3) | (((lane >> 2) & 3) << 6) | (((lane >> 4) & 1) << 5) | (((lane >> 5) & 1) << 8); }
constexpr int v_rd_off(int d0, int ks, int half) { return d0 * 512 + ks * 4096 + half * 2048; }
__device__ __forceinline__ int crow(int r, int hi) { return (r & 3) + 8 * (r >> 2) + 4 * hi; }
__device__ __forceinline__ unsigned cvtpk(float lo, float hi) {
    unsigned r; asm volatile("v_cvt_pk_bf16_f32 %0, %1, %2" : "=v"(r) : "v"(lo), "v"(hi)); return r;
}
__device__ __forceinline__ bf16x8 pack8(f32x4 a, f32x4 b) {
    u32x4 w = {cvtpk(a[0], a[1]), cvtpk(a[2], a[3]), cvtpk(b[0], b[1]), cvtpk(b[2], b[3])};
    return *reinterpret_cast<bf16x8*>(&w);
}
template <class T> __device__ __forceinline__ bf16x8 load8(const T* p) {
    if constexpr (same_t<T, float>::v) { return pack8(*(const f32x4*)p, *(const f32x4*)(p + 4)); }
    else { return *reinterpret_cast<const bf16x8*>(p); }
}
__device__ __forceinline__ void mask_tile(f32x16& p0, f32x16& p1, int dq, unsigned W) {
    const float NEG = -__builtin_inff();
#pragma unroll
    for (int r = 0; r < 16; ++r) {
        const int c = (r & 3) + 8 * (r >> 2);
        if ((unsigned)(dq - c) >= W) p0[r] = NEG;
        if ((unsigned)(dq - c - 32) >= W) p1[r] = NEG;
    }
}
__device__ __forceinline__ void partialSM(f32x16& p0, f32x16& p1, float& m_reg, float& mn, float& alpha) {
    float pmax = p0[0]; for (int r = 1; r < 16; ++r) pmax = fmaxf(pmax, p0[r]); for (int r = 0; r < 16; ++r) pmax = fmaxf(pmax, p1[r]);
    { auto rr = __builtin_amdgcn_permlane32_swap(__float_as_uint(pmax), __float_as_uint(pmax), false, false);
      pmax = fmaxf(__uint_as_float(rr[0]), __uint_as_float(rr[1])); }
    constexpr float C2 = 1.4426950408889634f * SCALE;
    if (__builtin_expect(__all((pmax - m_reg) * SCALE <= THR), 1)) { mn = m_reg; alpha = 1.f; }
    else { mn = fmaxf(m_reg, pmax); alpha = __builtin_amdgcn_exp2f((m_reg - mn) * C2); m_reg = mn; }
    const float mnL = -mn * C2;
    for (int r = 0; r < 16; ++r) p0[r] = fmaf(p0[r], C2, mnL); for (int r = 0; r < 16; ++r) p1[r] = fmaf(p1[r], C2, mnL);
    for (int r = 0; r < 16; ++r) p0[r] = __builtin_amdgcn_exp2f(p0[r]);
}
__device__ __forceinline__ void finishSM(f32x16& p0, f32x16& p1, float alpha, float& l_reg, bf16x8& pa0, bf16x8& pa1, bf16x8& pa2, bf16x8& pa3) {
    for (int r = 0; r < 16; ++r) p1[r] = __builtin_amdgcn_exp2f(p1[r]);
    float ps = 0; for (int r = 0; r < 16; ++r) ps += p0[r]; for (int r = 0; r < 16; ++r) ps += p1[r];
    { auto rr = __builtin_amdgcn_permlane32_swap(__float_as_uint(ps), __float_as_uint(ps), false, false);
      ps = __uint_as_float(rr[0]) + __uint_as_float(rr[1]); }
    l_reg = l_reg * alpha + ps;
#define PK4(P, B_, OUT) do { unsigned a0 = cvtpk(P[B_+0], P[B_+1]), a1 = cvtpk(P[B_+2], P[B_+3]);                          \
        unsigned b0 = cvtpk(P[B_+4], P[B_+5]), b1 = cvtpk(P[B_+6], P[B_+7]);                                             \
        auto r0 = __builtin_amdgcn_permlane32_swap(a0, b0, false, false); auto r1 = __builtin_amdgcn_permlane32_swap(a1, b1, false, false); \
        u32x4 w = {r0[0], r1[0], r0[1], r1[1]}; OUT = *reinterpret_cast<bf16x8*>(&w); } while (0)
    PK4(p0, 0, pa0); PK4(p0, 8, pa1); PK4(p1, 0, pa2); PK4(p1, 8, pa3);
#undef PK4
}
template <int KB, bool SK>
__device__ __forceinline__ void qkt(f32x16& p0, f32x16& p1, const char* K_lds, int r32, int hi, const bf16x8* qr, bool act) {
    if (SK && !act) { const float NEG = -__builtin_inff();
#pragma unroll
        for (int r = 0; r < 16; ++r) { p0[r] = NEG; p1[r] = NEG; } return; }
    p0 = f32x16{}; p1 = f32x16{};
    const char* kb[4];
#pragma unroll
    for (int dd = 0; dd < 4; ++dd) kb[dd] = K_lds + KB * SHM_K + KSWZ(r32, (dd * 16 + hi * 8) * 2);
#pragma unroll
    for (int d0 = 0; d0 < 8; ++d0) { const char* a = kb[d0 & 3] + (d0 >> 2) * 128;
        bf16x8 b0 = *reinterpret_cast<const bf16x8*>(a);
        bf16x8 b1 = *reinterpret_cast<const bf16x8*>(a + 32 * 256);
        p0 = __builtin_amdgcn_mfma_f32_32x32x16_bf16(b0, qr[d0], p0, 0, 0, 0);
        p1 = __builtin_amdgcn_mfma_f32_32x32x16_bf16(b1, qr[d0], p1, 0, 0, 0); }
}
template <int VB, bool SK>
__device__ __forceinline__ void pv_tile(f32x16* o, int vb0, bf16x8 pa0, bf16x8 pa1, bf16x8 pa2, bf16x8 pa3, bool act) {
    if (SK && !act) return;
#define TRRD(dst, off) asm volatile("ds_read_b64_tr_b16 %0, %1 offset:%2" : "=&v"(dst) : "v"(vb0), "i"(off) : "memory")
#define PV_D0(d0) do { s16x4 l0, l1, l2, l3, h0, h1, h2, h3; constexpr int b_ = VB * SHM_V + v_rd_off(d0, 0, 0);     \
        TRRD(l0, b_); TRRD(h0, b_ + 2048); TRRD(l1, b_ + 4096); TRRD(h1, b_ + 6144); TRRD(l2, b_ + 8192); TRRD(h2, b_ + 10240); TRRD(l3, b_ + 12288); TRRD(h3, b_ + 14336); \
        asm volatile("s_waitcnt lgkmcnt(0)" ::: "memory"); SBAR();                 \
        o[d0] = __builtin_amdgcn_mfma_f32_32x32x16_bf16(pa0, (bf16x8){l0[0], l0[1], l0[2], l0[3], h0[0], h0[1], h0[2], h0[3]}, o[d0], 0, 0, 0);   \
        o[d0] = __builtin_amdgcn_mfma_f32_32x32x16_bf16(pa1, (bf16x8){l1[0], l1[1], l1[2], l1[3], h1[0], h1[1], h1[2], h1[3]}, o[d0], 0, 0, 0);   \
        o[d0] = __builtin_amdgcn_mfma_f32_32x32x16_bf16(pa2, (bf16x8){l2[0], l2[1], l2[2], l2[3], h2[0], h2[1], h2[2], h2[3]}, o[d0], 0, 0, 0);   \
        o[d0] = __builtin_amdgcn_mfma_f32_32x32x16_bf16(pa3, (bf16x8){l3[0], l3[1], l3[2], l3[3], h3[0], h3[1], h3[2], h3[3]}, o[d0], 0, 0, 0); } while (0)
    PV_D0(0); PV_D0(1); PV_D0(2); PV_D0(3);
#undef PV_D0
#undef TRRD
}

template <class TIn, class TOut> struct BlockRef { const TIn* Q; const TIn* K; const TIn* V; TOut* O; int P0; };
template <class TIn> struct Seam {
    bf16x8 qr[8];
    bf16x8 st_v0, st_v1, st_k0, st_k1; f32x4 sf0, sf1, sf2, sf3;
    f32x4 tq[16];
};
__device__ __forceinline__ int swa_jlo(int P0, int W) { const int lowk = P0 - W + 1; return lowk > 0 ? lowk / KVBLK : 0; }
#define ROW(p, k0, rr) ((p) + (size_t)((k0) + (rr)) * LDKV + sc)
#define VMW() asm volatile("s_waitcnt vmcnt(0)" ::: "memory")
#define VMWN(n) asm volatile("s_waitcnt vmcnt(%0)" :: "i"(n) : "memory")
#define SLOAD_H(Kp, Vp, k0) do { S.st_v0 = load8<TIn>(ROW(Vp, k0, sr)); S.st_v1 = load8<TIn>(ROW(Vp, k0, 32 + sr));              \
                         S.st_k0 = load8<TIn>(ROW(Kp, k0, sr)); S.st_k1 = load8<TIn>(ROW(Kp, k0, 32 + sr)); } while (0)
#define SWRITE_HK(bf) do { *(bf16x8*)(K_lds + (bf) * SHM_K + kws) = S.st_k0; *(bf16x8*)(K_lds + (bf) * SHM_K + kws + 32 * 256) = S.st_k1; } while (0)
#define SWRITE_HV(bf) do { *(bf16x8*)(V_lds + (bf) * SHM_V + vst0) = S.st_v0; *(bf16x8*)(V_lds + (bf) * SHM_V + vst1) = S.st_v1; } while (0)
#define SWRITE_H(bf) do { SWRITE_HV(bf); SWRITE_HK(bf); } while (0)
#define SLOAD_F(p, k0) do { S.sf0 = *(const f32x4*)ROW(p, k0, sr); S.sf1 = *(const f32x4*)(ROW(p, k0, sr) + 4);                \
                            S.sf2 = *(const f32x4*)ROW(p, k0, 32 + sr); S.sf3 = *(const f32x4*)(ROW(p, k0, 32 + sr) + 4); } while (0)
#define SWRITE_KF(bf) do { *(bf16x8*)(K_lds + (bf) * SHM_K + kws) = pack8(S.sf0, S.sf1); *(bf16x8*)(K_lds + (bf) * SHM_K + kws + 32 * 256) = pack8(S.sf2, S.sf3); } while (0)
#define SWRITE_VF(bf) do { *(bf16x8*)(V_lds + (bf) * SHM_V + vst0) = pack8(S.sf0, S.sf1); *(bf16x8*)(V_lds + (bf) * SHM_V + vst1) = pack8(S.sf2, S.sf3); } while (0)
template <class TIn, class TOut>
__device__ __forceinline__ void causal_swa_prime(const BlockRef<TIn, TOut>& cur, int W, char* lds, Seam<TIn>& S) {
    constexpr bool F32 = same_t<TIn, float>::v;
    const int tid = opaque_tid(), wid = __builtin_amdgcn_readfirstlane(tid >> 6), lane = tid & 63, r32 = lane & 31, hi = lane >> 5;
    const int sr = tid >> 4, sc = (tid & 15) * 8, kws = KSWZ(sr, sc * 2); char* K_lds = lds + 2 * SHM_V;
    const int kb0 = swa_jlo(cur.P0, W) * KVBLK;
    for (int d0 = 0; d0 < 8; ++d0) S.qr[d0] = load8<TIn>(cur.Q + (size_t)(wid * QBLK + r32) * LDQ + d0 * 16 + hi * 8);
    if constexpr (F32) { SLOAD_F((const float*)cur.K, kb0); VMW(); SWRITE_KF(0); SBAR(); SLOAD_F((const float*)cur.V, kb0); }
    else { SLOAD_H(cur.K, cur.V, kb0); VMW(); SWRITE_HK(0); }
    __syncthreads();
}
template <class TIn, class TOut>
__device__ __forceinline__ void causal_swa_block(const BlockRef<TIn, TOut>& cur, const BlockRef<TIn, TOut>& nxt, int skv, int W, char* lds, Seam<TIn>& S) {
    constexpr bool F32 = same_t<TIn, float>::v;
    const int tid = opaque_tid(), wid = __builtin_amdgcn_readfirstlane(tid >> 6), lane = tid & 63, r32 = lane & 31, hi = lane >> 5;
    const int j_lo = swa_jlo(cur.P0, W);
    int j_hi = (cur.P0 + QB - 1) / KVBLK + 1; if (j_hi > skv / KVBLK) j_hi = skv / KVBLK;
    const int NT = j_hi - j_lo;
    const int kbn = swa_jlo(nxt.P0, W) * KVBLK;
    const int qlo = cur.P0 + wid * QBLK, qm = qlo + r32 - 4 * hi;
    char* V_lds = lds; char* K_lds = lds + 2 * SHM_V;
    float* ws = (float*)(lds + 2 * SHM_V + 2 * SHM_K) + wid * 64; float* li_l = ws, * al_l = ws + 32;
    float m_reg = -1e30f, l_reg = 0; f32x16 o[4] = {};
    const int sr = tid >> 4, sc = (tid & 15) * 8, vst0 = v_st(sr, sc), vst1 = v_st(32 + sr, sc), kws = KSWZ(sr, sc * 2);
    const int vb0 = (int)(uintptr_t)V_lds + v_rd_base(lane);
    const TIn* Kh = cur.K; const TIn* Vh = cur.V;
#define RESC(a) do { if (__any((a) < 1.f)) { if (hi == 0) al_l[r32] = (a); asm volatile("s_waitcnt lgkmcnt(0)" ::: "memory");              \
                     for (int d_ = 0; d_ < 4; ++d_) for (int r = 0; r < 16; ++r) o[d_][r] *= al_l[crow(r, hi)]; } } while (0)
#define KBASE(t) ((j_lo + (t)) * KVBLK)
#define ACT(t) (KBASE(t) <= qlo + QBLK - 1 && KBASE(t) + KVBLK - 1 >= qlo - W + 1)
#define MASKT(P0_, P1_, t) do { const int kb_ = KBASE(t); if ((!SK || ACT(t)) && (kb_ + KVBLK - 1 > qlo || kb_ <= qlo + QBLK - 1 - W)) mask_tile(P0_, P1_, qm - kb_, (unsigned)W); } while (0)
    constexpr int NQL = F32 ? 16 : 8;
    constexpr bool SK = WSKIP && !F32;
#define SEAM_K0() do { VMWN(NQL); if constexpr (F32) { SWRITE_KF(0); SBAR(); SLOAD_F((const float*)nxt.V, kbn); } else { SWRITE_HK(0); } SBAR(); } while (0)
    f32x16 pA0, pA1, pB0, pB1; float mnA, mnB, alA, alB; bf16x8 pa0, pa1, pa2, pa3;
    if constexpr (F32) { VMW(); SWRITE_VF(0); SBAR(); } else { SWRITE_HV(0); SBAR(); }
    if (NT > 1) { if constexpr (F32) SLOAD_F((const float*)Kh, KBASE(1)); else SLOAD_H(Kh, Vh, KBASE(1)); }
    SBAR(); qkt<0, SK>(pA0, pA1, K_lds, r32, hi, S.qr, ACT(0));
    if constexpr (F32) { if (NT > 1) { VMW(); SWRITE_KF(1); SBAR(); SLOAD_F((const float*)Vh, KBASE(1)); } }
    MASKT(pA0, pA1, 0); partialSM(pA0, pA1, m_reg, mnA, alA);
    if (NT > 1) { VMW(); if constexpr (F32) { SWRITE_VF(1); SBAR(); if (NT > 2) SLOAD_F((const float*)Kh, KBASE(2)); } else SWRITE_H(1); }
    __syncthreads();
#define HALF_STEP(PX0, PX1, mnX, alX, PY0, PY1, alY, t, KB, VB, SB) do {                                                      \
        SBAR(); qkt<KB, SK>(PX0, PX1, K_lds, r32, hi, S.qr, ACT(t));                                             \
        finishSM(PY0, PY1, alY, l_reg, pa0, pa1, pa2, pa3); SBAR();                                                           \
        if ((t) + 1 < NT) { if constexpr (F32) { VMW(); SWRITE_KF(SB); SBAR(); SLOAD_F((const float*)Vh, KBASE((t) + 1)); }  \
                            else { SLOAD_H(Kh, Vh, KBASE((t) + 1)); } SBAR(); }                                               \
        pv_tile<VB, SK>(o, vb0, pa0, pa1, pa2, pa3, ACT((t) - 1)); MASKT(PX0, PX1, (t)); partialSM(PX0, PX1, m_reg, mnX, alX);                                        \
        __syncthreads();                                                                                                      \
        if ((t) + 1 < NT) { VMW(); if constexpr (F32) { SWRITE_VF(SB); SBAR(); if ((t) + 2 < NT) SLOAD_F((const float*)Kh, KBASE((t) + 2)); } \
                            else { SWRITE_H(SB); } }                                                                          \
        RESC(alX); __syncthreads(); } while (0)
    for (int t = 1; t + 1 < NT; t += 2) {
        HALF_STEP(pB0, pB1, mnB, alB, pA0, pA1, alA, t, 1, 0, 0);
        HALF_STEP(pA0, pA1, mnA, alA, pB0, pB1, alB, t + 1, 0, 1, 1);
    }
    const bool even = (NT & 1) == 0;
    if (even) { SBAR(); qkt<1, SK>(pB0, pB1, K_lds, r32, hi, S.qr, ACT(NT - 1)); SBAR(); }
#define QROW(e) (nxt.Q + (size_t)(wid * QBLK + r32) * LDQ + ((e) >> 1) * 16 + hi * 8 + ((e) & 1) * 4)
    if constexpr (F32) { SLOAD_F((const float*)nxt.K, kbn); SBAR();
#pragma unroll
        for (int e = 0; e < 8; ++e) S.tq[e] = *(const f32x4*)QROW(e); }
    else { SLOAD_H(nxt.K, nxt.V, kbn); SBAR();
#pragma unroll
        for (int d0 = 0; d0 < 8; ++d0) S.qr[d0] = load8<TIn>(nxt.Q + (size_t)(wid * QBLK + r32) * LDQ + d0 * 16 + hi * 8); }
    SBAR();
    finishSM(pA0, pA1, alA, l_reg, pa0, pa1, pa2, pa3); SBAR();
    if constexpr (F32) {
#pragma unroll
        for (int e = 8; e < 16; ++e) S.tq[e] = *(const f32x4*)QROW(e); SBAR(); }
#undef QROW
    pv_tile<0, SK>(o, vb0, pa0, pa1, pa2, pa3, ACT(even ? NT - 2 : NT - 1));
    if (even) { MASKT(pB0, pB1, NT - 1); partialSM(pB0, pB1, m_reg, mnB, alB); __syncthreads(); RESC(alB);
        finishSM(pB0, pB1, alB, l_reg, pa0, pa1, pa2, pa3); SBAR(); pv_tile<1, SK>(o, vb0, pa0, pa1, pa2, pa3, ACT(NT - 1)); }
    SBAR(); SEAM_K0();
    if (hi == 0) li_l[r32] = l_reg; asm volatile("s_waitcnt lgkmcnt(0)" ::: "memory");
    float rli[16];
#pragma unroll
    for (int r = 0; r < 16; ++r) rli[r] = __builtin_amdgcn_rcpf(li_l[crow(r, hi)]);
    TOut* Ow = cur.O + (size_t)(wid * QBLK) * LDO;
#pragma unroll
    for (int r = 0; r < 16; ++r) { const int orow = crow(r, hi);
#pragma unroll
        for (int d0 = 0; d0 < 4; ++d0) { const float v = o[d0][r] * rli[r];
            if constexpr (same_t<TOut, float>::v) { Ow[(size_t)orow * LDO + d0 * 32 + r32] = v; }
            else { const float vn = __shfl_xor(v, 1);
                   if ((r32 & 1) == 0) *(unsigned*)(Ow + (size_t)orow * LDO + d0 * 32 + r32) = cvtpk(v, vn); } } }
    if constexpr (F32) {
#pragma unroll
        for (int d0 = 0; d0 < 8; ++d0) S.qr[d0] = pack8(S.tq[2 * d0], S.tq[2 * d0 + 1]); }
    __syncthreads();
#undef RESC
#undef KBASE
#undef ACT
#undef MASKT
#undef SEAM_K0
#undef HALF_STEP
}
#undef ROW
#undef VMW
#undef VMWN
#undef SLOAD_H
#undef SWRITE_HK
#undef SWRITE_HV
#undef SWRITE_H
#undef SLOAD_F
#undef SWRITE_KF
#undef SWRITE_VF

#undef KSWZ
#undef SBAR
}

namespace attB {
typedef short bf16x8 __attribute__((ext_vector_type(8)));
typedef short s16x4 __attribute__((ext_vector_type(4)));
typedef float f32x16 __attribute__((ext_vector_type(16)));
typedef unsigned u32x4 __attribute__((ext_vector_type(4)));
typedef unsigned short bf16_t;
constexpr int HD = 64, LD = NQKV_B, KOFF = 2048, VOFF = 2304, LDO = DM;
constexpr int LDS_K = 0, LDS_V = 32768, LDS_S = 65536, LDS_BYTES = 65536 + 8 * 32 * 4;
constexpr float C2 = 0.125f * 1.4426950408889634f;
__device__ __forceinline__ int crow(int r, int hi) { return (r & 3) + 8 * (r >> 2) + 4 * hi; }
__device__ __forceinline__ unsigned cvtpk(float lo, float hi) { unsigned r; asm volatile("v_cvt_pk_bf16_f32 %0, %1, %2" : "=v"(r) : "v"(lo), "v"(hi)); return r; }
typedef short v4i16_t __attribute__((ext_vector_type(4)));
__device__ __forceinline__ s16x4 vtr(LAS const unsigned char* p) { return __builtin_bit_cast(s16x4, __builtin_amdgcn_ds_read_tr16_b64_v4i16((LAS v4i16_t*)p)); }

__device__ __forceinline__ void swa_unit(int b, int kvh, int n, const bf16_t* __restrict__ QKV, const float* __restrict__ sinks, bf16_t* __restrict__ O, LAS unsigned char* lds) {
    const int tid = opaque_tid(), lane = tid & 63, r32 = lane & 31, hi = lane >> 5, wid = __builtin_amdgcn_readfirstlane(tid >> 6);
    __syncthreads();
    const size_t tok0 = (size_t)b * SEQ;
#pragma unroll
    for (int i = 0; i < 4; ++i) {
        const int c = tid + 512 * i, row = c >> 3, ch = c & 7, t = n * 128 - 128 + row;
        u32x4 kv = {0u, 0u, 0u, 0u}, vv = {0u, 0u, 0u, 0u};
        if (t >= 0) { const bf16_t* p = QKV + (tok0 + (size_t)t) * LD + kvh * HD + ch * 8; kv = *(const u32x4*)(p + KOFF); vv = *(const u32x4*)(p + VOFF); }
        *(LAS u32x4*)(lds + LDS_K + row * 128 + ((ch ^ ((row >> 1) & 7)) << 4)) = kv;
        *(LAS u32x4*)(lds + LDS_V + row * 128 + (ch << 4)) = vv;
    }
    __syncthreads();
    const int hq = kvh * 8 + wid;
    const float sink2 = sinks[hq] * 1.4426950408889634f;
    LAS float* scr = (LAS float*)(lds + LDS_S) + wid * 32;
    const int vq = (lane & 15) >> 2, vp = lane & 3, vg1 = (lane >> 4) & 1;
    LAS const unsigned char* vbase = lds + LDS_V + (4 * hi + vq) * 128 + (16 * vg1 + 4 * vp) * 2;
    const float NEG = -__builtin_inff();
    for (int qs = 0; qs < 4; ++qs) {
        const size_t tq = tok0 + (size_t)(n * 128 + 32 * qs + r32);
        bf16x8 qr[4];
#pragma unroll
        for (int d0 = 0; d0 < 4; ++d0) qr[d0] = *(const bf16x8*)(QKV + tq * LD + hq * HD + d0 * 16 + hi * 8);
        f32x16 p[5];
#pragma unroll
        for (int tt = 0; tt < 5; ++tt) {
            const int kt = qs + tt; const bool dead = (n == 0) && (kt < 4);
            p[tt] = f32x16{};
            if (!dead) { const int krow = kt * 32 + r32;
#pragma unroll
                for (int d0 = 0; d0 < 4; ++d0) { const bf16x8 kf = *(LAS const bf16x8*)(lds + LDS_K + krow * 128 + (((d0 * 2 + hi) ^ ((krow >> 1) & 7)) << 4));
                    p[tt] = __builtin_amdgcn_mfma_f32_32x32x16_bf16(kf, qr[d0], p[tt], 0, 0, 0); } }
#pragma unroll
            for (int r = 0; r < 16; ++r) { const int c = crow(r, hi); bool valid = !dead;
                if (tt == 0) valid = valid && (c > r32);
                if (tt == 4) valid = valid && (c <= r32);
                p[tt][r] = valid ? p[tt][r] * C2 : NEG; }
        }
        float mx = sink2;
#pragma unroll
        for (int tt = 0; tt < 5; ++tt)
#pragma unroll
            for (int r = 0; r < 16; ++r) mx = fmaxf(mx, p[tt][r]);
        mx = fmaxf(mx, __shfl_xor(mx, 32));
        float sum = 0.f;
#pragma unroll
        for (int tt = 0; tt < 5; ++tt)
#pragma unroll
            for (int r = 0; r < 16; ++r) { const float e = __builtin_amdgcn_exp2f(p[tt][r] - mx); p[tt][r] = e; sum += e; }
        sum += __shfl_xor(sum, 32);
        sum += __builtin_amdgcn_exp2f(sink2 - mx);
        if (hi == 0) scr[r32] = 1.0f / sum;
        f32x16 o[2]; o[0] = f32x16{}; o[1] = f32x16{};
#pragma unroll
        for (int tt = 0; tt < 5; ++tt) {
            const int kt = qs + tt; const bool dead = (n == 0) && (kt < 4);
            if (!dead) {
#pragma unroll
                for (int s = 0; s < 2; ++s) {
                    u32x4 w; w.x = cvtpk(p[tt][8 * s + 0], p[tt][8 * s + 1]); w.y = cvtpk(p[tt][8 * s + 2], p[tt][8 * s + 3]); w.z = cvtpk(p[tt][8 * s + 4], p[tt][8 * s + 5]); w.w = cvtpk(p[tt][8 * s + 6], p[tt][8 * s + 7]);
                    const bf16x8 pa = __builtin_bit_cast(bf16x8, w);
#pragma unroll
                    for (int d0 = 0; d0 < 2; ++d0) { LAS const unsigned char* vp_ = vbase + (kt * 32 + 16 * s) * 128 + d0 * 64;
                        const s16x4 lo = vtr(vp_), hh = vtr(vp_ + 8 * 128);
                        const bf16x8 vf = {lo[0], lo[1], lo[2], lo[3], hh[0], hh[1], hh[2], hh[3]};
                        o[d0] = __builtin_amdgcn_mfma_f32_32x32x16_bf16(pa, vf, o[d0], 0, 0, 0); }
                }
            }
        }
        bf16_t* Ow = O + (tok0 + (size_t)(n * 128 + 32 * qs)) * LDO + hq * HD;
#pragma unroll
        for (int r = 0; r < 16; ++r) { const int orow = crow(r, hi); const float ri = scr[orow];
#pragma unroll
            for (int d0 = 0; d0 < 2; ++d0) { const float v = o[d0][r] * ri; const float vn = __shfl_xor(v, 1);
                if ((r32 & 1) == 0) *(unsigned*)(Ow + (size_t)orow * LDO + d0 * 32 + r32) = cvtpk(v, vn); } }
    }
}
}

constexpr int NWAVES = 8;
#ifndef MK_PER_PHASE
#define MK_PER_PHASE 1
#endif
constexpr int N_PHASES = 2 + 8 * DEPTH;

constexpr size_t MiB = 1u << 20;
constexpr size_t WS_CTL = 0, CTL_ZERO_BYTES = 1 * MiB;
constexpr size_t WS_MOD = 2 * MiB;
constexpr size_t WS_TABA = 3 * MiB;
constexpr size_t WS_TABB = 5 * MiB;
constexpr size_t WS_BPERM = 6 * MiB;
constexpr size_t WS_WUP = 8 * MiB, WS_WDN = 40 * MiB, WS_WMLP_STRIDE = 64 * MiB;
constexpr size_t WS_WQKVA = 264 * MiB, WS_WOA = 288 * MiB, WS_WA_STRIDE = 32 * MiB;
constexpr size_t WS_WQKVB = 328 * MiB, WS_WOB = 338 * MiB, WS_WB_STRIDE = 18 * MiB;
constexpr size_t WS_X = 364 * MiB;
constexpr size_t WS_HB = 492 * MiB;
constexpr size_t WS_QKV = 556 * MiB;
constexpr size_t WS_AO = 748 * MiB;
constexpr size_t WS_AC = 876 * MiB;
constexpr size_t WS_HID = 940 * MiB;
constexpr size_t WS_END = 1196 * MiB;
constexpr int CW_TMO = 0, CW_CODE = 1, CW_BAR = 4096;

constexpr int RING_OFF = 0, RING_BYTES = 131072;
constexpr int LDSCTL_OFF = RING_BYTES, MISC_OFF = LDSCTL_OFF + 320;
constexpr int LDS_BYTES = 147456;
static_assert(attA::LDS_BYTES <= RING_BYTES && attB::LDS_BYTES <= RING_BYTES, "attention scratch fits the ring region");

struct Frame {
    LAS unsigned char* lds;
    volatile LAS unsigned* MISC;
    gu32* ctl;
    int vcu, G;
};
#define FR_IDS() const int f_tid = opaque_tid(), f_lane = f_tid & 63, f_wave = __builtin_amdgcn_readfirstlane(f_tid >> 6); (void)f_tid; (void)f_lane; (void)f_wave

__device__ __forceinline__ float wave_sum(float v) {
#pragma unroll
    for (int o = 1; o < 64; o <<= 1) v += __shfl_xor(v, o);
    return v;
}
__device__ __forceinline__ float bf2f(unsigned short u) { return __uint_as_float((unsigned)u << 16); }

__device__ __forceinline__ int dest_row(int n, int mode) {
    if (mode == 1 && n < 4096) { const int j = n & 127; return (n & ~127) + (((j & 63) << 1) | (j >> 6)); }
    if (mode == 2 && n < 2304) { const int j = n & 63; return (n & ~63) + (((j & 31) << 1) | (j >> 5)); }
    return n;
}
__device__ __forceinline__ void p0_transpose_item(const float* W, int K, int N, bf16* WT, int mode, LAS float* scr, int item, int lane) {
    const int nblk = N / 32, kb = item / nblk, nb = item % nblk, k0 = 64 * kb, n0 = 32 * nb;
#pragma unroll 8
    for (int i = 0; i < 32; ++i) { const int kk = 2 * i + (lane >> 5); scr[kk * 33 + (lane & 31)] = W[(size_t)(k0 + kk) * N + n0 + (lane & 31)]; }
    LDS_WAIT(); asm volatile("" ::: "memory");
    const int c = lane & 7;
#pragma unroll
    for (int j = 0; j < 4; ++j) { const int n = (lane >> 3) + 8 * j; const LAS float* s = scr + (8 * c) * 33 + n;
        v4u o; o.x = pk2(s[0 * 33], s[1 * 33]); o.y = pk2(s[2 * 33], s[3 * 33]); o.z = pk2(s[4 * 33], s[5 * 33]); o.w = pk2(s[6 * 33], s[7 * 33]);
        *(GAS v4u*)(WT + (size_t)dest_row(n0 + n, mode) * K + k0 + 8 * c) = o; }
    LDS_WAIT(); asm volatile("" ::: "memory");
}
__device__ __forceinline__ void sincos_d(double x, double& sn, double& cs) {
    const double k = __builtin_rint(x * 0.63661977236758134308);
    double r = __builtin_fma(-k, 1.57079632673412561417e+00, x); r = __builtin_fma(-k, 6.07710050650619224932e-11, r);
    const double r2 = r * r;
    double ps = -1.0 / 1307674368000.0; ps = ps * r2 + 1.0 / 6227020800.0; ps = ps * r2 - 1.0 / 39916800.0; ps = ps * r2 + 1.0 / 362880.0; ps = ps * r2 - 1.0 / 5040.0; ps = ps * r2 + 1.0 / 120.0; ps = ps * r2 - 1.0 / 6.0; ps = ps * r2 * r + r;
    double pc = 1.0 / 20922789888000.0; pc = pc * r2 - 1.0 / 87178291200.0; pc = pc * r2 + 1.0 / 479001600.0; pc = pc * r2 - 1.0 / 3628800.0; pc = pc * r2 + 1.0 / 40320.0; pc = pc * r2 - 1.0 / 720.0; pc = pc * r2 + 1.0 / 24.0; pc = pc * r2 - 0.5; pc = pc * r2 + 1.0;
    const int q = (int)k & 3;
    sn = (q == 0) ? ps : (q == 1) ? pc : (q == 2) ? -ps : -pc;
    cs = (q == 0) ? pc : (q == 1) ? -ps : (q == 2) ? -pc : ps;
}
__device__ __forceinline__ void rope_entry(float* tab, int idx, int half, double base_ratio) {
    const int s = idx / half, j = idx % half;
    double inv = 1.0, rr = base_ratio;
    for (int t = j; t; t >>= 1) { if (t & 1) inv *= rr; rr *= rr; }
    const float invf = (float)inv, angf = (float)s * invf;
    double sn, cs; sincos_d((double)angf, sn, cs);
    tab[2 * (size_t)idx] = (float)cs; tab[2 * (size_t)idx + 1] = (float)sn;
}

struct Args { const float* in[22]; float* out; unsigned char* ws; int ph_lo, ph_hi; };
typedef __attribute__((address_space(4))) const Args CArgs;

__device__ __forceinline__ void p0_prologue(Frame& F, CArgs* ap) {
    FR_IDS();
    unsigned char* ws = ap->ws;
    {
        LAS float* cact = (LAS float*)F.lds;
        LAS float* part = (LAS float*)(F.lds + 32768);
        const float* cin = ap->in[1];
        for (int i = f_tid; i < NB * DM; i += NWAVES * 64) { const float c = cin[i]; cact[i] = c / (1.0f + expf(-c)); }
        __syncthreads();
        float* mod = (float*)(ws + WS_MOD);
        for (int it = F.vcu; it < 256; it += F.G) {
            const int L = it >> 6, cb = it & 63;
            if (f_lane < 48) {
                const float* Wp = ap->in[2] + ((size_t)L * DM + 256 * f_wave) * (NMOD * DM) + 192 * cb + 4 * f_lane;
                f32x4 a0 = {0.f, 0.f, 0.f, 0.f}, a1 = a0, a2 = a0, a3 = a0;
#pragma unroll 8
                for (int kk = 0; kk < 256; ++kk) { const f32x4 w = *(const f32x4*)(Wp + (size_t)kk * (NMOD * DM)); const int k = 256 * f_wave + kk;
                    a0 += w * cact[k]; a1 += w * cact[DM + k]; a2 += w * cact[2 * DM + k]; a3 += w * cact[3 * DM + k]; }
                LAS f32x4* pp = (LAS f32x4*)(part + (f_wave * NB) * 192) + f_lane;
                pp[0] = a0; pp[48] = a1; pp[96] = a2; pp[144] = a3;
            }
            __syncthreads();
            for (int o = f_tid; o < NB * 192; o += NWAVES * 64) { const int b = o / 192, cc = o % 192; float s = 0.f;
#pragma unroll
                for (int w = 0; w < 8; ++w) s += part[(w * NB + b) * 192 + cc];
                mod[((size_t)L * NB + b) * (NMOD * DM) + 192 * cb + cc] = s + ap->in[3][(size_t)L * (NMOD * DM) + 192 * cb + cc]; }
            __syncthreads();
        }
    }
    {
        LAS float* scr = (LAS float*)(F.lds + RING_OFF + f_wave * 16384);
        const int gw = F.vcu * NWAVES + f_wave, NGW = F.G * NWAVES;
        constexpr int NITEMS = 4 * 16384 + 2 * 8192 + 2 * 4608;
        for (int it = gw; it < NITEMS; it += NGW) {
            int r = it; const float* W; bf16* WT; int K, N, mode = 0, item;
            if (r < 65536) { const int L = r >> 14, rr = r & 16383;
                if (rr < 8192) { W = ap->in[8] + (size_t)L * DM * DFF; K = DM; N = DFF; WT = (bf16*)(ws + WS_WUP + L * WS_WMLP_STRIDE); item = rr; }
                else { W = ap->in[9] + (size_t)L * DFF * DM; K = DFF; N = DM; WT = (bf16*)(ws + WS_WDN + L * WS_WMLP_STRIDE); item = rr - 8192; } }
            else { r -= 65536;
                if (r < 16384) { const int j = r >> 13, rr = r & 8191;
                    if (rr < 6144) { W = ap->in[10] + (size_t)j * DM * NQKV_A; K = DM; N = NQKV_A; WT = (bf16*)(ws + WS_WQKVA + j * WS_WA_STRIDE); mode = 1; item = rr; }
                    else { W = ap->in[11] + (size_t)j * DM * DM; K = DM; N = DM; WT = (bf16*)(ws + WS_WOA + j * WS_WA_STRIDE); item = rr - 6144; } }
                else { r -= 16384; const int j = r / 4608, rr = r % 4608;
                    if (rr < 2560) { W = ap->in[17] + (size_t)j * DM * NQKV_B; K = DM; N = NQKV_B; WT = (bf16*)(ws + WS_WQKVB + j * WS_WB_STRIDE); mode = 2; item = rr; }
                    else { W = ap->in[20] + (size_t)j * DM * DM; K = DM; N = DM; WT = (bf16*)(ws + WS_WOB + j * WS_WB_STRIDE); item = rr - 2560; } } }
            p0_transpose_item(W, K, N, WT, mode, scr, item, f_lane);
        }
    }
    {
        const int gt = F.vcu * (NWAVES * 64) + f_tid, NGT = F.G * NWAVES * 64;
        float* tabA = (float*)(ws + WS_TABA); float* tabB = (float*)(ws + WS_TABB);
        for (int idx = gt; idx < SEQ * 64; idx += NGT) rope_entry(tabA, idx, 64, 0.86596432336006535);
        for (int idx = gt; idx < SEQ * 32; idx += NGT) rope_entry(tabB, idx, 32, 0.74989420933245582);
        float* bp = (float*)(ws + WS_BPERM);
        for (int idx = gt; idx < 2 * NQKV_B; idx += NGT) { const int j = idx / NQKV_B, n = idx % NQKV_B;
            int src = n; if (n < 2304) { const int p = n & 63; src = (n & ~63) + (p >> 1) + 32 * (p & 1); }
            bp[idx] = ap->in[18][(size_t)j * NQKV_B + src]; }
    }
}
__device__ __forceinline__ void h0_phase(Frame& F, const float* x, const float* sc, const float* sh, bf16* hb) {
    FR_IDS();
    const int gw = F.vcu * NWAVES + f_wave, NGW = F.G * NWAVES;
    for (int m = gw; m < MTOK; m += NGW) {
        const int b = m / SEQ;
        const GAS f32x4* xr = (const GAS f32x4*)(x + (size_t)m * DM) + f_lane;
        const f32x4* scp = (const f32x4*)(sc + (size_t)b * (NMOD * DM)) + f_lane; const f32x4* shp = (const f32x4*)(sh + (size_t)b * (NMOD * DM)) + f_lane;
        GAS unsigned long long* o8 = (GAS unsigned long long*)(hb + (size_t)m * DM) + f_lane;
#pragma unroll
        for (int j = 0; j < 8; ++j) { const f32x4 v = xr[64 * j] * (scp[64 * j] + 1.0f) + shp[64 * j];
            o8[64 * j] = (unsigned long long)pk2(v.x, v.y) | ((unsigned long long)pk2(v.z, v.w) << 32); }
    }
}
__device__ __forceinline__ void ln_phase(Frame& F, const float* vin, float* xout, const float* g, const float* bln, const float* sc, const float* sh, bf16* hb) {
    FR_IDS();
    const int gw = F.vcu * NWAVES + f_wave, NGW = F.G * NWAVES;
    for (int m = gw; m < MTOK; m += NGW) {
        const int b = m / SEQ;
        const GAS f32x4* xr = (const GAS f32x4*)(vin + (size_t)m * DM) + f_lane;
        f32x4 v[8]; float s = 0.f;
#pragma unroll
        for (int j = 0; j < 8; ++j) { v[j] = xr[64 * j]; s += (v[j].x + v[j].y) + (v[j].z + v[j].w); }
        const float mean = wave_sum(s) * (1.f / DM); float s2 = 0.f;
#pragma unroll
        for (int j = 0; j < 8; ++j) { v[j] = v[j] - mean; s2 += (v[j].x * v[j].x + v[j].y * v[j].y) + (v[j].z * v[j].z + v[j].w * v[j].w); }
        const float rstd = 1.f / sqrtf(wave_sum(s2) * (1.f / DM) + LN_EPS);
        const f32x4* gp = (const f32x4*)g + f_lane; const f32x4* bp = (const f32x4*)bln + f_lane;
        GAS f32x4* xo = (GAS f32x4*)(xout + (size_t)m * DM) + f_lane;
#pragma unroll
        for (int j = 0; j < 8; ++j) { v[j] = v[j] * rstd * gp[64 * j] + bp[64 * j]; xo[64 * j] = v[j]; }
        if (hb) {
            const f32x4* scp = (const f32x4*)(sc + (size_t)b * (NMOD * DM)) + f_lane; const f32x4* shp = (const f32x4*)(sh + (size_t)b * (NMOD * DM)) + f_lane;
            GAS unsigned long long* o8 = (GAS unsigned long long*)(hb + (size_t)m * DM) + f_lane;
#pragma unroll
            for (int j = 0; j < 8; ++j) { const f32x4 h = v[j] * (scp[64 * j] + 1.0f) + shp[64 * j];
                o8[64 * j] = (unsigned long long)pk2(h.x, h.y) | ((unsigned long long)pk2(h.z, h.w) << 32); }
        }
    }
}
__device__ __forceinline__ void combine_phase(Frame& F, const bf16* AO, bf16* AC, const float* lq1, const float* lk1, const float* lq2, const float* lk2, const float* gsub, float lam_init) {
    FR_IDS();
    const float d1 = wave_sum(lq1[f_lane] * lk1[f_lane] + lq1[f_lane + 64] * lk1[f_lane + 64]);
    const float d2 = wave_sum(lq2[f_lane] * lk2[f_lane] + lq2[f_lane + 64] * lk2[f_lane + 64]);
    const float lam = expf(d1) - expf(d2) + lam_init;
    const f32x4 gs = *((const f32x4*)gsub + f_lane) * (1.0f - lam_init);
    const int gw = F.vcu * NWAVES + f_wave, NGW = F.G * NWAVES;
    for (int m = gw; m < MTOK; m += NGW) {
        const GAS unsigned long long* ip = (const GAS unsigned long long*)(AO + (size_t)m * (2 * DM)) + f_lane;
        GAS unsigned long long* op = (GAS unsigned long long*)(AC + (size_t)m * DM) + f_lane;
        unsigned long long r1[8], r2[8];
#pragma unroll
        for (int h = 0; h < 8; ++h) { r1[h] = ip[(2 * h) * 64]; r2[h] = ip[(2 * h + 1) * 64]; }
#pragma unroll
        for (int h = 0; h < 8; ++h) {
            f32x4 d;
            d.x = bf2f((unsigned short)(r1[h])) - lam * bf2f((unsigned short)(r2[h]));
            d.y = bf2f((unsigned short)(r1[h] >> 16)) - lam * bf2f((unsigned short)(r2[h] >> 16));
            d.z = bf2f((unsigned short)(r1[h] >> 32)) - lam * bf2f((unsigned short)(r2[h] >> 32));
            d.w = bf2f((unsigned short)(r1[h] >> 48)) - lam * bf2f((unsigned short)(r2[h] >> 48));
            const float ss = wave_sum((d.x * d.x + d.y * d.y) + (d.z * d.z + d.w * d.w));
            const float r = 1.f / sqrtf(ss * (1.f / 256.f) + LN_EPS);
            const f32x4 o = d * r * gs;
            op[h * 64] = (unsigned long long)pk2(o.x, o.y) | ((unsigned long long)pk2(o.z, o.w) << 32);
        }
    }
}
typedef attA::bf16 abf;
typedef attA::BlockRef<abf, abf> ARef;
__device__ __forceinline__ ARef attA_ref(const bf16* QKV, bf16* AO, int L, int pass) {
    const int k = L >> 3, xcd = L & 7, gi = k >> 5, r = k & 31;
    const int grp = gi * 8 + xcd, b = grp >> 3, hp = grp & 7;
    const int hq = 2 * hp + (r & 1), vh = (r >> 1) & 1, x = r >> 2;
    const int qb = pass ? 15 - x : x;
    const abf* base = (const abf*)QKV + (size_t)b * SEQ * NQKV_A;
    ARef R; R.Q = base + (size_t)qb * 256 * NQKV_A + hq * 128; R.K = base + DM + hq * 128; R.V = base + 2 * DM + hp * 256 + vh * 128;
    R.O = (abf*)AO + ((size_t)b * SEQ + (size_t)qb * 256) * (2 * DM) + hq * 256 + vh * 128; R.P0 = qb * 256;
    return R;
}
__device__ __forceinline__ void attnA_phase(char* lds, const bf16* QKV, bf16* AO) {
    const int total = 1024, stride = (int)gridDim.x;
    int L = blockIdx.x; if (L >= total) return;
    int pass = 0;
    ARef cur = attA_ref(QKV, AO, L, 0);
    attA::Seam<abf> S;
    attA::causal_swa_prime<abf, abf>(cur, SEQ, lds, S);
    for (;;) {
        const bool more_pass = pass == 0, more_item = L + stride < total, last = !more_pass && !more_item;
        int passn = pass + 1, Ln = L;
        if (!more_pass) { passn = 0; Ln = more_item ? L + stride : L; }
        const ARef nxt = last ? cur : attA_ref(QKV, AO, Ln, passn);
        attA::causal_swa_block<abf, abf>(cur, nxt, SEQ, SEQ, lds, S);
        if (last) break;
        cur = nxt; pass = passn; L = Ln;
    }
}
__device__ __forceinline__ void attnB_phase(Frame& F, const bf16* QKV, const float* sinks, bf16* AC) {
    for (int u = F.vcu; u < NB * 4 * 32; u += F.G) { const int n = u & 31, kvh = (u >> 5) & 3, b = u >> 7;
        attB::swa_unit(b, kvh, n, QKV, sinks, AC, F.lds); }
    __syncthreads();
}

#ifndef SITES
#define SITES 0xffff
#endif
__device__ __forceinline__ CArgs* kargs() { CArgs* p = (CArgs*)__builtin_amdgcn_kernarg_segment_ptr(); asm volatile("" : "+s"(p)); return p; }
#define AIN(i) (kargs()->in[i])
#define WSP(off) (kargs()->ws + (off))
__global__ void __launch_bounds__(NWAVES * 64, 2) fwd_kernel(Args args_unused) {
    extern __shared__ __attribute__((aligned(16))) unsigned char lds[];
    Frame F;
    F.lds = (LAS unsigned char*)lds;
    F.MISC = (volatile LAS unsigned*)(F.lds + MISC_OFF);
    F.G = gridDim.x; { const int bx = blockIdx.x; F.vcu = (F.G % 8 == 0) ? (bx % 8) * (F.G / 8) + bx / 8 : bx; }
    F.ctl = (gu32*)WSP(WS_CTL);
    for (int u = threadIdx.x; u < (LDS_BYTES - LDSCTL_OFF) / 4; u += NWAVES * 64) ((LAS unsigned*)(F.lds + LDSCTL_OFF))[u] = 0u;
    __syncthreads();
    const int lo = kargs()->ph_lo, hi = kargs()->ph_hi;
    XcdBarrier bar; bar.bar = (unsigned*)(F.ctl + CW_BAR); bar.x = 0; bar.st = nullptr;
    if (hi - lo > 1) bar = xcd_barrier_post((unsigned*)(F.ctl + CW_BAR), F.MISC + 8);
#define IN(k) (lo <= (k) && (k) < hi)
#define SEAM(k) do { if ((k) + 1 < hi) xcd_barrier(bar); } while (0)

#define MOD_ ((float*)WSP(WS_MOD))
#define X_ ((float*)WSP(WS_X))
#define HB_ ((bf16*)WSP(WS_HB))
#define QKV_ ((bf16*)WSP(WS_QKV))
#define AO_ ((bf16*)WSP(WS_AO))
#define AC_ ((bf16*)WSP(WS_AC))
#define HID_ ((bf16*)WSP(WS_HID))
    constexpr size_t MODL = (size_t)NB * NMOD * DM;
    constexpr int MODB = NMOD * DM;

#if SITES & 1
    if (IN(0)) { p0_prologue(F, kargs()); SEAM(0); }
#endif
#if SITES & 4096
    if (IN(1)) { h0_phase(F, AIN(0), MOD_ + 1 * DM, MOD_ + 0 * DM, HB_); SEAM(1); }
#endif

    for (int L = 0; L < DEPTH; ++L) {
        const int pb = 2 + 8 * L, j = L >> 1;
#define MODL_ (MOD_ + (size_t)L * MODL)
        if ((L & 1) == 0) {
#if SITES & 8
            if (IN(pb + 0)) {
                pg8::Gemm g{HB_, (const bf16*)WSP(WS_WQKVA + j * WS_WA_STRIDE), MTOK, NQKV_A, DM}; pg8::StaticOrder S; S.init(MTOK, NQKV_A, F.G, (int)blockIdx.x);
                pg8::EpiQKV<128> E{QKV_, NQKV_A, nullptr, (const float*)WSP(WS_TABA), 16, SEQ - 1};
                pg8::gemm_phase<pg8::EpiQKV<128>, pg8::StaticOrder, true, true>(F.lds + RING_OFF, g, S, E);
                SEAM(pb + 0);
            }
#endif
#if SITES & 2
            if (IN(pb + 1)) { attnA_phase((char*)lds + RING_OFF, QKV_, AO_); SEAM(pb + 1); }
#endif
#if SITES & 512
            if (IN(pb + 2)) {
                const float lam_init = (L == 0) ? 0.2f : 0.47071301658633585f;
                combine_phase(F, AO_, AC_, AIN(12) + j * 128, AIN(13) + j * 128, AIN(14) + j * 128, AIN(15) + j * 128, AIN(16) + j * 256, lam_init);
                SEAM(pb + 2);
            }
#endif
#if SITES & 16
            if (IN(pb + 3)) {
                pg8::Gemm g{AC_, (const bf16*)WSP(WS_WOA + j * WS_WA_STRIDE), MTOK, DM, DM}; pg8::StaticOrder S; S.init(MTOK, DM, F.G, (int)blockIdx.x);
                pg8::EpiResid E{L == 0 ? AIN(0) : (const float*)X_, X_, DM, MODL_ + 2 * DM, MODB, nullptr, ALPHA, 12};
                pg8::gemm_phase<pg8::EpiResid, pg8::StaticOrder, true, true>(F.lds + RING_OFF, g, S, E);
                SEAM(pb + 3);
            }
#endif
        } else {
#if SITES & 32
            if (IN(pb + 0)) {
                pg8::Gemm g{HB_, (const bf16*)WSP(WS_WQKVB + j * WS_WB_STRIDE), MTOK, NQKV_B, DM}; pg8::StaticOrder S; S.init(MTOK, NQKV_B, F.G, (int)blockIdx.x);
                pg8::EpiQKV<64> E{QKV_, NQKV_B, (const float*)WSP(WS_BPERM) + j * NQKV_B, (const float*)WSP(WS_TABB), 9, SEQ - 1};
                pg8::gemm_phase<pg8::EpiQKV<64>, pg8::StaticOrder, true, true>(F.lds + RING_OFF, g, S, E);
                SEAM(pb + 0);
            }
#endif
#if SITES & 4
            if (IN(pb + 1)) { attnB_phase(F, QKV_, AIN(19) + j * 32, AC_); SEAM(pb + 1); }
#endif
#if SITES & 64
            if (IN(pb + 3)) {
                pg8::Gemm g{AC_, (const bf16*)WSP(WS_WOB + j * WS_WB_STRIDE), MTOK, DM, DM}; pg8::StaticOrder S; S.init(MTOK, DM, F.G, (int)blockIdx.x);
                pg8::EpiResid E{X_, X_, DM, MODL_ + 2 * DM, MODB, AIN(21) + j * DM, ALPHA, 12};
                pg8::gemm_phase<pg8::EpiResid, pg8::StaticOrder, true, true>(F.lds + RING_OFF, g, S, E);
                SEAM(pb + 3);
            }
#endif
        }
#if SITES & 1024
        if (IN(pb + 4)) { ln_phase(F, X_, X_, AIN(4) + L * DM, AIN(5) + L * DM, MODL_ + 4 * DM, MODL_ + 3 * DM, HB_); SEAM(pb + 4); }
#endif
#if SITES & 128
        if (IN(pb + 5)) {
            pg8::Gemm g{HB_, (const bf16*)WSP(WS_WUP + L * WS_WMLP_STRIDE), MTOK, DFF, DM}; pg8::StaticOrder S; S.init(MTOK, DFF, F.G, (int)blockIdx.x);
            pg8::EpiRelu2 E{HID_, DFF};
            pg8::gemm_phase<pg8::EpiRelu2, pg8::StaticOrder, true, true>(F.lds + RING_OFF, g, S, E);
            SEAM(pb + 5);
        }
#endif
#if SITES & 256
        if (IN(pb + 6)) {
            pg8::Gemm g{HID_, (const bf16*)WSP(WS_WDN + L * WS_WMLP_STRIDE), MTOK, DM, DFF}; pg8::StaticOrder S; S.init(MTOK, DM, F.G, (int)blockIdx.x);
            pg8::EpiResid E{X_, X_, DM, MODL_ + 5 * DM, MODB, nullptr, ALPHA, 12};
            pg8::gemm_phase<pg8::EpiResid, pg8::StaticOrder, true, true>(F.lds + RING_OFF, g, S, E);
            SEAM(pb + 6);
        }
#endif
#if SITES & 2048
        if (IN(pb + 7)) {
            const bool lastL = (L == DEPTH - 1);
            ln_phase(F, X_, lastL ? kargs()->out : X_, AIN(6) + L * DM, AIN(7) + L * DM, MODL_ + MODL + 1 * DM, MODL_ + MODL + 0 * DM, lastL ? (bf16*)nullptr : HB_);
            SEAM(pb + 7);
        }
#endif
    }
#undef IN
#undef SEAM
}

extern "C" void kernel_launch(void* const* d_in, const int* in_sizes, int n_in, void* d_out, int out_size, void* d_ws, size_t ws_size, hipStream_t stream) {
    static int grid = 0;
    if (grid == 0) {
        if (n_in != 22 || in_sizes[0] != MTOK * DM || out_size != MTOK * DM || ws_size < WS_END) {
            fprintf(stderr, "kernel_launch: unexpected shapes (n_in %d, in0 %d, out %d, ws %zu; need ws >= %zu); nothing launched\n", n_in, n_in > 0 ? in_sizes[0] : -1, out_size, ws_size, (size_t)WS_END); grid = -1; return; }
        int dev = 0, cus = 0, per_cu = 0;
        if (hipGetDevice(&dev) != hipSuccess || hipDeviceGetAttribute(&cus, hipDeviceAttributeMultiprocessorCount, dev) != hipSuccess) { fprintf(stderr, "kernel_launch: device query failed\n"); grid = -1; return; }
        if (hipFuncSetAttribute((const void*)fwd_kernel, hipFuncAttributeMaxDynamicSharedMemorySize, LDS_BYTES) != hipSuccess) { fprintf(stderr, "kernel_launch: hipFuncSetAttribute failed\n"); grid = -1; return; }
        if (hipOccupancyMaxActiveBlocksPerMultiprocessor(&per_cu, (const void*)fwd_kernel, NWAVES * 64, LDS_BYTES) != hipSuccess || per_cu < 1)
            fprintf(stderr, "kernel_launch: note: occupancy query reports %d workgroups per CU\n", per_cu);
        (void)hipGetLastError();
        grid = cus;
    }
    if (grid < 0) return;
    if (hipMemsetAsync((char*)d_ws + WS_CTL, 0, CTL_ZERO_BYTES, stream) != hipSuccess) { fprintf(stderr, "kernel_launch: memset failed\n"); return; }
    Args a{};
    for (int i = 0; i < 22; ++i) a.in[i] = (const float*)d_in[i];
    a.out = (float*)d_out; a.ws = (unsigned char*)d_ws;
#if MK_PER_PHASE
    for (int p = 0; p < N_PHASES; ++p) {
        if (p >= 2 && ((p - 2) & 7) == 2 && (((p - 2) >> 3) & 1)) continue;
        a.ph_lo = p; a.ph_hi = p + 1;
        hipLaunchKernelGGL(fwd_kernel, dim3(grid), dim3(NWAVES * 64), LDS_BYTES, stream, a);
    }
#else
    a.ph_lo = 0; a.ph_hi = N_PHASES;
    hipLaunchKernelGGL(fwd_kernel, dim3(grid), dim3(NWAVES * 64), LDS_BYTES, stream, a);
#endif
    const hipError_t le = hipPeekAtLastError();
    if (le != hipSuccess) fprintf(stderr, "kernel_launch: launch failed: %s\n", hipGetErrorName(le));
}
```

```cpp
#include <hip/hip_runtime.h>
#include <hip/hip_bf16.h>
#include <cstdio>
#include <cstdint>

constexpr int DM = 2048, NB = 4, SEQ = 4096, DEPTH = 4, MTOK = NB * SEQ, DFF = 8192;
constexpr int NQKV_A = 3 * DM;
constexpr int NQKV_B = 2560;
constexpr float LN_EPS = 1e-5f;
constexpr float ALPHA = 1.681792830507429f;
constexpr int NMOD = 6;
__device__ __forceinline__ int opaque_tid() { int t = (int)threadIdx.x; asm volatile("" : "+v"(t)); return t; }
#ifndef PG8_RELAX
#define PG8_RELAX 0
#endif
#ifndef CONV_PROBE
#define CONV_PROBE 0
#endif
#ifndef PROBE_WG
#define PROBE_WG 0
#endif
#ifndef DATAFLOW
#define DATAFLOW 1
#endif
#ifndef FOLD2_AT_C0
#define FOLD2_AT_C0 1
#endif
#ifndef L0_DOWN_GLOBAL
#define L0_DOWN_GLOBAL 0
#endif
#ifndef XCC_ALIGN
#define XCC_ALIGN 0
#endif
#ifndef QKV_DATAFLOW
#define QKV_DATAFLOW 0
#endif
#ifndef L0_ATT_GLOBAL
#define L0_ATT_GLOBAL 1
#endif
#ifndef CONV_DEFER
#define CONV_DEFER 1
#endif
#ifndef ATTA_FULLV
#define ATTA_FULLV 1
#endif
template <int K> __device__ __forceinline__ float lane_xor(float v) {
    if constexpr (K == 32) { const auto rr = __builtin_amdgcn_permlane32_swap(__float_as_uint(v), __float_as_uint(v), false, false);
        return __uint_as_float(((opaque_tid() & 32) ? rr[0] : rr[1])); }
    else return __uint_as_float((unsigned)__builtin_amdgcn_ds_swizzle((int)__float_as_uint(v), (K << 10) | 0x1F));
}
__device__ __forceinline__ float half_sum32(float v) { const auto rr = __builtin_amdgcn_permlane32_swap(__float_as_uint(v), __float_as_uint(v), false, false); return __uint_as_float(rr[0]) + __uint_as_float(rr[1]); }
__device__ __forceinline__ float half_max32(float v) { const auto rr = __builtin_amdgcn_permlane32_swap(__float_as_uint(v), __float_as_uint(v), false, false); return fmaxf(__uint_as_float(rr[0]), __uint_as_float(rr[1])); }
typedef unsigned wt_u32x4 __attribute__((ext_vector_type(4)));
__device__ __forceinline__ void store16_wt(void* p, wt_u32x4 v) { asm volatile("global_store_dwordx4 %0, %1, off sc1\n\ts_nop 1" :: "v"(p), "v"(v) : "memory"); }
__device__ __forceinline__ void store4_wt(void* p, unsigned v) { asm volatile("global_store_dword %0, %1, off sc1\n\ts_nop 1" :: "v"(p), "v"(v) : "memory"); }

#define GAS __attribute__((address_space(1)))
#define LAS __attribute__((address_space(3)))
typedef unsigned short bf16;
typedef unsigned v4u __attribute__((ext_vector_type(4)));
typedef float f32x4 __attribute__((ext_vector_type(4)));
typedef short bf16x8 __attribute__((ext_vector_type(8)));
typedef GAS unsigned gu32;
typedef GAS unsigned long long gu64;
#define RLX_AGENT __ATOMIC_RELAXED, __HIP_MEMORY_SCOPE_AGENT
#define LDS_WAIT() asm volatile("s_waitcnt lgkmcnt(0)" ::: "memory")
#define VM_WAIT() asm volatile("s_waitcnt vmcnt(0)" ::: "memory")
__device__ __forceinline__ unsigned long long rt() { return __builtin_amdgcn_s_memrealtime(); }
__device__ __forceinline__ unsigned f2bf(float f) { unsigned u = __builtin_bit_cast(unsigned, f); return (u + 0x7fffu + ((u >> 16) & 1u)) >> 16; }
__device__ __forceinline__ unsigned pk2(float lo, float hi) { return f2bf(lo) | (f2bf(hi) << 16); }

#define XB_TMO      128
#define XB_XCNT(j)  (256  + 64 * (j))
#define XB_XSUB(j)  (1280 + 64 * (j))
#define XB_XGEN(j)  (2304 + 64 * (j))
#define XB_TOP      3328
#define XB_TOPGEN   3392
#define XCD_BAR_WORDS 3456
#define XB_SPIN_CAP (1u << 18)

__device__ __forceinline__ unsigned xb_ld(unsigned* p)              { return __hip_atomic_load(p, __ATOMIC_RELAXED, __HIP_MEMORY_SCOPE_AGENT); }
__device__ __forceinline__ unsigned xb_add(unsigned* p, unsigned v) { return __hip_atomic_fetch_add(p, v, __ATOMIC_RELAXED, __HIP_MEMORY_SCOPE_AGENT); }
__device__ __forceinline__ unsigned xb_xcc_id() { return (unsigned)__builtin_amdgcn_s_getreg((3 << 11) | 20) & 0xFu; }
#define XB_SPIN(cond, bar) do { unsigned _sp = 0; while (cond) { __builtin_amdgcn_s_sleep(1); \
    if ((++_sp & 255u) == 0u) { if (xb_ld(&(bar)[XB_TMO])) break; if (_sp > XB_SPIN_CAP) { atomicAdd(&(bar)[XB_TMO], 1u); break; } } } } while (0)

struct XcdBarrier {
    unsigned* bar; unsigned x;
    volatile LAS unsigned* st;
};

__device__ __forceinline__ XcdBarrier xcd_barrier_post(unsigned* bar, volatile LAS unsigned* st) {
    XcdBarrier b; b.bar = bar; b.x = xb_xcc_id(); b.st = st;
    if (threadIdx.x == 0) (void)xb_add(&bar[XB_XCNT(b.x)], 1u);
    return b;
}
__device__ __forceinline__ void xcd_barrier_complete(unsigned* bar, unsigned x, unsigned& nloc, unsigned& nx) {
    const unsigned G = gridDim.x * gridDim.y * gridDim.z;
    unsigned sum, cnt, mine, sp = 0u;
    for (;;) {
        sum = 0u; cnt = 0u; mine = 0u;
#pragma unroll
        for (unsigned j = 0; j < 16; ++j) { const unsigned c = xb_ld(&bar[XB_XCNT(j)]); sum += c; cnt += (c > 0u) ? 1u : 0u; mine = (j == x) ? c : mine; }
        if (sum == G) break;
        __builtin_amdgcn_s_sleep(1);
        if ((++sp & 255u) == 0u) { if (xb_ld(&bar[XB_TMO])) break; if (sp > XB_SPIN_CAP) { atomicAdd(&bar[XB_TMO], 1u); break; } }
    }
    nloc = mine > 0u ? mine : 1u; nx = cnt > 0u ? cnt : 1u;
}

__device__ __forceinline__ void xcd_barrier(const XcdBarrier& b) {
    asm volatile("s_waitcnt vmcnt(0)" ::: "memory");
    __syncthreads();
    if (threadIdx.x == 0) {
        unsigned* bar = b.bar;
        __builtin_amdgcn_s_waitcnt(0);
        unsigned nloc = b.st[0], nx = b.st[1];
        unsigned bx = b.x; asm volatile("" : "+s"(bx));
        if (nloc == 0u) { xcd_barrier_complete(bar, bx, nloc, nx); b.st[0] = nloc; b.st[1] = nx; }
        const unsigned old = xb_add(&bar[XB_XSUB(bx)], 1u);
        const unsigned gen = old / nloc;
        if (old + 1u == (gen + 1u) * nloc) {
            __builtin_amdgcn_fence(__ATOMIC_RELEASE, "agent");
            asm volatile("s_waitcnt vmcnt(0)" ::: "memory");
            const unsigned og = xb_add(&bar[XB_TOP], 1u);
            const unsigned tg = og / nx;
            if (og + 1u == (tg + 1u) * nx) xb_add(&bar[XB_TOPGEN], 1u);
            else XB_SPIN(xb_ld(&bar[XB_TOPGEN]) == tg, bar);
            __builtin_amdgcn_fence(__ATOMIC_ACQUIRE, "agent");
            xb_add(&bar[XB_XGEN(bx)], 1u);
            asm volatile("s_waitcnt vmcnt(0)" ::: "memory");
        } else {
            XB_SPIN(xb_ld(&bar[XB_XGEN(bx)]) == gen, bar);
            __builtin_amdgcn_fence(__ATOMIC_ACQUIRE, "agent");
            asm volatile("s_waitcnt vmcnt(0)" ::: "memory");
        }
    }
    __syncthreads();
}

namespace pg8 {
#define PG8_LAS __attribute__((address_space(3)))
typedef unsigned short bf16_t;
typedef short bf16x8 __attribute__((ext_vector_type(8)));
typedef float f32x4 __attribute__((ext_vector_type(4)));
typedef unsigned u32x4 __attribute__((ext_vector_type(4)));
constexpr int BM = 256, BK = 64, HALF = 128, HTB = HALF * BK * 2  , STAGE_BYTES = 8 * HTB, NXCD = 8, WGM = 8;

__host__ __device__ __forceinline__ int lds_byte(int r, int c) { const int st = (r >> 4) * 2 + (c >> 5), rr = r & 15, cc = c & 31, ob = rr * 64 + cc * 2; return st * 1024 + (ob ^ (((ob >> 9) & 1) << 5)); }
__host__ __device__ __forceinline__ void stage_rc(int b, int& R, int& C) { const int st = b / 1024, sb = b % 1024, swz = sb ^ (((sb >> 9) & 1) << 5); R = (st >> 1) * 16 + swz / 64; C = (st & 1) * 32 + (swz % 64) / 2; }
__host__ __device__ __forceinline__ int perm32(int rho) { const int n = rho >> 4, i = rho & 15; return 8 * (i >> 2) + 4 * n + (i & 3); }

struct Unit { int pm, pn; };
struct Gemm { const bf16_t* A; const bf16_t* Bt; int M, N, K; unsigned long long* probe = nullptr; };

struct StaticOrder {
    int nM, nN, nwg, G, c;
    __host__ __device__ void init(int M, int N, int G_, int c_) { nM = M / BM; nN = N / BM; nwg = nM * nN; G = G_; c = c_; }
    __host__ __device__ bool next(int i, Unit& u) const {
        const long L = (long)i * G + c; if (L >= nwg) return false;
        int wgid = (int)L; { const int q = nwg / NXCD, r = nwg % NXCD, xcd = wgid % NXCD, off = wgid / NXCD; wgid = (xcd < r ? xcd * (q + 1) : r * (q + 1) + (xcd - r) * q) + off; }
        const int nig = WGM * nN, gid = wgid / nig, fm = gid * WGM, gsz = (nM - fm) < WGM ? (nM - fm) : WGM;
        u.pm = fm + ((wgid % nig) % gsz); u.pn = (wgid % nig) / gsz; return true;
    }
    __device__ __forceinline__ void a_ready(const Unit&) const {}
    __device__ __forceinline__ void done(const Unit&) const {}
};

__device__ __forceinline__ unsigned cvt_pk_bf16(float lo, float hi) { unsigned r; asm volatile("v_cvt_pk_bf16_f32 %0, %1, %2" : "=v"(r) : "v"(lo), "v"(hi)); return r; }
typedef float f32x2 __attribute__((ext_vector_type(2)));

typedef float f32x2v __attribute__((ext_vector_type(2)));
typedef unsigned u32x2v __attribute__((ext_vector_type(2)));
constexpr float kInvD = 1.0f / 2048.0f, kEps = 1e-5f;
__device__ __forceinline__ void row_mu_r(const float* st, int row, float& mu, float& r) {
    const f32x4* p = (const f32x4*)(st + 16 * (size_t)row); const f32x4 a = p[0], b = p[1], c = p[2], d = p[3];
    const float s = ((a[0] + a[2]) + (b[0] + b[2])) + ((c[0] + c[2]) + (d[0] + d[2])), q = ((a[1] + a[3]) + (b[1] + b[3])) + ((c[1] + c[3]) + (d[1] + d[3]));
    mu = s * kInvD; const float var = fmaxf(q * kInvD - mu * mu, 0.f); r = __builtin_amdgcn_rsqf(var + kEps);
}
__device__ __forceinline__ void stage_mu_r(PG8_LAS f32x2v* mr, const float* st, int pm, int t) {
    if (t < 256) { float mu, r; row_mu_r(st, pm * BM + t, mu, r); mr[t] = (f32x2v){mu, r}; }
    asm volatile("s_waitcnt lgkmcnt(0)" ::: "memory"); __builtin_amdgcn_s_barrier(); asm volatile("" ::: "memory");
}
__device__ __forceinline__ u32x4 pack_bf16x8(const f32x4 v0, const f32x4 v1) { u32x4 w; w.x = cvt_pk_bf16(v0[0], v0[1]); w.y = cvt_pk_bf16(v0[2], v0[3]); w.z = cvt_pk_bf16(v1[0], v1[1]); w.w = cvt_pk_bf16(v1[2], v1[3]); return w; }
template <int HD> struct EpiQKV {
    static constexpr bool PERM = true, AFTER_DRAIN = false; static constexpr int NSTORES = 16;
    bf16_t* O; int ldc; const float* bias; const float* tab; const float* ident; int rope_tiles; int seq_mask;
    const float* st; const float* cs; const float* cb; int cstride; int seq_shift; PG8_LAS float* mrt; int staged_pm;
    __device__ __forceinline__ void operator()(f32x4 (&acc)[2][2][4][2], const Unit& u, int wr, int wc, int fr, int fq) const {
        asm volatile("" : "+v"(fr), "+v"(fq));
        const int row0 = u.pm * BM + wr * 64 + fr, col0 = u.pn * BM + wc * 32 + 8 * fq, lrow0 = wr * 64 + fr;
        PG8_LAS f32x2v* mr = (PG8_LAS f32x2v*)mrt; (void)staged_pm;
        const bool rope = u.pn < rope_tiles;
        const char* tbase = rope ? (const char*)tab : (const char*)ident; const unsigned tmul = rope ? (unsigned)(HD * 4) : 0u;
        const size_t cofs = (size_t)((u.pm * BM) >> seq_shift) * cstride + col0;
#pragma unroll
        for (int bj = 0; bj < 2; ++bj) {
            f32x4 bv[2], cbv[2], csv[2];
#pragma unroll
            for (int n = 0; n < 2; ++n) { bv[n] = *(const f32x4*)(bias + col0 + bj * HALF + 4 * n); cbv[n] = *(const f32x4*)(cb + cofs + bj * HALF + 4 * n); csv[n] = *(const f32x4*)(cs + cofs + bj * HALF + 4 * n); }
            const unsigned tcol = rope ? (unsigned)(((col0 + bj * HALF) & (HD - 1)) >> 1) * 8u : 0u;
#pragma unroll
            for (int ai = 0; ai < 2; ++ai) {
                f32x4 tb[4][2];
#pragma unroll
                for (int m = 0; m < 4; ++m) { const unsigned tof = (unsigned)((row0 + ai * HALF + m * 16) & seq_mask) * tmul + tcol;
                    tb[m][0] = *(const f32x4*)(tbase + tof); tb[m][1] = *(const f32x4*)(tbase + tof + 16u); }
                asm volatile("" : "+v"(tb[0][0]), "+v"(tb[0][1]), "+v"(tb[1][0]), "+v"(tb[1][1]), "+v"(tb[2][0]), "+v"(tb[2][1]), "+v"(tb[3][0]), "+v"(tb[3][1]));
                if (ai == 0) { bv[0] += cbv[0]; bv[1] += cbv[1]; }
#pragma unroll
                for (int m = 0; m < 4; ++m) { const f32x2v q = mr[lrow0 + ai * HALF + m * 16]; const float mu = q.x, r = q.y;
                    const f32x4 v0 = (acc[ai][bj][m][0] - csv[0] * mu) * r + bv[0], v1 = (acc[ai][bj][m][1] - csv[1] * mu) * r + bv[1];
                    const f32x4 t0 = tb[m][0], t1 = tb[m][1];
                    acc[ai][bj][m][0] = (f32x4){v0[0] * t0[0] - v0[1] * t0[1], v0[1] * t0[0] + v0[0] * t0[1], v0[2] * t0[2] - v0[3] * t0[3], v0[3] * t0[2] + v0[2] * t0[3]};
                    acc[ai][bj][m][1] = (f32x4){v1[0] * t1[0] - v1[1] * t1[1], v1[1] * t1[0] + v1[0] * t1[1], v1[2] * t1[2] - v1[3] * t1[3], v1[3] * t1[2] + v1[2] * t1[3]}; }
                asm volatile("" : "+v"(acc[ai][bj][0][0]), "+v"(acc[ai][bj][0][1]), "+v"(acc[ai][bj][1][0]), "+v"(acc[ai][bj][1][1]), "+v"(acc[ai][bj][2][0]), "+v"(acc[ai][bj][2][1]), "+v"(acc[ai][bj][3][0]), "+v"(acc[ai][bj][3][1]) :: "memory");
            }
        }
#pragma unroll
        for (int ai = 0; ai < 2; ++ai)
#pragma unroll
            for (int m = 0; m < 4; ++m) { bf16_t* rowp = O + (size_t)(row0 + ai * HALF + m * 16) * ldc + col0;
#pragma unroll
                for (int bj = 0; bj < 2; ++bj) { const u32x4 w_ = pack_bf16x8(acc[ai][bj][m][0], acc[ai][bj][m][1]);
                    if (QKV_DATAFLOW) store16_wt(rowp + bj * HALF, w_); else *(u32x4*)(rowp + bj * HALF) = w_; } }
    }
};
struct EpiRelu2 {
    static constexpr bool PERM = true, AFTER_DRAIN = false; static constexpr int NSTORES = 16;
    bf16_t* O; int ldc; const float* st; const float* cs; const float* cb; int cstride; int seq_shift; PG8_LAS float* mrt; int staged_pm; bf16_t* dup;
    __device__ __forceinline__ void operator()(f32x4 (&acc)[2][2][4][2], const Unit& u, int wr, int wc, int fr, int fq) const {
        asm volatile("" : "+v"(fr), "+v"(fq));
        const int row0 = u.pm * BM + wr * 64 + fr, col0 = u.pn * BM + wc * 32 + 8 * fq, lrow0 = wr * 64 + fr;
        const size_t cofs = (size_t)((u.pm * BM) >> seq_shift) * cstride + col0;
        PG8_LAS f32x2v* mr = (PG8_LAS f32x2v*)mrt; (void)staged_pm;
        f32x4 cbv[2][2], csv[2][2];
#pragma unroll
        for (int bj = 0; bj < 2; ++bj)
#pragma unroll
            for (int n = 0; n < 2; ++n) { cbv[bj][n] = *(const f32x4*)(cb + cofs + bj * HALF + 4 * n); csv[bj][n] = *(const f32x4*)(cs + cofs + bj * HALF + 4 * n); }
        asm volatile("" ::: "memory");
#pragma unroll
        for (int ai = 0; ai < 2; ++ai)
#pragma unroll
            for (int m = 0; m < 4; ++m) { bf16_t* rowp = O + (size_t)(row0 + ai * HALF + m * 16) * ldc + col0; const f32x2v q = mr[lrow0 + ai * HALF + m * 16];
#pragma unroll
                for (int bj = 0; bj < 2; ++bj) { f32x4 v0 = (acc[ai][bj][m][0] - csv[bj][0] * q.x) * q.y + cbv[bj][0], v1 = (acc[ai][bj][m][1] - csv[bj][1] * q.x) * q.y + cbv[bj][1];
#pragma unroll
                    for (int e = 0; e < 4; ++e) { const float a = fmaxf(v0[e], 0.f), b = fmaxf(v1[e], 0.f); v0[e] = a * a; v1[e] = b * b; }
                    { const u32x4 w_ = pack_bf16x8(v0, v1); *(u32x4*)(rowp + bj * HALF) = w_;
#ifdef PROBE_DUPSTORE
                      *(u32x4*)(dup + (size_t)(row0 + ai * HALF + m * 16) * ldc + col0 + bj * HALF) = w_;
#endif
                    } } }
    }
};
struct EpiResid {
    static constexpr bool PERM = true, AFTER_DRAIN = false; static constexpr int NSTORES = 16;
    const bf16_t* rb; const float* ig; int igstride; const float* pst; const float* pg; const float* pb; float* outf; float* st; bf16_t* hb; const float* gn; int gnstride;
    int ldc; const float* gate; int gstride; const float* bias; float alpha; int seq_shift;
    PG8_LAS float* tbl; int staged_pm;
    __device__ __forceinline__ void operator()(f32x4 (&acc)[2][2][4][2], const Unit& u, int wr, int wc, int fr, int fq) const {
        asm volatile("" : "+v"(fr), "+v"(fq));
        const int lrow0 = wr * 64 + fr, col0 = u.pn * BM + wc * 32 + 8 * fq;
        const int b = (u.pm * BM) >> seq_shift, t = (wr * 4 + wc) * 64 + fq * 16 + fr;
        const float* gb = gate + (size_t)b * gstride + col0; const float* gnb = gn + (size_t)b * gnstride + col0; const float* igb = ig + (size_t)b * igstride + col0;
        PG8_LAS f32x2v* mr = (PG8_LAS f32x2v*)tbl; PG8_LAS f32x2v* ps = (PG8_LAS f32x2v*)tbl + 256;
        (void)staged_pm;
        const unsigned rowb = (unsigned)((u.pm * BM + lrow0) * ldc + col0) * 2u;
        const unsigned rstep = (unsigned)ldc * 32u;
#pragma unroll
        for (int bj = 0; bj < 2; ++bj) { const int c = bj * HALF;
            u32x4 xs[2][4];
#pragma unroll
            for (int ai = 0; ai < 2; ++ai)
#pragma unroll
                for (int m = 0; m < 4; ++m) xs[ai][m] = *(const u32x4*)((const char*)rb + (rowb + (unsigned)(ai * 8 + m) * rstep + (unsigned)c * 2u));
            f32x4 gv[2], c1[2], c2[2], c3[2];
#pragma unroll
            for (int n = 0; n < 2; ++n) { gv[n] = *(const f32x4*)(gb + c + 4 * n); c1[n] = *(const f32x4*)(igb + c + 4 * n); c2[n] = *(const f32x4*)(pg + col0 + c + 4 * n);
                c3[n] = *(const f32x4*)(pb + col0 + c + 4 * n); }
            const f32x4 bz0 = *(const f32x4*)(bias + col0 + c), bz1 = *(const f32x4*)(bias + col0 + c + 4);
            asm volatile("" : "+v"(xs[0][0]), "+v"(xs[0][1]), "+v"(xs[0][2]), "+v"(xs[0][3]), "+v"(xs[1][0]), "+v"(xs[1][1]), "+v"(xs[1][2]), "+v"(xs[1][3]));
#pragma unroll
            for (int n = 0; n < 2; ++n) { gv[n] = gv[n] + 1.0f; c1[n] = c1[n] * alpha  ; c2[n] = c2[n] * alpha; c3[n] = c3[n] * alpha + gv[n] * (n ? bz1 : bz0); }
#pragma unroll
            for (int ai = 0; ai < 2; ++ai)
#pragma unroll
                for (int m = 0; m < 4; ++m) { const f32x2v q = mr[lrow0 + ai * HALF + m * 16]; const u32x4 x = xs[ai][m];
                    const f32x4 x0 = {__uint_as_float(x.x << 16), __uint_as_float(x.x & 0xffff0000u), __uint_as_float(x.y << 16), __uint_as_float(x.y & 0xffff0000u)};
                    const f32x4 x1 = {__uint_as_float(x.z << 16), __uint_as_float(x.z & 0xffff0000u), __uint_as_float(x.w << 16), __uint_as_float(x.w & 0xffff0000u)};
                    acc[ai][bj][m][0] = (x0 * c1[0] - c2[0] * q.x) * q.y + c3[0] + gv[0] * acc[ai][bj][m][0];
                    acc[ai][bj][m][1] = (x1 * c1[1] - c2[1] * q.x) * q.y + c3[1] + gv[1] * acc[ai][bj][m][1]; }
            asm volatile("" : "+v"(acc[0][bj][0][0]), "+v"(acc[0][bj][1][0]), "+v"(acc[0][bj][2][0]), "+v"(acc[0][bj][3][0]), "+v"(acc[1][bj][0][0]), "+v"(acc[1][bj][1][0]), "+v"(acc[1][bj][2][0]), "+v"(acc[1][bj][3][0]),
                              "+v"(acc[0][bj][0][1]), "+v"(acc[0][bj][1][1]), "+v"(acc[0][bj][2][1]), "+v"(acc[0][bj][3][1]), "+v"(acc[1][bj][0][1]), "+v"(acc[1][bj][1][1]), "+v"(acc[1][bj][2][1]), "+v"(acc[1][bj][3][1]) :: "memory");
        }
        unsigned rowb2 = rowb; asm volatile("" : "+v"(rowb2));
#pragma unroll
        for (int ai = 0; ai < 2; ++ai)
#pragma unroll
            for (int m = 0; m < 4; ++m) { const int lrow = lrow0 + ai * HALF + m * 16;
                float s_ = 0.f, q_ = 0.f;
#pragma unroll
                for (int bj = 0; bj < 2; ++bj)
#pragma unroll
                    for (int n = 0; n < 2; ++n) { const f32x4 v = acc[ai][bj][m][n]; s_ += (v[0] + v[1]) + (v[2] + v[3]); q_ += (v[0] * v[0] + v[1] * v[1]) + (v[2] * v[2] + v[3] * v[3]); }
                s_ += lane_xor<16>(s_); s_ = half_sum32(s_); q_ += lane_xor<16>(q_); q_ = half_sum32(q_);
                if (fq == 0) ps[lrow * 4 + wc] = (f32x2v){s_, q_}; }
        if (hb) {
            f32x4 gnv[2][2];
#pragma unroll
            for (int bj = 0; bj < 2; ++bj)
#pragma unroll
                for (int n = 0; n < 2; ++n) gnv[bj][n] = *(const f32x4*)(gnb + bj * HALF + 4 * n);
#pragma unroll
            for (int ai = 0; ai < 2; ++ai)
#pragma unroll
                for (int m = 0; m < 4; ++m) { const unsigned ob = rowb2 + (unsigned)(ai * 8 + m) * rstep;
#pragma unroll
                    for (int bj = 0; bj < 2; ++bj) *(u32x4*)((char*)hb + (ob + (unsigned)bj * 256u)) = pack_bf16x8(acc[ai][bj][m][0] * gnv[bj][0], acc[ai][bj][m][1] * gnv[bj][1]); }
        } else {
#pragma unroll
            for (int ai = 0; ai < 2; ++ai)
#pragma unroll
                for (int m = 0; m < 4; ++m) { const unsigned ob = (rowb2 + (unsigned)(ai * 8 + m) * rstep) * 2u;
#pragma unroll
                    for (int bj = 0; bj < 2; ++bj) { *(f32x4*)((char*)outf + (ob + (unsigned)bj * 512u)) = acc[ai][bj][m][0]; *(f32x4*)((char*)outf + (ob + (unsigned)bj * 512u + 16u)) = acc[ai][bj][m][1]; } }
        }
        asm volatile("s_waitcnt lgkmcnt(0)" ::: "memory"); __builtin_amdgcn_s_barrier(); asm volatile("" ::: "memory");
        if (t < 256) { const f32x2v a = ps[t * 4 + 0], b2 = ps[t * 4 + 1], c = ps[t * 4 + 2], d = ps[t * 4 + 3];
            *(f32x2v*)(st + 16 * (size_t)(u.pm * BM + t) + 2 * u.pn) = (f32x2v){(a.x + b2.x) + (c.x + d.x), (a.y + b2.y) + (c.y + d.y)}; }
    }
};

template <class Epi, class Sched, bool ALIGN_EPI = false, bool SP2 = false>
__device__ __forceinline__ void gemm_phase(PG8_LAS unsigned char* lds, const Gemm g, const Sched& S, const Epi& E) {
    const int tid = opaque_tid(), wid = __builtin_amdgcn_readfirstlane(tid >> 6), lane = tid & 63, wr = wid >> 2, wc = wid & 3, fr = lane & 15, fq = lane >> 4;
    const int K = g.K, nt = K / BK;
    unsigned voffA[2], voffB[2];
#pragma unroll
    for (int i = 0; i < 2; ++i) { int R, C; stage_rc(tid * 16 + i * 8192, R, C); const int Rb = Epi::PERM ? ((R & ~31) + perm32(R & 31)) : R;
        voffA[i] = (unsigned)(R * K + C) * 2u; voffB[i] = (unsigned)(Rb * K + C) * 2u; }
    const size_t kstep = (size_t)(BK * 2);
    const size_t hstep = (size_t)HALF * K * 2;
    const size_t tstep = 2 * hstep;
    const unsigned ldsw = (unsigned)wid * 1024u;
    const int aoff = lds_byte(wr * 64 + fr, fq * 8), boff = lds_byte(wc * 32 + fr, fq * 8);
#define PG8_SA(b, h) (((b) * 2 + (h)) * HTB)
#define PG8_SB(b, h) ((4 + (b) * 2 + (h)) * HTB)
#define PG8_STAGE(bufoff, gbase, voff) do { _Pragma("unroll") for (int _i = 0; _i < 2; ++_i) \
        __builtin_amdgcn_global_load_lds((const unsigned*)((const char*)(gbase) + (voff)[_i]), (PG8_LAS unsigned*)(lds + (bufoff) + ldsw + _i * 8192), 16, 0, 0); } while (0)
#define PG8_LDA(dst, b, h) do { _Pragma("unroll") for (int m = 0; m < 4; ++m) _Pragma("unroll") for (int k = 0; k < 2; ++k) dst[m][k] = *(const PG8_LAS bf16x8*)(lds + PG8_SA(b, h) + aoff + m * 2048 + k * 1024); } while (0)
#define PG8_LDB(dst, b, h) do { _Pragma("unroll") for (int n = 0; n < 2; ++n) _Pragma("unroll") for (int k = 0; k < 2; ++k) dst[n][k] = *(const PG8_LAS bf16x8*)(lds + PG8_SB(b, h) + boff + n * 2048 + k * 1024); } while (0)
#define PG8_MMA(ai, bj, At, Bt) do { __builtin_amdgcn_s_setprio(1); _Pragma("unroll") for (int m = 0; m < 4; ++m) _Pragma("unroll") for (int n = 0; n < 2; ++n) _Pragma("unroll") for (int k = 0; k < 2; ++k) \
        acc[ai][bj][m][n] = __builtin_amdgcn_mfma_f32_16x16x32_bf16(Bt[n][k], At[m][k], acc[ai][bj][m][n], 0, 0, 0); __builtin_amdgcn_s_setprio(0); } while (0)
#define PG8_WAIT_V(n) asm volatile("s_waitcnt vmcnt(" #n ")" ::: "memory")
#define PG8_WAIT_L(n) asm volatile("s_waitcnt lgkmcnt(" #n ")" ::: "memory")
#if PG8_RELAX
#define PG8_WAIT_VR() do { asm volatile("s_waitcnt vmcnt(%0)" :: "n"(8 + Epi::NSTORES) : "memory"); if (!PG8_RELAX || relax_ == 0) { PG8_WAIT_V(8); } } while (0)
#else
#define PG8_WAIT_VR() PG8_WAIT_V(8)
#endif
#define PG8_BAR __builtin_amdgcn_s_barrier()
#define PG8_SCHED __builtin_amdgcn_sched_barrier(0)
    Unit cur, nxt; int ui = 0;
    if (!S.next(0, cur)) return;
#if PG8_PROBE
    unsigned long long pr_tk = 0, pr_te = 0; const unsigned long long pr_r0 = __builtin_amdgcn_s_memrealtime(), pr_c0 = __builtin_amdgcn_s_memtime();
#endif
    f32x4 acc[2][2][4][2];
#pragma unroll
    for (int a = 0; a < 2; ++a)
#pragma unroll
        for (int b = 0; b < 2; ++b)
#pragma unroll
            for (int m = 0; m < 4; ++m)
#pragma unroll
                for (int n = 0; n < 2; ++n) acc[a][b][m][n] = (f32x4){0.f, 0.f, 0.f, 0.f};
    bf16x8 At[4][2], B0[2][2], B1[2][2];
    const char* cA = (const char*)g.A + (size_t)cur.pm * tstep; const char* cB = (const char*)g.Bt + (size_t)cur.pn * tstep;
    S.a_ready(cur);
    if constexpr (SP2) {
        PG8_STAGE(PG8_SB(0, 0), cB, voffB); PG8_STAGE(PG8_SB(0, 1), cB + hstep, voffB); PG8_STAGE(PG8_SA(0, 0), cA, voffA); PG8_STAGE(PG8_SA(0, 1), cA + hstep, voffA);
        if (wr == 1) PG8_BAR;
        PG8_WAIT_V(2); PG8_BAR;
        PG8_STAGE(PG8_SB(1, 0), cB + kstep, voffB); PG8_STAGE(PG8_SA(1, 0), cA + kstep, voffA); PG8_STAGE(PG8_SB(1, 1), cB + hstep + kstep, voffB);
        PG8_WAIT_V(6); PG8_BAR;
    } else {
        PG8_STAGE(PG8_SB(0, 0), cB, voffB); PG8_STAGE(PG8_SA(0, 0), cA, voffA); PG8_STAGE(PG8_SB(0, 1), cB + hstep, voffB); PG8_STAGE(PG8_SA(0, 1), cA + hstep, voffA);
        if (wr == 1) PG8_BAR;
        PG8_WAIT_V(4); PG8_BAR;
        PG8_STAGE(PG8_SB(1, 0), cB + kstep, voffB); PG8_STAGE(PG8_SA(1, 0), cA + kstep, voffA); PG8_STAGE(PG8_SB(1, 1), cB + hstep + kstep, voffB);
        PG8_WAIT_V(6); PG8_BAR;
    }
    for (;;) {
        const bool has_next = S.next(ui + 1, nxt);
        const char* nA = has_next ? (const char*)g.A + (size_t)nxt.pm * tstep : cA; const char* nB = has_next ? (const char*)g.Bt + (size_t)nxt.pn * tstep : cB;
#if PG8_PROBE
        const unsigned long long pr_ta = __builtin_amdgcn_s_memtime();
#endif
        for (int t = 0; t < nt; t += 2) {
            const bool last = (t == nt - 2);
#if PG8_PROBE >= 9 && PG8_PROBE <= 10
            int pr_tv = (PG8_PROBE == 9 ? 0 : 8); asm volatile("" : "+v"(pr_tv)); const bool pr_sel = (ui > 0) && (t == __builtin_amdgcn_readfirstlane(pr_tv)); const unsigned pr_i0 = (unsigned)__builtin_amdgcn_s_memtime();
#endif
#if PG8_RELAX
            int relax_v = ((t == 0) && (ui > 0)) ? 1 : 0; asm volatile("" : "+v"(relax_v)); const int relax_ = __builtin_amdgcn_readfirstlane(relax_v);
#endif
            const char* a1 = cA + (size_t)(t + 1) * kstep;
            const char* a2 = last ? nA : cA + (size_t)(t + 2) * kstep; const char* b2 = last ? nB : cB + (size_t)(t + 2) * kstep;
            const char* a3 = a2 + kstep; const char* b3 = b2 + kstep;
            if (last && has_next) S.a_ready(nxt);
            if constexpr (SP2) {
            PG8_LDB(B0, 0, 0); PG8_LDB(B1, 0, 1); PG8_SCHED; PG8_LDA(At, 0, 0); PG8_STAGE(PG8_SA(1, 1), a1 + hstep, voffA);
            PG8_WAIT_VR(); PG8_WAIT_L(0); PG8_BAR; PG8_MMA(0, 0, At, B0); PG8_MMA(0, 1, At, B1); PG8_BAR; PG8_SCHED;
            PG8_LDA(At, 0, 1); PG8_STAGE(PG8_SB(0, 0), b2, voffB); PG8_STAGE(PG8_SB(0, 1), b2 + hstep, voffB); PG8_STAGE(PG8_SA(0, 0), a2, voffA);
            PG8_WAIT_VR(); PG8_WAIT_L(0); PG8_BAR; PG8_MMA(1, 0, At, B0); PG8_MMA(1, 1, At, B1); PG8_BAR; PG8_SCHED;
            PG8_LDB(B0, 1, 0); PG8_LDB(B1, 1, 1); PG8_SCHED; PG8_LDA(At, 1, 0); PG8_STAGE(PG8_SA(0, 1), a2 + hstep, voffA);
            PG8_WAIT_V(8); PG8_WAIT_L(0); PG8_BAR; PG8_MMA(0, 0, At, B0); PG8_MMA(0, 1, At, B1); PG8_BAR; PG8_SCHED;
            PG8_LDA(At, 1, 1); PG8_STAGE(PG8_SB(1, 0), b3, voffB); PG8_STAGE(PG8_SB(1, 1), b3 + hstep, voffB); PG8_STAGE(PG8_SA(1, 0), a3, voffA);
            PG8_WAIT_V(8); PG8_WAIT_L(0); PG8_BAR; PG8_MMA(1, 0, At, B0); PG8_MMA(1, 1, At, B1); PG8_BAR; PG8_SCHED;
            } else {
            PG8_LDB(B0, 0, 0); PG8_SCHED; PG8_LDA(At, 0, 0); PG8_STAGE(PG8_SA(1, 1), a1 + hstep, voffA);
            PG8_WAIT_L(8); PG8_BAR; PG8_WAIT_L(0); PG8_MMA(0, 0, At, B0); PG8_BAR; PG8_SCHED;
            PG8_LDB(B1, 0, 1); PG8_STAGE(PG8_SB(0, 0), b2, voffB);
            PG8_BAR; PG8_WAIT_L(0); PG8_MMA(0, 1, At, B1); PG8_BAR;
            PG8_LDA(At, 0, 1); PG8_STAGE(PG8_SA(0, 0), a2, voffA);
            PG8_BAR; PG8_WAIT_L(0); PG8_MMA(1, 0, At, B0); PG8_BAR; PG8_SCHED;
            PG8_STAGE(PG8_SB(0, 1), b2 + hstep, voffB);
            PG8_WAIT_V(6); PG8_BAR; PG8_MMA(1, 1, At, B1); PG8_BAR;
            PG8_LDB(B0, 1, 0); PG8_SCHED; PG8_LDA(At, 1, 0); PG8_STAGE(PG8_SA(0, 1), a2 + hstep, voffA);
            PG8_WAIT_L(8); PG8_BAR; PG8_WAIT_L(0); PG8_MMA(0, 0, At, B0); PG8_BAR; PG8_SCHED;
            PG8_LDB(B1, 1, 1); PG8_STAGE(PG8_SB(1, 0), b3, voffB);
            PG8_BAR; PG8_WAIT_L(0); PG8_MMA(0, 1, At, B1); PG8_BAR;
            PG8_LDA(At, 1, 1); PG8_STAGE(PG8_SA(1, 0), a3, voffA);
            PG8_BAR; PG8_WAIT_L(0); PG8_MMA(1, 0, At, B0); PG8_BAR; PG8_SCHED;
            PG8_STAGE(PG8_SB(1, 1), b3 + hstep, voffB);
            PG8_WAIT_V(6); PG8_BAR; PG8_MMA(1, 1, At, B1); PG8_BAR;
            }
#if PG8_PROBE >= 9 && PG8_PROBE <= 10
            if (pr_sel) pr_tk += (unsigned)((unsigned)__builtin_amdgcn_s_memtime() - pr_i0);
#endif
        }
#if PG8_PROBE
        const unsigned long long pr_tb = __builtin_amdgcn_s_memtime(); if (!(PG8_PROBE >= 9 && PG8_PROBE <= 10)) pr_tk += pr_tb - pr_ta;
#endif
        if constexpr (ALIGN_EPI) { if (wr == 0) PG8_BAR; }
        if constexpr (!Epi::AFTER_DRAIN) { E(acc, cur, wr, wc, fr, fq); S.done(cur); }
#if PG8_PROBE
        { const unsigned long long pr_tc = __builtin_amdgcn_s_memtime(); pr_te += pr_tc - pr_tb; }
#endif
        if (!has_next) break;
#pragma unroll
        for (int a = 0; a < 2; ++a)
#pragma unroll
            for (int b = 0; b < 2; ++b)
#pragma unroll
                for (int m = 0; m < 4; ++m)
#pragma unroll
                    for (int n = 0; n < 2; ++n) acc[a][b][m][n] = (f32x4){0.f, 0.f, 0.f, 0.f};
        cur = nxt; cA = nA; cB = nB; ++ui;
        if constexpr (ALIGN_EPI) { if (wr == 1) PG8_BAR; }
    }
#if PG8_PROBE
    if (g.probe && blockIdx.x == 0 && tid == 0) { g.probe[0] = pr_tk; g.probe[1] = pr_te; g.probe[2] = (unsigned long long)(ui + 1); g.probe[3] = __builtin_amdgcn_s_memrealtime() - pr_r0; g.probe[4] = __builtin_amdgcn_s_memtime() - pr_c0; }
#endif
    PG8_WAIT_V(0);
    if constexpr (!ALIGN_EPI) { if (wr == 0) PG8_BAR; }
    PG8_BAR;
    if constexpr (Epi::AFTER_DRAIN) { E.fused(acc, cur, wr, wc, fr, fq, lds, wid, lane); S.done(cur); }
#undef PG8_SA
#undef PG8_SB
#undef PG8_STAGE
#undef PG8_LDA
#undef PG8_LDB
#undef PG8_MMA
#undef PG8_WAIT_V
#undef PG8_WAIT_L
#undef PG8_WAIT_VR
#undef PG8_BAR
#undef PG8_SCHED
}
}

namespace attA {
constexpr int D = 128;
constexpr int LDQ = NQKV_A, LDKV = NQKV_A, LDO = 2 * DM;
constexpr float THR = 8.f;
constexpr bool WSKIP = false;
constexpr float SCALE = 0.08838834764831845f;
constexpr int NW = 8, QBLK = 32, KVBLK = 64, QB = NW * QBLK;
constexpr int SHM_V = KVBLK * D * 2, SHM_K = KVBLK * D * 2;
constexpr int LDS_BYTES = 2 * SHM_V + 2 * SHM_K + NW * 64 * 4;
using bf16 = __hip_bfloat16;
typedef short bf16x8 __attribute__((ext_vector_type(8)));
typedef short s16x4 __attribute__((ext_vector_type(4)));
typedef float f32x16 __attribute__((ext_vector_type(16)));
typedef float f32x4 __attribute__((ext_vector_type(4)));
typedef unsigned u32x4 __attribute__((ext_vector_type(4)));
template <class A, class Bt> struct same_t { static constexpr bool v = false; };
template <class A> struct same_t<A, A> { static constexpr bool v = true; };

#define KSWZ(row, colB) ((row) * 256 + ((colB) ^ (((row) & 7) << 4)))
#define SBAR() __builtin_amdgcn_sched_barrier(0)
__device__ __forceinline__ int v_st(int k, int c) { const int kk = (k & ~0xC) | ((k & 4) << 1) | ((k & 8) >> 1); return ((kk >> 3) * 4 + (c >> 5)) * 512 + ((kk & 7) * 32 + (c & 31)) * 2; }
__device__ __forceinline__ int v_rd_base(int lane) { return ((lane & 3) << 3) | (((lane >> 2) & 3) << 6) | (((lane >> 4) & 1) << 5) | (((lane >> 5) & 1) << 8); }
constexpr int v_rd_off(int d0, int ks, int half) { return d0 * 512 + ks * 4096 + half * 2048; }
__device__ __forceinline__ int crow(int r, int hi) { return (r & 3) + 8 * (r >> 2) + 4 * hi; }
__device__ __forceinline__ unsigned cvtpk(float lo, float hi) {
    unsigned r; asm volatile("v_cvt_pk_bf16_f32 %0, %1, %2" : "=v"(r) : "v"(lo), "v"(hi)); return r;
}
__device__ __forceinline__ bf16x8 pack8(f32x4 a, f32x4 b) {
    u32x4 w = {cvtpk(a[0], a[1]), cvtpk(a[2], a[3]), cvtpk(b[0], b[1]), cvtpk(b[2], b[3])};
    return *reinterpret_cast<bf16x8*>(&w);
}
template <class T> __device__ __forceinline__ bf16x8 load8(const T* p) {
    if constexpr (same_t<T, float>::v) { return pack8(*(const f32x4*)p, *(const f32x4*)(p + 4)); }
    else { return *reinterpret_cast<const bf16x8*>(p); }
}
__device__ __forceinline__ void mask_tile(f32x16& p0, f32x16& p1, int dq, unsigned W) {
    const float NEG = -__builtin_inff();
#pragma unroll
    for (int r = 0; r < 16; ++r) {
        const int c = (r & 3) + 8 * (r >> 2);
        if ((unsigned)(dq - c) >= W) p0[r] = NEG;
        if ((unsigned)(dq - c - 32) >= W) p1[r] = NEG;
    }
}
__device__ __forceinline__ void partialSM(f32x16& p0, f32x16& p1, float& m_reg, float& mn, float& alpha) {
    float pmax = p0[0]; for (int r = 1; r < 16; ++r) pmax = fmaxf(pmax, p0[r]); for (int r = 0; r < 16; ++r) pmax = fmaxf(pmax, p1[r]);
    { auto rr = __builtin_amdgcn_permlane32_swap(__float_as_uint(pmax), __float_as_uint(pmax), false, false);
      pmax = fmaxf(__uint_as_float(rr[0]), __uint_as_float(rr[1])); }
    constexpr float C2 = 1.4426950408889634f * SCALE;
    if (__builtin_expect(__all((pmax - m_reg) * SCALE <= THR), 1)) { mn = m_reg; alpha = 1.f; }
    else { mn = fmaxf(m_reg, pmax); alpha = __builtin_amdgcn_exp2f((m_reg - mn) * C2); m_reg = mn; }
    const float mnL = -mn * C2;
    for (int r = 0; r < 16; ++r) p0[r] = fmaf(p0[r], C2, mnL); for (int r = 0; r < 16; ++r) p1[r] = fmaf(p1[r], C2, mnL);
    for (int r = 0; r < 16; ++r) p0[r] = __builtin_amdgcn_exp2f(p0[r]);
}
__device__ __forceinline__ void finishSM(f32x16& p0, f32x16& p1, float alpha, float& l_reg, bf16x8& pa0, bf16x8& pa1, bf16x8& pa2, bf16x8& pa3) {
    for (int r = 0; r < 16; ++r) p1[r] = __builtin_amdgcn_exp2f(p1[r]);
    float ps = 0; for (int r = 0; r < 16; ++r) ps += p0[r]; for (int r = 0; r < 16; ++r) ps += p1[r];
    { auto rr = __builtin_amdgcn_permlane32_swap(__float_as_uint(ps), __float_as_uint(ps), false, false);
      ps = __uint_as_float(rr[0]) + __uint_as_float(rr[1]); }
    l_reg = l_reg * alpha + ps;
#define PK4(P, B_, OUT) do { unsigned a0 = cvtpk(P[B_+0], P[B_+1]), a1 = cvtpk(P[B_+2], P[B_+3]);                          \
        unsigned b0 = cvtpk(P[B_+4], P[B_+5]), b1 = cvtpk(P[B_+6], P[B_+7]);                                             \
        auto r0 = __builtin_amdgcn_permlane32_swap(a0, b0, false, false); auto r1 = __builtin_amdgcn_permlane32_swap(a1, b1, false, false); \
        u32x4 w = {r0[0], r1[0], r0[1], r1[1]}; OUT = *reinterpret_cast<bf16x8*>(&w); } while (0)
    PK4(p0, 0, pa0); PK4(p0, 8, pa1); PK4(p1, 0, pa2); PK4(p1, 8, pa3);
#undef PK4
}
template <int KB, bool SK>
__device__ __forceinline__ void qkt(f32x16& p0, f32x16& p1, const char* K_lds, int r32, int hi, const bf16x8* qr, bool act) {
    if (SK && !act) { const float NEG = -__builtin_inff();
#pragma unroll
        for (int r = 0; r < 16; ++r) { p0[r] = NEG; p1[r] = NEG; } return; }
    p0 = f32x16{}; p1 = f32x16{};
    const char* kb[4];
#pragma unroll
    for (int dd = 0; dd < 4; ++dd) kb[dd] = K_lds + KB * SHM_K + KSWZ(r32, (dd * 16 + hi * 8) * 2);
#pragma unroll
    for (int d0 = 0; d0 < 8; ++d0) { const char* a = kb[d0 & 3] + (d0 >> 2) * 128;
        bf16x8 b0 = *reinterpret_cast<const bf16x8*>(a);
        bf16x8 b1 = *reinterpret_cast<const bf16x8*>(a + 32 * 256);
        p0 = __builtin_amdgcn_mfma_f32_32x32x16_bf16(b0, qr[d0], p0, 0, 0, 0);
        p1 = __builtin_amdgcn_mfma_f32_32x32x16_bf16(b1, qr[d0], p1, 0, 0, 0); }
}
template <int VB, bool SK>
__device__ __forceinline__ void pv_tile(f32x16* o, int vb0, bf16x8 pa0, bf16x8 pa1, bf16x8 pa2, bf16x8 pa3, bool act) {
    if (SK && !act) return;
#define TRRD(dst, off) asm volatile("ds_read_b64_tr_b16 %0, %1 offset:%2" : "=&v"(dst) : "v"(vb0), "i"(off) : "memory")
#define PV_D0(d0) do { s16x4 l0, l1, l2, l3, h0, h1, h2, h3; constexpr int b_ = VB * SHM_V + v_rd_off(d0, 0, 0);     \
        TRRD(l0, b_); TRRD(h0, b_ + 2048); TRRD(l1, b_ + 4096); TRRD(h1, b_ + 6144); TRRD(l2, b_ + 8192); TRRD(h2, b_ + 10240); TRRD(l3, b_ + 12288); TRRD(h3, b_ + 14336); \
        asm volatile("s_waitcnt lgkmcnt(0)" ::: "memory"); SBAR();                 \
        o[d0] = __builtin_amdgcn_mfma_f32_32x32x16_bf16(pa0, (bf16x8){l0[0], l0[1], l0[2], l0[3], h0[0], h0[1], h0[2], h0[3]}, o[d0], 0, 0, 0);   \
        o[d0] = __builtin_amdgcn_mfma_f32_32x32x16_bf16(pa1, (bf16x8){l1[0], l1[1], l1[2], l1[3], h1[0], h1[1], h1[2], h1[3]}, o[d0], 0, 0, 0);   \
        o[d0] = __builtin_amdgcn_mfma_f32_32x32x16_bf16(pa2, (bf16x8){l2[0], l2[1], l2[2], l2[3], h2[0], h2[1], h2[2], h2[3]}, o[d0], 0, 0, 0);   \
        o[d0] = __builtin_amdgcn_mfma_f32_32x32x16_bf16(pa3, (bf16x8){l3[0], l3[1], l3[2], l3[3], h3[0], h3[1], h3[2], h3[3]}, o[d0], 0, 0, 0); } while (0)
    PV_D0(0); PV_D0(1); PV_D0(2); PV_D0(3);
#undef PV_D0
#undef TRRD
}

template <class TIn, class TOut> struct BlockRef { const TIn* Q; const TIn* K; const TIn* V; TOut* O; int P0; };
template <class TIn> struct Seam {
    bf16x8 qr[8];
    bf16x8 st_v0, st_v1, st_k0, st_k1; f32x4 sf0, sf1, sf2, sf3;
    f32x4 tq[16];
};
__device__ __forceinline__ int swa_jlo(int P0, int W) { const int lowk = P0 - W + 1; return lowk > 0 ? lowk / KVBLK : 0; }
#define ROW(p, k0, rr) ((p) + (size_t)((k0) + (rr)) * LDKV + sc)
#define VMW() asm volatile("s_waitcnt vmcnt(0)" ::: "memory")
#define VMWN(n) asm volatile("s_waitcnt vmcnt(%0)" :: "i"(n) : "memory")
#define SLOAD_H(Kp, Vp, k0) do { S.st_v0 = load8<TIn>(ROW(Vp, k0, sr)); S.st_v1 = load8<TIn>(ROW(Vp, k0, 32 + sr));              \
                         S.st_k0 = load8<TIn>(ROW(Kp, k0, sr)); S.st_k1 = load8<TIn>(ROW(Kp, k0, 32 + sr)); } while (0)
#define SWRITE_HK(bf) do { *(bf16x8*)(K_lds + (bf) * SHM_K + kws) = S.st_k0; *(bf16x8*)(K_lds + (bf) * SHM_K + kws + 32 * 256) = S.st_k1; } while (0)
#define SWRITE_HV(bf) do { *(bf16x8*)(V_lds + (bf) * SHM_V + vst0) = S.st_v0; *(bf16x8*)(V_lds + (bf) * SHM_V + vst1) = S.st_v1; } while (0)
#define SWRITE_H(bf) do { SWRITE_HV(bf); SWRITE_HK(bf); } while (0)
#define SLOAD_F(p, k0) do { S.sf0 = *(const f32x4*)ROW(p, k0, sr); S.sf1 = *(const f32x4*)(ROW(p, k0, sr) + 4);                \
                            S.sf2 = *(const f32x4*)ROW(p, k0, 32 + sr); S.sf3 = *(const f32x4*)(ROW(p, k0, 32 + sr) + 4); } while (0)
#define SWRITE_KF(bf) do { *(bf16x8*)(K_lds + (bf) * SHM_K + kws) = pack8(S.sf0, S.sf1); *(bf16x8*)(K_lds + (bf) * SHM_K + kws + 32 * 256) = pack8(S.sf2, S.sf3); } while (0)
#define SWRITE_VF(bf) do { *(bf16x8*)(V_lds + (bf) * SHM_V + vst0) = pack8(S.sf0, S.sf1); *(bf16x8*)(V_lds + (bf) * SHM_V + vst1) = pack8(S.sf2, S.sf3); } while (0)
template <class TIn, class TOut>
__device__ __forceinline__ void causal_swa_prime(const BlockRef<TIn, TOut>& cur, int W, char* lds, Seam<TIn>& S) {
    constexpr bool F32 = same_t<TIn, float>::v;
    const int tid = opaque_tid(), wid = __builtin_amdgcn_readfirstlane(tid >> 6), lane = tid & 63, r32 = lane & 31, hi = lane >> 5;
    const int sr = tid >> 4, sc = (tid & 15) * 8, kws = KSWZ(sr, sc * 2); char* K_lds = lds + 2 * SHM_V;
    const int kb0 = swa_jlo(cur.P0, W) * KVBLK;
    for (int d0 = 0; d0 < 8; ++d0) S.qr[d0] = load8<TIn>(cur.Q + (size_t)(wid * QBLK + r32) * LDQ + d0 * 16 + hi * 8);
    if constexpr (F32) { SLOAD_F((const float*)cur.K, kb0); VMW(); SWRITE_KF(0); SBAR(); SLOAD_F((const float*)cur.V, kb0); }
    else { SLOAD_H(cur.K, cur.V, kb0); VMW(); SWRITE_HK(0); }
    __syncthreads();
}
template <class TIn, class TOut>
__device__ __forceinline__ void causal_swa_block(const BlockRef<TIn, TOut>& cur, const BlockRef<TIn, TOut>& nxt, int skv, int W, char* lds, Seam<TIn>& S) {
    constexpr bool F32 = same_t<TIn, float>::v;
    const int tid = opaque_tid(), wid = __builtin_amdgcn_readfirstlane(tid >> 6), lane = tid & 63, r32 = lane & 31, hi = lane >> 5;
    const int j_lo = swa_jlo(cur.P0, W);
    int j_hi = (cur.P0 + QB - 1) / KVBLK + 1; if (j_hi > skv / KVBLK) j_hi = skv / KVBLK;
    const int NT = j_hi - j_lo;
    const int kbn = swa_jlo(nxt.P0, W) * KVBLK;
    const int qlo = cur.P0 + wid * QBLK, qm = qlo + r32 - 4 * hi;
    char* V_lds = lds; char* K_lds = lds + 2 * SHM_V;
    float* ws = (float*)(lds + 2 * SHM_V + 2 * SHM_K) + wid * 64; float* li_l = ws, * al_l = ws + 32;
    float m_reg = -1e30f, l_reg = 0; f32x16 o[4] = {};
    const int sr = tid >> 4, sc = (tid & 15) * 8, vst0 = v_st(sr, sc), vst1 = v_st(32 + sr, sc), kws = KSWZ(sr, sc * 2);
    const int vb0 = (int)(uintptr_t)V_lds + v_rd_base(lane);
    const TIn* Kh = cur.K; const TIn* Vh = cur.V;
#define RESC(a) do { if (__any((a) < 1.f)) { if (hi == 0) al_l[r32] = (a); asm volatile("s_waitcnt lgkmcnt(0)" ::: "memory");              \
                     for (int d_ = 0; d_ < 4; ++d_) for (int r = 0; r < 16; ++r) o[d_][r] *= al_l[crow(r, hi)]; } } while (0)
#define KBASE(t) ((j_lo + (t)) * KVBLK)
#define ACT(t) (KBASE(t) <= qlo + QBLK - 1 && KBASE(t) + KVBLK - 1 >= qlo - W + 1)
#define MASKT(P0_, P1_, t) do { const int kb_ = KBASE(t); if ((!SK || ACT(t)) && (kb_ + KVBLK - 1 > qlo || kb_ <= qlo + QBLK - 1 - W)) mask_tile(P0_, P1_, qm - kb_, (unsigned)W); } while (0)
    constexpr int NQL = F32 ? 16 : 8;
    constexpr bool SK = WSKIP && !F32;
#define SEAM_K0() do { VMWN(NQL); if constexpr (F32) { SWRITE_KF(0); SBAR(); SLOAD_F((const float*)nxt.V, kbn); } else { SWRITE_HK(0); } SBAR(); } while (0)
    f32x16 pA0, pA1, pB0, pB1; float mnA, mnB, alA, alB; bf16x8 pa0, pa1, pa2, pa3;
    if constexpr (F32) { VMW(); SWRITE_VF(0); SBAR(); } else { SWRITE_HV(0); SBAR(); }
    if (NT > 1) { if constexpr (F32) SLOAD_F((const float*)Kh, KBASE(1)); else SLOAD_H(Kh, Vh, KBASE(1)); }
    SBAR(); qkt<0, SK>(pA0, pA1, K_lds, r32, hi, S.qr, ACT(0));
    if constexpr (F32) { if (NT > 1) { VMW(); SWRITE_KF(1); SBAR(); SLOAD_F((const float*)Vh, KBASE(1)); } }
    MASKT(pA0, pA1, 0); partialSM(pA0, pA1, m_reg, mnA, alA);
    if (NT > 1) { VMW(); if constexpr (F32) { SWRITE_VF(1); SBAR(); if (NT > 2) SLOAD_F((const float*)Kh, KBASE(2)); } else SWRITE_H(1); }
    __syncthreads();
#define HALF_STEP(PX0, PX1, mnX, alX, PY0, PY1, alY, t, KB, VB, SB) do {                                                      \
        SBAR(); qkt<KB, SK>(PX0, PX1, K_lds, r32, hi, S.qr, ACT(t));                                             \
        finishSM(PY0, PY1, alY, l_reg, pa0, pa1, pa2, pa3); SBAR();                                                           \
        if ((t) + 1 < NT) { if constexpr (F32) { VMW(); SWRITE_KF(SB); SBAR(); SLOAD_F((const float*)Vh, KBASE((t) + 1)); }  \
                            else { SLOAD_H(Kh, Vh, KBASE((t) + 1)); } SBAR(); }                                               \
        pv_tile<VB, SK>(o, vb0, pa0, pa1, pa2, pa3, ACT((t) - 1)); MASKT(PX0, PX1, (t)); partialSM(PX0, PX1, m_reg, mnX, alX);                                        \
        __syncthreads();                                                                                                      \
        if ((t) + 1 < NT) { VMW(); if constexpr (F32) { SWRITE_VF(SB); SBAR(); if ((t) + 2 < NT) SLOAD_F((const float*)Kh, KBASE((t) + 2)); } \
                            else { SWRITE_H(SB); } }                                                                          \
        RESC(alX); __syncthreads(); } while (0)
    for (int t = 1; t + 1 < NT; t += 2) {
        HALF_STEP(pB0, pB1, mnB, alB, pA0, pA1, alA, t, 1, 0, 0);
        HALF_STEP(pA0, pA1, mnA, alA, pB0, pB1, alB, t + 1, 0, 1, 1);
    }
    const bool even = (NT & 1) == 0;
    if (even) { SBAR(); qkt<1, SK>(pB0, pB1, K_lds, r32, hi, S.qr, ACT(NT - 1)); SBAR(); }
#define QROW(e) (nxt.Q + (size_t)(wid * QBLK + r32) * LDQ + ((e) >> 1) * 16 + hi * 8 + ((e) & 1) * 4)
    if constexpr (F32) { SLOAD_F((const float*)nxt.K, kbn); SBAR();
#pragma unroll
        for (int e = 0; e < 8; ++e) S.tq[e] = *(const f32x4*)QROW(e); }
    else { SLOAD_H(nxt.K, nxt.V, kbn); SBAR();
#pragma unroll
        for (int d0 = 0; d0 < 8; ++d0) S.qr[d0] = load8<TIn>(nxt.Q + (size_t)(wid * QBLK + r32) * LDQ + d0 * 16 + hi * 8); }
    SBAR();
    finishSM(pA0, pA1, alA, l_reg, pa0, pa1, pa2, pa3); SBAR();
    if constexpr (F32) {
#pragma unroll
        for (int e = 8; e < 16; ++e) S.tq[e] = *(const f32x4*)QROW(e); SBAR(); }
#undef QROW
    pv_tile<0, SK>(o, vb0, pa0, pa1, pa2, pa3, ACT(even ? NT - 2 : NT - 1));
    if (even) { MASKT(pB0, pB1, NT - 1); partialSM(pB0, pB1, m_reg, mnB, alB); __syncthreads(); RESC(alB);
        finishSM(pB0, pB1, alB, l_reg, pa0, pa1, pa2, pa3); SBAR(); pv_tile<1, SK>(o, vb0, pa0, pa1, pa2, pa3, ACT(NT - 1)); }
    SBAR(); SEAM_K0();
    if (hi == 0) li_l[r32] = l_reg; asm volatile("s_waitcnt lgkmcnt(0)" ::: "memory");
    float rli[16];
#pragma unroll
    for (int r = 0; r < 16; ++r) rli[r] = __builtin_amdgcn_rcpf(li_l[crow(r, hi)]);
    TOut* Ow = cur.O + (size_t)(wid * QBLK) * LDO;
#pragma unroll
    for (int r = 0; r < 16; ++r) { const int orow = crow(r, hi);
#pragma unroll
        for (int d0 = 0; d0 < 4; ++d0) { const float v = o[d0][r] * rli[r];
            if constexpr (same_t<TOut, float>::v) { Ow[(size_t)orow * LDO + d0 * 32 + r32] = v; }
            else { const float vn = __shfl_xor(v, 1);
                   if ((r32 & 1) == 0) *(unsigned*)(Ow + (size_t)orow * LDO + d0 * 32 + r32) = cvtpk(v, vn); } } }
    if constexpr (F32) {
#pragma unroll
        for (int d0 = 0; d0 < 8; ++d0) S.qr[d0] = pack8(S.tq[2 * d0], S.tq[2 * d0 + 1]); }
    __syncthreads();
#undef RESC
#undef KBASE
#undef ACT
#undef MASKT
#undef SEAM_K0
#undef HALF_STEP
}
#undef ROW
#undef VMW
#undef VMWN
#undef SLOAD_H
#undef SWRITE_HK
#undef SWRITE_HV
#undef SWRITE_H
#undef SLOAD_F
#undef SWRITE_KF
#undef SWRITE_VF

#ifndef ATTA_LATE_FROM
#define ATTA_LATE_FROM 4
#endif
#ifndef ATTA_VPF
#define ATTA_VPF 1
#endif
#ifndef ATTA_PINGPONG
#define ATTA_PINGPONG 0
#endif
constexpr int SHM_V2 = KVBLK * 256 * 2;
constexpr int NVB = 3;
constexpr int LDS2_BYTES = NVB * SHM_V2 + 2 * SHM_K;
struct Blk2 { const bf16* Q; const bf16* K; const bf16* V; bf16* O; int P0; };

template <int HF>
__device__ __forceinline__ void pv_half(f32x16 (&o)[8], const bf16x8& pa0, const bf16x8& pa1, int vb) {
#define TRRD(dst, off) asm volatile("ds_read_b64_tr_b16 %0, %1 offset:%2" : "=&v"(dst) : "v"(vb), "i"(off) : "memory")
#define RD4(l0, h0, l1, h1, d0) do { constexpr int b_ = ((d0) >> 2) * 16384 + ((d0) & 3) * 512 + HF * 8192;     \
        TRRD(l0, b_); TRRD(h0, b_ + 2048); TRRD(l1, b_ + 4096); TRRD(h1, b_ + 6144); } while (0)
#define MM2(l0, h0, l1, h1, d0) do { \
        o[d0] = __builtin_amdgcn_mfma_f32_32x32x16_bf16(pa0, (bf16x8){l0[0], l0[1], l0[2], l0[3], h0[0], h0[1], h0[2], h0[3]}, o[d0], 0, 0, 0); \
        o[d0] = __builtin_amdgcn_mfma_f32_32x32x16_bf16(pa1, (bf16x8){l1[0], l1[1], l1[2], l1[3], h1[0], h1[1], h1[2], h1[3]}, o[d0], 0, 0, 0); } while (0)
#define LWAIT() do { asm volatile("s_waitcnt lgkmcnt(0)" ::: "memory"); SBAR(); } while (0)
#if ATTA_VPF == 2
#define LWAIT4() do { asm volatile("s_waitcnt lgkmcnt(4)" ::: "memory"); SBAR(); } while (0)
    s16x4 a0, a1, a2, a3, b0, b1, b2, b3, c0, c1, c2, c3;
    RD4(a0, a1, a2, a3, 0); RD4(b0, b1, b2, b3, 1);
    LWAIT4(); RD4(c0, c1, c2, c3, 2); SBAR(); MM2(a0, a1, a2, a3, 0); SBAR();
    LWAIT4(); RD4(a0, a1, a2, a3, 3); SBAR(); MM2(b0, b1, b2, b3, 1); SBAR();
    LWAIT4(); RD4(b0, b1, b2, b3, 4); SBAR(); MM2(c0, c1, c2, c3, 2); SBAR();
    LWAIT4(); RD4(c0, c1, c2, c3, 5); SBAR(); MM2(a0, a1, a2, a3, 3); SBAR();
    LWAIT4(); RD4(a0, a1, a2, a3, 6); SBAR(); MM2(b0, b1, b2, b3, 4); SBAR();
    LWAIT4(); RD4(b0, b1, b2, b3, 7); SBAR(); MM2(c0, c1, c2, c3, 5); SBAR();
    LWAIT4(); MM2(a0, a1, a2, a3, 6); SBAR();
    LWAIT(); MM2(b0, b1, b2, b3, 7);
#undef LWAIT4
#else
    s16x4 a0, a1, a2, a3, b0, b1, b2, b3;
    RD4(a0, a1, a2, a3, 0);
    LWAIT(); RD4(b0, b1, b2, b3, 1); SBAR(); MM2(a0, a1, a2, a3, 0); SBAR();
    LWAIT(); RD4(a0, a1, a2, a3, 2); SBAR(); MM2(b0, b1, b2, b3, 1); SBAR();
    LWAIT(); RD4(b0, b1, b2, b3, 3); SBAR(); MM2(a0, a1, a2, a3, 2); SBAR();
    LWAIT(); RD4(a0, a1, a2, a3, 4); SBAR(); MM2(b0, b1, b2, b3, 3); SBAR();
    LWAIT(); RD4(b0, b1, b2, b3, 5); SBAR(); MM2(a0, a1, a2, a3, 4); SBAR();
    LWAIT(); RD4(a0, a1, a2, a3, 6); SBAR(); MM2(b0, b1, b2, b3, 5); SBAR();
    LWAIT(); RD4(b0, b1, b2, b3, 7); SBAR(); MM2(a0, a1, a2, a3, 6); SBAR();
    LWAIT(); MM2(b0, b1, b2, b3, 7);
#endif
#undef LWAIT
#undef MM2
#undef RD4
#undef TRRD
}

template <int BF, bool LATE>
__device__ __forceinline__ void fullv_tile(f32x16 (&o)[8], float& m_reg, float& l_reg, const bf16x8 (&qr)[8], const char* K_lds, int vcur, int vprev, float* al_l, int t, int qlo, int qm, int r32, int hi,
                                           char* pp_l) {
    constexpr float C2 = 1.4426950408889634f * SCALE;
    const char* kb[4];
#pragma unroll
    for (int dd = 0; dd < 4; ++dd) kb[dd] = K_lds + BF * SHM_K + KSWZ(r32, (dd * 16 + hi * 8) * 2);
#pragma unroll
    for (int hf = 0; hf < 2; ++hf) {
        if constexpr (LATE) { const bf16x8 q0 = *(const bf16x8*)pp_l, q1 = *(const bf16x8*)(pp_l + 1024);
            if (hf == 0) pv_half<1>(o, q0, q1, vprev); else pv_half<0>(o, q0, q1, vcur); }
        const int kbase = t * KVBLK + hf * 32;
        if (kbase > qlo + QBLK - 1) { if constexpr (LATE) { *(bf16x8*)pp_l = bf16x8{}; *(bf16x8*)(pp_l + 1024) = bf16x8{}; } continue; }
        f32x16 p = f32x16{};
#pragma unroll
        for (int d0 = 0; d0 < 8; ++d0) { const bf16x8 kf = *reinterpret_cast<const bf16x8*>(kb[d0 & 3] + (d0 >> 2) * 128 + hf * (32 * 256));
            p = __builtin_amdgcn_mfma_f32_32x32x16_bf16(kf, qr[d0], p, 0, 0, 0); }
        if (kbase + 31 > qlo) {
            const float NEG = -__builtin_inff(); const int dq = qm - kbase;
#pragma unroll
            for (int r = 0; r < 16; ++r) { const int c = (r & 3) + 8 * (r >> 2); if (dq - c < 0) p[r] = NEG; } }
        float pmax = p[0];
#pragma unroll
        for (int r = 1; r < 16; ++r) pmax = fmaxf(pmax, p[r]);
        { auto rr = __builtin_amdgcn_permlane32_swap(__float_as_uint(pmax), __float_as_uint(pmax), false, false); pmax = fmaxf(__uint_as_float(rr[0]), __uint_as_float(rr[1])); }
        float mn = m_reg, alpha = 1.f;
        if (!__builtin_expect(__all((pmax - m_reg) * SCALE <= THR), 1)) { mn = fmaxf(m_reg, pmax); alpha = __builtin_amdgcn_exp2f((m_reg - mn) * C2); m_reg = mn; }
        if (__any(alpha < 1.f)) { if (hi == 0) al_l[r32] = alpha; asm volatile("s_waitcnt lgkmcnt(0)" ::: "memory");
#pragma unroll
            for (int d_ = 0; d_ < 8; ++d_)
#pragma unroll
                for (int r = 0; r < 16; ++r) { const float a_ = al_l[crow(r, hi)]; asm volatile("v_mul_f32 %0, %0, %1" : "+v"(o[d_][r]) : "v"(a_)); } }
        const float mnL = -mn * C2; float ps = 0.f;
#pragma unroll
        for (int r = 0; r < 16; ++r) { p[r] = __builtin_amdgcn_exp2f(fmaf(p[r], C2, mnL)); ps += p[r]; }
        { auto rr = __builtin_amdgcn_permlane32_swap(__float_as_uint(ps), __float_as_uint(ps), false, false); ps = __uint_as_float(rr[0]) + __uint_as_float(rr[1]); }
        l_reg = l_reg * alpha + ps;
        bf16x8 pa0, pa1;
#define PK4(P, B_, OUT) do { unsigned a0 = cvtpk(P[B_+0], P[B_+1]), a1 = cvtpk(P[B_+2], P[B_+3]); unsigned b0 = cvtpk(P[B_+4], P[B_+5]), b1 = cvtpk(P[B_+6], P[B_+7]); \
        auto r0 = __builtin_amdgcn_permlane32_swap(a0, b0, false, false); auto r1 = __builtin_amdgcn_permlane32_swap(a1, b1, false, false); \
        u32x4 w = {r0[0], r1[0], r0[1], r1[1]}; OUT = *reinterpret_cast<bf16x8*>(&w); } while (0)
        PK4(p, 0, pa0); PK4(p, 8, pa1);
#undef PK4
        if constexpr (LATE) { *(bf16x8*)pp_l = pa0; *(bf16x8*)(pp_l + 1024) = pa1; }
        else { if (hf == 0) pv_half<0>(o, pa0, pa1, vcur); else pv_half<1>(o, pa0, pa1, vcur); }
    }
}

template <bool LATE_>
__device__ __forceinline__ void causal_fullv_block_impl(const Blk2& cur, char* lds) {
    const int tid = opaque_tid(), wid = __builtin_amdgcn_readfirstlane(tid >> 6), lane = tid & 63, r32 = lane & 31, hi = lane >> 5;
    char* V_lds = lds; char* K_lds = lds + NVB * SHM_V2;
    float* ws = (float*)(lds + 132096) + wid * 64; float* li_l = ws; float* al_l = ws + 32;
    const int NT = (cur.P0 + QB) / KVBLK;
    const int qlo = cur.P0 + wid * QBLK, qm = qlo + r32 - 4 * hi;
    const int vb0 = (int)(uintptr_t)V_lds + v_rd_base(lane);
    unsigned koff[2];
#pragma unroll
    for (int e = 0; e < 2; ++e) { const int rl = 4 * e + (lane >> 4), c = (lane & 15) ^ (rl & 7); koff[e] = (unsigned)((8 * wid + rl) * LDKV + c * 8) * 2u; }
    const int kkl = (lane & 31) >> 2, klane = ((kkl >> 2) << 3) | (kkl & 3);
    const unsigned voff = (unsigned)((klane + 16 * (wid >> 1) + 4 * (wid & 1)) * LDKV + 32 * (lane >> 5) + 8 * (lane & 3)) * 2u;
    typedef __attribute__((address_space(3))) unsigned las_u32;
    las_u32* const lds3 = (las_u32*)lds;
#define GLDS(gp, lo) __builtin_amdgcn_global_load_lds((const unsigned*)(gp), (las_u32*)((__attribute__((address_space(3))) char*)lds3 + (lo)), 16, 0, 0)
#define DMA_TILE(k0, bf, vo) do { const char* kp_ = (const char*)(cur.K + (size_t)(k0) * LDKV); const char* vp_ = (const char*)(cur.V + (size_t)(k0) * LDKV) + voff; \
        GLDS(kp_ + koff[0], NVB * SHM_V2 + (bf) * SHM_K + 2048 * wid); GLDS(kp_ + koff[1], NVB * SHM_V2 + (bf) * SHM_K + 2048 * wid + 1024); \
        GLDS(vp_, (vo) + 2048 * wid); GLDS(vp_ + 128, (vo) + 2048 * wid + 1024); GLDS(vp_ + 256, (vo) + 16384 + 2048 * wid); GLDS(vp_ + 384, (vo) + 16384 + 2048 * wid + 1024); } while (0)
#define DMA_WAIT() asm volatile("s_waitcnt vmcnt(0)" ::: "memory")
    bf16x8 qr[8];
#pragma unroll
    for (int d0 = 0; d0 < 8; ++d0) qr[d0] = load8<bf16>(cur.Q + (size_t)(wid * QBLK + r32) * LDQ + d0 * 16 + hi * 8);
    DMA_TILE(0, 0, 0); DMA_WAIT();
    __syncthreads();
    float m_reg = -1e30f, l_reg = 0.f; f32x16 o[8];
#pragma unroll
    for (int d_ = 0; d_ < 8; ++d_) o[d_] = f32x16{};
    constexpr bool late = LATE_;
    char* pp_l = lds + 134144 + (wid & 3) * 2048 + lane * 16;
    if (late) { *(bf16x8*)pp_l = bf16x8{}; *(bf16x8*)(pp_l + 1024) = bf16x8{}; }
    int vo_p = 0, vo_c = 0;
    if (wid >= 4) __builtin_amdgcn_s_setprio(1);
#define NEXT_VO(v) ((v) == (NVB - 1) * SHM_V2 ? 0 : (v) + SHM_V2)
    for (int t = 0; t < NT; t += 2) {
        const int vo_n = NEXT_VO(vo_c), vo_nn = NEXT_VO(vo_n);
        DMA_TILE((t + 1) * KVBLK, 1, vo_n);
        fullv_tile<0, LATE_>(o, m_reg, l_reg, qr, K_lds, vb0 + vo_c, vb0 + vo_p, al_l, t, qlo, qm, r32, hi, pp_l);
        DMA_WAIT();
        __syncthreads();
        if (t + 2 < NT) DMA_TILE((t + 2) * KVBLK, 0, vo_nn);
        fullv_tile<1, LATE_>(o, m_reg, l_reg, qr, K_lds, vb0 + vo_n, vb0 + vo_c, al_l, t + 1, qlo, qm, r32, hi, pp_l);
        DMA_WAIT();
        __syncthreads();
        vo_p = vo_n; vo_c = vo_nn;
    }
    if (late) { const bf16x8 q0 = *(const bf16x8*)pp_l, q1 = *(const bf16x8*)(pp_l + 1024); pv_half<1>(o, q0, q1, vb0 + vo_p); }
#undef NEXT_VO
#undef DMA_TILE
#undef DMA_WAIT
#undef GLDS
#undef NEXT_VO
    __builtin_amdgcn_s_setprio(0);
    if (ATTA_PINGPONG) __syncthreads();
    if (hi == 0) li_l[r32] = l_reg; asm volatile("s_waitcnt lgkmcnt(0)" ::: "memory");
    char* stg = lds + wid * 16384;
#pragma unroll
    for (int r = 0; r < 16; ++r) { const float rl = __builtin_amdgcn_rcpf(li_l[crow(r, hi)]); const int orow = crow(r, hi);
#pragma unroll
        for (int d0 = 0; d0 < 8; ++d0) { const float v = o[d0][r] * rl; *(unsigned short*)(stg + orow * 512 + (d0 * 32 + r32) * 2) = (unsigned short)cvtpk(v, v); } }
    asm volatile("s_waitcnt lgkmcnt(0)" ::: "memory");
    bf16* Ow = cur.O + (size_t)(wid * QBLK) * LDO;
#pragma unroll
    for (int i = 0; i < 16; ++i) { const int row = 2 * i + (lane >> 5), ch = lane & 31;
        const u32x4 v = *(const u32x4*)(stg + row * 512 + ch * 16); store16_wt(Ow + (size_t)row * LDO + ch * 8, v); }
    __syncthreads();
}
__device__ __forceinline__ void causal_fullv_block(const Blk2& cur, char* lds) {
    const int wid_ = __builtin_amdgcn_readfirstlane(opaque_tid() >> 6);
    if (ATTA_PINGPONG && wid_ >= ATTA_LATE_FROM) causal_fullv_block_impl<true>(cur, lds); else causal_fullv_block_impl<false>(cur, lds);
}
#undef KSWZ
#undef SBAR
}

namespace attB {
typedef short bf16x8 __attribute__((ext_vector_type(8)));
typedef short s16x4 __attribute__((ext_vector_type(4)));
typedef float f32x16 __attribute__((ext_vector_type(16)));
typedef unsigned u32x4 __attribute__((ext_vector_type(4)));
typedef unsigned short bf16_t;
constexpr int HD = 64, LD = NQKV_B, KOFF = 2048, VOFF = 2304, LDO = DM;
constexpr int LDS_K = 0, LDS_V = 32768, LDS_S = 65536, LDS_O = 69632, LDS_BYTES = LDS_O + 8 * 4096;
constexpr float C2 = 0.125f * 1.4426950408889634f;
__device__ __forceinline__ int crow(int r, int hi) { return (r & 3) + 8 * (r >> 2) + 4 * hi; }
__device__ __forceinline__ unsigned cvtpk(float lo, float hi) { unsigned r; asm volatile("v_cvt_pk_bf16_f32 %0, %1, %2" : "=v"(r) : "v"(lo), "v"(hi)); return r; }
typedef short v4i16_t __attribute__((ext_vector_type(4)));
__device__ __forceinline__ s16x4 vtr(LAS const unsigned char* p) { return __builtin_bit_cast(s16x4, __builtin_amdgcn_ds_read_tr16_b64_v4i16((LAS v4i16_t*)p)); }

__device__ __forceinline__ void swa_unit(int b, int kvh, int n, const bf16_t* __restrict__ QKV, const float* __restrict__ sinks, bf16_t* __restrict__ O, LAS unsigned char* lds) {
    const int tid = opaque_tid(), lane = tid & 63, r32 = lane & 31, hi = lane >> 5, wid = __builtin_amdgcn_readfirstlane(tid >> 6);
    __syncthreads();
    const size_t tok0 = (size_t)b * SEQ;
#pragma unroll
    for (int i = 0; i < 4; ++i) {
        const int c = tid + 512 * i, row = c >> 3, ch = c & 7, t = n * 128 - 128 + row;
        u32x4 kv = {0u, 0u, 0u, 0u}, vv = {0u, 0u, 0u, 0u};
        if (t >= 0) { const bf16_t* p = QKV + (tok0 + (size_t)t) * LD + kvh * HD + ch * 8; kv = *(const u32x4*)(p + KOFF); vv = *(const u32x4*)(p + VOFF); }
        *(LAS u32x4*)(lds + LDS_K + row * 128 + ((ch ^ ((row >> 1) & 7)) << 4)) = kv;
        *(LAS u32x4*)(lds + LDS_V + row * 128 + (ch << 4)) = vv;
    }
    __syncthreads();
    const int hq = kvh * 8 + wid;
    const float sink2 = sinks[hq] * 1.4426950408889634f;
    LAS float* scr = (LAS float*)(lds + LDS_S) + wid * 32;
    const int vq = (lane & 15) >> 2, vp = lane & 3, vg1 = (lane >> 4) & 1;
    LAS const unsigned char* vbase = lds + LDS_V + (4 * hi + vq) * 128 + (16 * vg1 + 4 * vp) * 2;
    const float NEG = -__builtin_inff();
    for (int qs = 0; qs < 4; ++qs) {
        const size_t tq = tok0 + (size_t)(n * 128 + 32 * qs + r32);
        bf16x8 qr[4];
#pragma unroll
        for (int d0 = 0; d0 < 4; ++d0) qr[d0] = *(const bf16x8*)(QKV + tq * LD + hq * HD + d0 * 16 + hi * 8);
        f32x16 p[5];
#pragma unroll
        for (int tt = 0; tt < 5; ++tt) {
            const int kt = qs + tt; const bool dead = (n == 0) && (kt < 4);
            p[tt] = f32x16{};
            if (!dead) { const int krow = kt * 32 + r32;
#pragma unroll
                for (int d0 = 0; d0 < 4; ++d0) { const bf16x8 kf = *(LAS const bf16x8*)(lds + LDS_K + krow * 128 + (((d0 * 2 + hi) ^ ((krow >> 1) & 7)) << 4));
                    p[tt] = __builtin_amdgcn_mfma_f32_32x32x16_bf16(kf, qr[d0], p[tt], 0, 0, 0); } }
#pragma unroll
            for (int r = 0; r < 16; ++r) { const int c = crow(r, hi); bool valid = !dead;
                if (tt == 0) valid = valid && (c > r32);
                if (tt == 4) valid = valid && (c <= r32);
                p[tt][r] = valid ? p[tt][r] * C2 : NEG; }
        }
        float mx = sink2;
#pragma unroll
        for (int tt = 0; tt < 5; ++tt)
#pragma unroll
            for (int r = 0; r < 16; ++r) mx = fmaxf(mx, p[tt][r]);
        mx = half_max32(mx);
        float sum = 0.f;
#pragma unroll
        for (int tt = 0; tt < 5; ++tt)
#pragma unroll
            for (int r = 0; r < 16; ++r) { const float e = __builtin_amdgcn_exp2f(p[tt][r] - mx); p[tt][r] = e; sum += e; }
        sum = half_sum32(sum);
        sum += __builtin_amdgcn_exp2f(sink2 - mx);
        if (hi == 0) scr[r32] = 1.0f / sum;
        f32x16 o[2]; o[0] = f32x16{}; o[1] = f32x16{};
#pragma unroll
        for (int tt = 0; tt < 5; ++tt) {
            const int kt = qs + tt; const bool dead = (n == 0) && (kt < 4);
            if (!dead) {
#pragma unroll
                for (int s = 0; s < 2; ++s) {
                    u32x4 w; w.x = cvtpk(p[tt][8 * s + 0], p[tt][8 * s + 1]); w.y = cvtpk(p[tt][8 * s + 2], p[tt][8 * s + 3]); w.z = cvtpk(p[tt][8 * s + 4], p[tt][8 * s + 5]); w.w = cvtpk(p[tt][8 * s + 6], p[tt][8 * s + 7]);
                    const bf16x8 pa = __builtin_bit_cast(bf16x8, w);
#pragma unroll
                    for (int d0 = 0; d0 < 2; ++d0) { LAS const unsigned char* vp_ = vbase + (kt * 32 + 16 * s) * 128 + d0 * 64;
                        const s16x4 lo = vtr(vp_), hh = vtr(vp_ + 8 * 128);
                        const bf16x8 vf = {lo[0], lo[1], lo[2], lo[3], hh[0], hh[1], hh[2], hh[3]};
                        o[d0] = __builtin_amdgcn_mfma_f32_32x32x16_bf16(pa, vf, o[d0], 0, 0, 0); }
                }
            }
        }
        bf16_t* Ow = O + (tok0 + (size_t)(n * 128 + 32 * qs)) * LDO + hq * HD;
        LAS unsigned char* stg = lds + LDS_O + wid * 4096;
#pragma unroll
        for (int r = 0; r < 16; ++r) { const int orow = crow(r, hi); const float ri = scr[orow];
#pragma unroll
            for (int d0 = 0; d0 < 2; ++d0) { const float v = o[d0][r] * ri; *(LAS unsigned short*)(stg + orow * 128 + (d0 * 32 + r32) * 2) = (unsigned short)cvtpk(v, v); } }
        asm volatile("s_waitcnt lgkmcnt(0)" ::: "memory");
#pragma unroll
        for (int i = 0; i < 4; ++i) { const int row = 8 * i + (lane >> 3), ch = lane & 7;
            const u32x4 v = *(LAS const u32x4*)(stg + row * 128 + ch * 16); store16_wt(Ow + (size_t)row * LDO + ch * 8, v); }
    }
}
}

constexpr int NWAVES = 8;
#ifndef MK_PER_PHASE
#define MK_PER_PHASE 0
#endif
constexpr int N_PHASES = 3 + 8 * DEPTH;

constexpr size_t MiB = 1u << 20;
constexpr size_t WS_CTL = 0, CTL_ZERO_BYTES = 1 * MiB;
constexpr size_t WS_STATS = 1198 * MiB;
constexpr size_t WS_MOD = 2 * MiB;
constexpr size_t WS_TABA = 3 * MiB;
constexpr size_t WS_TABB = 5 * MiB;
constexpr size_t WS_BPERM = 6 * MiB;
constexpr size_t WS_WUP = 8 * MiB, WS_WDN = 40 * MiB, WS_WMLP_STRIDE = 64 * MiB;
constexpr size_t WS_WQKVA = 264 * MiB, WS_WOA = 288 * MiB, WS_WA_STRIDE = 32 * MiB;
constexpr size_t WS_WQKVB = 328 * MiB, WS_WOB = 338 * MiB, WS_WB_STRIDE = 18 * MiB;
constexpr size_t WS_X = 364 * MiB;
constexpr size_t WS_HB = 492 * MiB;
constexpr size_t WS_QKV = 556 * MiB;
constexpr size_t WS_AO = 748 * MiB;
constexpr size_t WS_AC = 876 * MiB;
constexpr size_t WS_HID = 940 * MiB;
constexpr size_t WS_CS = 1196 * MiB, WS_CB = 1197 * MiB;
constexpr size_t WS_GN = 6 * MiB + 64 * 1024;
constexpr int CSTRIDE = 8192;
constexpr size_t WS_ZEROS = 768 * 1024;
constexpr size_t WS_ONES = 6 * MiB + 32 * 1024;
constexpr size_t WS_IDENT = 6 * MiB + 48 * 1024;
constexpr size_t WS_IG = 6 * MiB + 640 * 1024;
constexpr size_t WS_NEUTRAL = 1 * MiB;
constexpr size_t WS_PROBE = 7 * MiB;
constexpr size_t WS_QKVB = 1206 * MiB;
constexpr size_t WS_END = 1286 * MiB;
constexpr int CW_TMO = 0, CW_CODE = 1, CW_BAR = 4096;
constexpr int CW_PSUB = 16384, CW_PGEN = 20480;
constexpr int CW_XMASK = 8192, CW_LSUB = 8192 + 1024, CW_LGEN = 8192 + 2048;

constexpr int RING_OFF = 0, RING_BYTES = 131072;
constexpr int LDSCTL_OFF = RING_BYTES, MISC_OFF = LDSCTL_OFF + 320, STATTBL_OFF = LDSCTL_OFF + 1024;
constexpr int LDS_BYTES = 147456;
static_assert(attA::LDS_BYTES <= RING_BYTES && attA::LDS2_BYTES <= RING_BYTES && attB::LDS_BYTES <= RING_BYTES, "attention scratch fits the ring region");

struct Frame {
    LAS unsigned char* lds;
    volatile LAS unsigned* MISC;
    gu32* ctl;
    int vcu, G;
};
#define FR_IDS() const int f_tid = opaque_tid(), f_lane = f_tid & 63, f_wave = __builtin_amdgcn_readfirstlane(f_tid >> 6); (void)f_tid; (void)f_lane; (void)f_wave

__device__ __forceinline__ float wave_sum(float v) {
    v += lane_xor<1>(v); v += lane_xor<2>(v); v += lane_xor<4>(v); v += lane_xor<8>(v); v += lane_xor<16>(v);
    return half_sum32(v);
}
__device__ __forceinline__ float bf2f(unsigned short u) { return __uint_as_float((unsigned)u << 16); }

__device__ __forceinline__ int dest_row(int n, int mode) {
    if (mode == 1 && n < 4096) { const int j = n & 127; return (n & ~127) + (((j & 63) << 1) | (j >> 6)); }
    if (mode == 2 && n < 2304) { const int j = n & 63; return (n & ~63) + (((j & 31) << 1) | (j >> 5)); }
    return n;
}
struct ConvDesc { bf16* dst; int K, mode, n0; };
#ifndef CONV_SHAPE
#define CONV_SHAPE 0
#endif
#if CONV_SHAPE == 0
__device__ __forceinline__ void conv_issue(const float* W, int K, int N, bf16* WT, int mode, int item, int lane, ConvDesc& D, float (&wv)[32]) {
    const int nblk = N / 32, kb = item / nblk, nb = item % nblk, k0 = 64 * kb, n0 = 32 * nb;
    const float* p = W + (size_t)(k0 + (lane >> 5)) * N + n0 + (lane & 31);
#pragma unroll
    for (int i = 0; i < 32; ++i) wv[i] = p[(size_t)(2 * i) * N];
    D.dst = WT + k0; D.K = K; D.mode = mode; D.n0 = n0;
}
__device__ __forceinline__ void conv_finish(const ConvDesc& D, const float (&wv)[32], LAS float* scr, int lane) {
#pragma unroll
    for (int i = 0; i < 32; ++i) { const int kk = 2 * i + (lane >> 5); scr[kk * 33 + (lane & 31)] = wv[i]; }
    LDS_WAIT(); asm volatile("" ::: "memory");
    const int c = lane & 7;
#pragma unroll
    for (int j = 0; j < 4; ++j) { const int n = (lane >> 3) + 8 * j; const LAS float* s = scr + (8 * c) * 33 + n;
        v4u o; o.x = pk2(s[0 * 33], s[1 * 33]); o.y = pk2(s[2 * 33], s[3 * 33]); o.z = pk2(s[4 * 33], s[5 * 33]); o.w = pk2(s[6 * 33], s[7 * 33]);
        *(GAS v4u*)(D.dst + (size_t)dest_row(D.n0 + n, D.mode) * D.K + 8 * c) = o; }
    LDS_WAIT(); asm volatile("" ::: "memory");
}
#else
__device__ __forceinline__ void conv_issue(const float* W, int K, int N, bf16* WT, int mode, int item, int lane, ConvDesc& D, float (&wv)[32]) {
    const int nblk = N / 64, kb = item / nblk, nb = item % nblk, k0 = 32 * kb, n0 = 64 * nb;
    const float* p = W + (size_t)k0 * N + n0 + lane;
#pragma unroll
    for (int i = 0; i < 32; ++i) wv[i] = p[(size_t)i * N];
    D.dst = WT + k0; D.K = K; D.mode = mode; D.n0 = n0;
}
__device__ __forceinline__ void conv_finish(const ConvDesc& D, const float (&wv)[32], LAS float* scr, int lane) {
#pragma unroll
    for (int i = 0; i < 32; ++i) scr[i * 65 + lane] = wv[i];
    LDS_WAIT(); asm volatile("" ::: "memory");
    const int c = lane & 3;
#pragma unroll
    for (int j = 0; j < 4; ++j) { const int n = (lane >> 2) + 16 * j; const LAS float* s = scr + (8 * c) * 65 + n;
        v4u o; o.x = pk2(s[0 * 65], s[1 * 65]); o.y = pk2(s[2 * 65], s[3 * 65]); o.z = pk2(s[4 * 65], s[5 * 65]); o.w = pk2(s[6 * 65], s[7 * 65]);
        *(GAS v4u*)(D.dst + (size_t)dest_row(D.n0 + n, D.mode) * D.K + 8 * c) = o; }
    LDS_WAIT(); asm volatile("" ::: "memory");
}
#endif
__device__ __forceinline__ void sincos_d(double x, double& sn, double& cs) {
    const double k = __builtin_rint(x * 0.63661977236758134308);
    double r = __builtin_fma(-k, 1.57079632673412561417e+00, x); r = __builtin_fma(-k, 6.07710050650619224932e-11, r);
    const double r2 = r * r;
    double ps = -1.0 / 1307674368000.0; ps = ps * r2 + 1.0 / 6227020800.0; ps = ps * r2 - 1.0 / 39916800.0; ps = ps * r2 + 1.0 / 362880.0; ps = ps * r2 - 1.0 / 5040.0; ps = ps * r2 + 1.0 / 120.0; ps = ps * r2 - 1.0 / 6.0; ps = ps * r2 * r + r;
    double pc = 1.0 / 20922789888000.0; pc = pc * r2 - 1.0 / 87178291200.0; pc = pc * r2 + 1.0 / 479001600.0; pc = pc * r2 - 1.0 / 3628800.0; pc = pc * r2 + 1.0 / 40320.0; pc = pc * r2 - 1.0 / 720.0; pc = pc * r2 + 1.0 / 24.0; pc = pc * r2 - 0.5; pc = pc * r2 + 1.0;
    const int q = (int)k & 3;
    sn = (q == 0) ? ps : (q == 1) ? pc : (q == 2) ? -ps : -pc;
    cs = (q == 0) ? pc : (q == 1) ? -ps : (q == 2) ? -pc : ps;
}
__device__ __forceinline__ void rope_entry(float* tab, int idx, int half, double base_ratio) {
    const int s = idx / half, j = idx % half;
    double inv = 1.0, rr = base_ratio;
    for (int t = j; t; t >>= 1) { if (t & 1) inv *= rr; rr *= rr; }
    const float invf = (float)inv, angf = (float)s * invf;
    double sn, cs; sincos_d((double)angf, sn, cs);
    tab[2 * (size_t)idx] = (float)cs; tab[2 * (size_t)idx + 1] = (float)sn;
}

struct Args { const float* in[22]; float* out; unsigned char* ws; int ph_lo, ph_hi; };
typedef __attribute__((address_space(4))) const Args CArgs;

constexpr int CONV_ITEMS = 4 * 16384 + 2 * 8192 + 2 * 4608;
constexpr int CONV_NOW = 16384 + 8192 + 4608;
constexpr int CONV_LATER = CONV_ITEMS - CONV_NOW;
__device__ __forceinline__ int now_item(int d) { return d < 16384 ? d : d < 24576 ? 65536 + (d - 16384) : 81920 + (d - 24576); }
__device__ __forceinline__ void convert_issue(CArgs* ap, int it, int lane, ConvDesc& D, float (&wv)[32]) {
    unsigned char* ws = ap->ws;
    int r = it; const float* W; bf16* WT; int K, N, mode = 0, item;
    if (r < 65536) { const int L = r >> 14, rr = r & 16383;
        if (rr < 8192) { W = ap->in[8] + (size_t)L * DM * DFF; K = DM; N = DFF; WT = (bf16*)(ws + WS_WUP + L * WS_WMLP_STRIDE); item = rr; }
        else { W = ap->in[9] + (size_t)L * DFF * DM; K = DFF; N = DM; WT = (bf16*)(ws + WS_WDN + L * WS_WMLP_STRIDE); item = rr - 8192; } }
    else { r -= 65536;
        if (r < 16384) { const int j = r >> 13, rr = r & 8191;
            if (rr < 6144) { W = ap->in[10] + (size_t)j * DM * NQKV_A; K = DM; N = NQKV_A; WT = (bf16*)(ws + WS_WQKVA + j * WS_WA_STRIDE); mode = 1; item = rr; }
            else { W = ap->in[11] + (size_t)j * DM * DM; K = DM; N = DM; WT = (bf16*)(ws + WS_WOA + j * WS_WA_STRIDE); item = rr - 6144; } }
        else { r -= 16384; const int j = r / 4608, rr = r % 4608;
            if (rr < 2560) { W = ap->in[17] + (size_t)j * DM * NQKV_B; K = DM; N = NQKV_B; WT = (bf16*)(ws + WS_WQKVB + j * WS_WB_STRIDE); mode = 2; item = rr; }
            else { W = ap->in[20] + (size_t)j * DM * DM; K = DM; N = DM; WT = (bf16*)(ws + WS_WOB + j * WS_WB_STRIDE); item = rr - 2560; } } }
    conv_issue(W, K, N, WT, mode, item, lane, D, wv);
}
__device__ __forceinline__ void convert_item(CArgs* ap, int it, LAS float* scr, int lane) {
    ConvDesc D; float wv[32]; convert_issue(ap, it, lane, D, wv); conv_finish(D, wv, scr, lane);
}
#ifndef CONV_NCH
#define CONV_NCH 4
#endif
constexpr int CONV_CHUNKS = CONV_NCH;
__device__ __forceinline__ int deferred_item(int d) { return d < 49152 ? 16384 + d : d < 57344 ? 73728 + (d - 49152) : 86528 + (d - 57344); }
__device__ __forceinline__ void convert_chunk(CArgs* ap, char* ring, int q) {
    FR_IDS();
#if CONV_PROBE
    if (f_tid == 0) *(unsigned long long*)(ring + 140000) = __builtin_amdgcn_s_memrealtime();
#endif
    LAS float* scr = (LAS float*)(ring + f_wave * 16384);
    const int gw = (int)blockIdx.x * NWAVES + f_wave, NGW = (int)gridDim.x * NWAVES;
    constexpr int PER = (CONV_LATER + 2048 * CONV_CHUNKS - 1) / (2048 * CONV_CHUNKS);
    const int per = (NGW == 2048) ? PER : (CONV_LATER + NGW * CONV_CHUNKS - 1) / (NGW * CONV_CHUNKS);
    const int d0 = gw + NGW * (q * per);
    ConvDesc da, db; float va[32], vb[32];
    bool ha = d0 < CONV_LATER, hb = false;
    if (ha) convert_issue(ap, deferred_item(d0), f_lane, da, va);
    for (int jj = 0; jj < per; jj += 2) {
        const int d1 = d0 + NGW * (jj + 1), d2 = d0 + NGW * (jj + 2);
        hb = (jj + 1 < per) && d1 < CONV_LATER;
        if (hb) convert_issue(ap, deferred_item(d1), f_lane, db, vb);
        if (ha) conv_finish(da, va, scr, f_lane);
        ha = (jj + 2 < per) && d2 < CONV_LATER;
        if (ha) convert_issue(ap, deferred_item(d2), f_lane, da, va);
        if (hb) conv_finish(db, vb, scr, f_lane);
    }
    __syncthreads();
#if CONV_PROBE
    if (blockIdx.x == PROBE_WG && f_tid == 0) atomicAdd((unsigned long long*)(ap->ws + 512 * 1024 + 64), __builtin_amdgcn_s_memrealtime() - *(unsigned long long*)(ring + 140000));
#endif
}
__device__ __forceinline__ void p0_prologue(Frame& F, CArgs* ap) {
    FR_IDS();
    unsigned char* ws = ap->ws;
    {
        LAS float* cact = (LAS float*)F.lds;
        LAS float* part = (LAS float*)(F.lds + 32768);
        const float* cin = ap->in[1];
        for (int i = f_tid; i < NB * DM; i += NWAVES * 64) { const float c = cin[i]; cact[i] = c / (1.0f + expf(-c)); }
        __syncthreads();
        float* mod = (float*)(ws + WS_MOD);
        for (int it = F.vcu; it < 256; it += F.G) {
            const int L = it >> 6, cb = it & 63;
            if (f_lane < 48) {
                const float* Wp = ap->in[2] + ((size_t)L * DM + 256 * f_wave) * (NMOD * DM) + 192 * cb + 4 * f_lane;
                f32x4 a0 = {0.f, 0.f, 0.f, 0.f}, a1 = a0, a2 = a0, a3 = a0;
#pragma unroll 8
                for (int kk = 0; kk < 256; ++kk) { const f32x4 w = *(const f32x4*)(Wp + (size_t)kk * (NMOD * DM)); const int k = 256 * f_wave + kk;
                    a0 += w * cact[k]; a1 += w * cact[DM + k]; a2 += w * cact[2 * DM + k]; a3 += w * cact[3 * DM + k]; }
                LAS f32x4* pp = (LAS f32x4*)(part + (f_wave * NB) * 192) + f_lane;
                pp[0] = a0; pp[48] = a1; pp[96] = a2; pp[144] = a3;
            }
            __syncthreads();
            for (int o = f_tid; o < NB * 192; o += NWAVES * 64) { const int b = o / 192, cc = o % 192; float s = 0.f;
#pragma unroll
                for (int w = 0; w < 8; ++w) s += part[(w * NB + b) * 192 + cc];
                mod[((size_t)L * NB + b) * (NMOD * DM) + 192 * cb + cc] = s + ap->in[3][(size_t)L * (NMOD * DM) + 192 * cb + cc]; }
            __syncthreads();
        }
    }
    {
        LAS float* scr = (LAS float*)(F.lds + RING_OFF + f_wave * 16384);
        const int gw = F.vcu * NWAVES + f_wave, NGW = F.G * NWAVES;
#if CONV_DEFER
        for (int d = gw; d < CONV_NOW; d += NGW) convert_item(ap, now_item(d), scr, f_lane);
#else
        for (int d = gw; d < CONV_ITEMS; d += NGW) convert_item(ap, d, scr, f_lane);
#endif
    }
    {
        const int gt = F.vcu * (NWAVES * 64) + f_tid, NGT = F.G * NWAVES * 64;
        float* tabA = (float*)(ws + WS_TABA); float* tabB = (float*)(ws + WS_TABB);
        for (int idx = gt; idx < SEQ * 64; idx += NGT) rope_entry(tabA, idx, 64, 0.86596432336006535);
        for (int idx = gt; idx < SEQ * 32; idx += NGT) rope_entry(tabB, idx, 32, 0.74989420933245582);
        for (int idx = gt; idx < DM; idx += NGT) ((float*)(ws + WS_ONES))[idx] = 1.0f;
        if (gt < 8) ((float*)(ws + WS_IDENT))[gt] = (gt & 1) ? 0.f : 1.f;
        for (int idx = gt; idx < MTOK * 16; idx += NGT) ((float*)(ws + WS_NEUTRAL))[idx] = ((idx & 15) == 1) ? 2048.0f * (1.0f - LN_EPS) : 0.f;
        float* bp = (float*)(ws + WS_BPERM);
        for (int idx = gt; idx < 2 * NQKV_B; idx += NGT) { const int j = idx / NQKV_B, n = idx % NQKV_B;
            int src = n; if (n < 2304) { const int p = n & 63; src = (n & ~63) + (p >> 1) + 32 * (p & 1); }
            bp[idx] = ap->in[18][(size_t)j * NQKV_B + src]; }
    }
}
__device__ __forceinline__ void h0_phase(Frame& F, const float* x, const float* sc, const float* sh, bf16* hb, bf16* xb) {
    FR_IDS();
    const int gw = F.vcu * NWAVES + f_wave, NGW = F.G * NWAVES;
    for (int m = gw; m < MTOK; m += NGW) {
        const int b = m / SEQ;
        const GAS f32x4* xr = (const GAS f32x4*)(x + (size_t)m * DM) + f_lane;
        const f32x4* scp = (const f32x4*)(sc + (size_t)b * (NMOD * DM)) + f_lane; const f32x4* shp = (const f32x4*)(sh + (size_t)b * (NMOD * DM)) + f_lane;
        GAS unsigned long long* o8 = (GAS unsigned long long*)(hb + (size_t)m * DM) + f_lane; GAS unsigned long long* x8 = (GAS unsigned long long*)(xb + (size_t)m * DM) + f_lane;
#pragma unroll
        for (int j = 0; j < 8; ++j) { const f32x4 xv = xr[64 * j]; const f32x4 v = xv * (scp[64 * j] + 1.0f) + shp[64 * j];
            o8[64 * j] = (unsigned long long)pk2(v.x, v.y) | ((unsigned long long)pk2(v.z, v.w) << 32);
            x8[64 * j] = (unsigned long long)pk2(xv.x, xv.y) | ((unsigned long long)pk2(xv.z, xv.w) << 32); }
    }
}
__device__ __forceinline__ void final_ln_phase(Frame& F, const float* vin, const float* st, float* xout, const float* g, const float* bln) {
    FR_IDS();
    const int m0 = 256 * (8 * ((int)blockIdx.x & 7) + (((int)blockIdx.x >> 3) & 7)) + ((int)blockIdx.x >> 6) * 64 + f_wave * 8;
    for (int m = m0; m < m0 + 8; ++m) {
        float mu, r; pg8::row_mu_r(st, m, mu, r);
        const GAS f32x4* xr = (const GAS f32x4*)(vin + (size_t)m * DM) + f_lane;
        const f32x4* gp = (const f32x4*)g + f_lane; const f32x4* bp = (const f32x4*)bln + f_lane;
        GAS f32x4* xo = (GAS f32x4*)(xout + (size_t)m * DM) + f_lane;
#pragma unroll
        for (int j = 0; j < 8; ++j) xo[64 * j] = (xr[64 * j] - mu) * r * gp[64 * j] + bp[64 * j];
    }
}
__device__ __forceinline__ void fold_phase(Frame& F, CArgs* ap, int s_lo, int s_hi, bool gn) {
    FR_IDS();
    unsigned char* ws = ap->ws;
    LAS float* GL = (LAS float*)F.lds;
    const float* mod = (const float*)(ws + WS_MOD);
    for (int s = 0; s < 7; ++s) {
        const bool do_c = s >= s_lo && s < s_hi, do_g = gn && F.vcu == s;
        if (!do_c && !do_g) continue;
        const int L = s >> 1, odd = s & 1, Lc = L + odd;
        const float* g = (odd ? ap->in[6] : ap->in[4]) + (size_t)L * DM; const float* bl = (odd ? ap->in[7] : ap->in[5]) + (size_t)L * DM;
        const float* mc = mod + (size_t)Lc * NB * NMOD * DM + (odd ? 0 : 3 * DM);
        __syncthreads();
        {
            const int k = 4 * f_tid;
            const f32x4 gv = *(const f32x4*)(g + k), blv = *(const f32x4*)(bl + k);
            f32x4 scv[NB], shv[NB];
#pragma unroll
            for (int b = 0; b < NB; ++b) { scv[b] = *(const f32x4*)(mc + (size_t)b * NMOD * DM + DM + k) + 1.0f; shv[b] = *(const f32x4*)(mc + (size_t)b * NMOD * DM + k); }
#pragma unroll
            for (int b = 0; b < NB; ++b) { const f32x4 G = gv * scv[b];
                *(LAS f32x4*)(GL + b * DM + k) = G; *(LAS f32x4*)(GL + (4 + b) * DM + k) = blv * scv[b] + shv[b];
                if (do_g) { *(f32x4*)((float*)(ws + WS_GN) + ((size_t)s * NB + b) * DM + k) = G;
                    *(f32x4*)((float*)(ws + WS_IG) + ((size_t)s * NB + b) * DM + k) = (f32x4){1.0f / scv[b][0], 1.0f / scv[b][1], 1.0f / scv[b][2], 1.0f / scv[b][3]}; } }
        }
        __syncthreads();
        if (!do_c) continue;
        const bf16* Wt; int N;
        if (!odd) { Wt = (const bf16*)(ws + WS_WUP + Lc * WS_WMLP_STRIDE); N = DFF; }
        else if (Lc & 1) { Wt = (const bf16*)(ws + WS_WQKVB + (Lc >> 1) * WS_WB_STRIDE); N = NQKV_B; }
        else { Wt = (const bf16*)(ws + WS_WQKVA + (Lc >> 1) * WS_WA_STRIDE); N = NQKV_A; }
        float* cs = (float*)(ws + WS_CS) + (size_t)s * NB * CSTRIDE; float* cb = (float*)(ws + WS_CB) + (size_t)s * NB * CSTRIDE;
        const int n0 = F.vcu * NWAVES + f_wave, NGW = F.G * NWAVES;
        for (int nb = n0; nb < N; nb += 4 * NGW) {
            v4u wv[4][4];
#pragma unroll
            for (int j = 0; j < 4; ++j) { const int n = nb + j * NGW < N ? nb + j * NGW : nb;
#pragma unroll
                for (int i = 0; i < 4; ++i) wv[j][i] = *(const GAS v4u*)(Wt + (size_t)n * DM + 8 * (f_lane + 64 * i)); }
#pragma unroll
            for (int j = 0; j < 4; ++j) { const int n = nb + j * NGW; if (n >= N) break;
                asm volatile("" ::: "memory");
                float a[8] = {0.f, 0.f, 0.f, 0.f, 0.f, 0.f, 0.f, 0.f};
#pragma unroll
                for (int i = 0; i < 4; ++i) { const int k0 = 8 * (f_lane + 64 * i); const v4u w4 = wv[j][i];
                    float w[8]; w[0] = __uint_as_float(w4.x << 16); w[1] = __uint_as_float(w4.x & 0xffff0000u); w[2] = __uint_as_float(w4.y << 16); w[3] = __uint_as_float(w4.y & 0xffff0000u);
                    w[4] = __uint_as_float(w4.z << 16); w[5] = __uint_as_float(w4.z & 0xffff0000u); w[6] = __uint_as_float(w4.w << 16); w[7] = __uint_as_float(w4.w & 0xffff0000u);
#pragma unroll
                    for (int v = 0; v < 8; ++v) { const f32x4 g0 = *(const LAS f32x4*)(GL + v * DM + k0), g1 = *(const LAS f32x4*)(GL + v * DM + k0 + 4);
                        a[v] += (w[0] * g0[0] + w[1] * g0[1]) + (w[2] * g0[2] + w[3] * g0[3]) + (w[4] * g1[0] + w[5] * g1[1]) + (w[6] * g1[2] + w[7] * g1[3]); } }
#pragma unroll
                for (int v = 0; v < 8; ++v) a[v] = wave_sum(a[v]);
                if (f_lane == 0) {
#pragma unroll
                    for (int b = 0; b < 4; ++b) { cs[(size_t)b * CSTRIDE + n] = a[b]; cb[(size_t)b * CSTRIDE + n] = a[4 + b]; } }
            }
        }
    }
    __syncthreads();
}
__device__ __forceinline__ void combine_phase(Frame& F, const bf16* AO, bf16* AC, const float* lq1, const float* lk1, const float* lq2, const float* lk2, const float* gsub, float lam_init) {
    FR_IDS();
    const float d1 = wave_sum(lq1[f_lane] * lk1[f_lane] + lq1[f_lane + 64] * lk1[f_lane + 64]);
    const float d2 = wave_sum(lq2[f_lane] * lk2[f_lane] + lq2[f_lane + 64] * lk2[f_lane + 64]);
    const float lam = expf(d1) - expf(d2) + lam_init;
    const f32x4 gs = *((const f32x4*)gsub + f_lane) * (1.0f - lam_init);
    const int m0 = 256 * (8 * ((int)blockIdx.x & 7) + (((int)blockIdx.x >> 3) & 7)) + ((int)blockIdx.x >> 6) * 64 + f_wave * 8;
    for (int m = m0; m < m0 + 8; ++m) {
        const GAS unsigned long long* ip = (const GAS unsigned long long*)(AO + (size_t)m * (2 * DM)) + f_lane;
        GAS unsigned long long* op = (GAS unsigned long long*)(AC + (size_t)m * DM) + f_lane;
        unsigned long long r1[8], r2[8];
#pragma unroll
        for (int h = 0; h < 8; ++h) { r1[h] = ip[(2 * h) * 64]; r2[h] = ip[(2 * h + 1) * 64]; }
#pragma unroll
        for (int h = 0; h < 8; ++h) {
            f32x4 d;
            d.x = bf2f((unsigned short)(r1[h])) - lam * bf2f((unsigned short)(r2[h]));
            d.y = bf2f((unsigned short)(r1[h] >> 16)) - lam * bf2f((unsigned short)(r2[h] >> 16));
            d.z = bf2f((unsigned short)(r1[h] >> 32)) - lam * bf2f((unsigned short)(r2[h] >> 32));
            d.w = bf2f((unsigned short)(r1[h] >> 48)) - lam * bf2f((unsigned short)(r2[h] >> 48));
            const float ss = wave_sum((d.x * d.x + d.y * d.y) + (d.z * d.z + d.w * d.w));
            const float r = 1.f / sqrtf(ss * (1.f / 256.f) + LN_EPS);
            const f32x4 o = d * r * gs;
            op[h * 64] = (unsigned long long)pk2(o.x, o.y) | ((unsigned long long)pk2(o.z, o.w) << 32);
        }
    }
}
typedef attA::bf16 abf;
typedef attA::BlockRef<abf, abf> ARef;
__device__ __forceinline__ ARef attA_ref(const bf16* QKV, bf16* AO, int L, int pass) {
    const int k = L >> 3, xcd = L & 7, gi = k >> 5, r = k & 31;
    const int grp = gi * 8 + xcd, b = grp >> 3, hp = grp & 7;
    const int hq = 2 * hp + (r & 1), vh = (r >> 1) & 1, x = r >> 2;
    const int qb = pass ? 15 - x : x;
    const abf* base = (const abf*)QKV + (size_t)b * SEQ * NQKV_A;
    ARef R; R.Q = base + (size_t)qb * 256 * NQKV_A + hq * 128; R.K = base + DM + hq * 128; R.V = base + 2 * DM + hp * 256 + vh * 128;
    R.O = (abf*)AO + ((size_t)b * SEQ + (size_t)qb * 256) * (2 * DM) + hq * 256 + vh * 128; R.P0 = qb * 256;
    return R;
}
__device__ __forceinline__ void attnA_phase(char* lds, const bf16* QKV, bf16* AO) {
    const int total = 1024, stride = (int)gridDim.x;
    int L = blockIdx.x; if (L >= total) return;
    int pass = 0;
    ARef cur = attA_ref(QKV, AO, L, 0);
    attA::Seam<abf> S;
    attA::causal_swa_prime<abf, abf>(cur, SEQ, lds, S);
    for (;;) {
        const bool more_pass = pass == 0, more_item = L + stride < total, last = !more_pass && !more_item;
        int passn = pass + 1, Ln = L;
        if (!more_pass) { passn = 0; Ln = more_item ? L + stride : L; }
        const ARef nxt = last ? cur : attA_ref(QKV, AO, Ln, passn);
        attA::causal_swa_block<abf, abf>(cur, nxt, SEQ, SEQ, lds, S);
        if (last) break;
        cur = nxt; pass = passn; L = Ln;
    }
}
constexpr int CW_READY = 24576;
constexpr int CW_FOLD2 = CW_READY + 16 * 64 * DEPTH;
constexpr int CW_QDONE = CW_FOLD2 + 16;
constexpr int CW_TDONE = CW_QDONE + 16 * 64 * DEPTH;
__device__ __forceinline__ void wait_panels(unsigned* base, int npan, unsigned expected, unsigned* bar) {
    const int t = opaque_tid();
    if (t < 64) {
        unsigned sp = 0;
        for (;;) { const unsigned c = t < npan ? xb_ld(base + 16 * t) : expected;
            if (__builtin_amdgcn_ballot_w64(c < expected) == 0ull) break;
            __builtin_amdgcn_s_sleep(1);
            if ((++sp & 255u) == 0u) { if (xb_ld(&bar[XB_TMO])) break; if (sp > XB_SPIN_CAP) { if (t == 0) atomicAdd(&bar[XB_TMO], 1u); break; } } }
        if (t == 0) { __builtin_amdgcn_fence(__ATOMIC_ACQUIRE, "agent"); asm volatile("s_waitcnt vmcnt(0)" ::: "memory"); }
    }
    __syncthreads();
}
__device__ __forceinline__ void signal_ready2(unsigned* cnt, unsigned* cnt2) {
    asm volatile("s_waitcnt vmcnt(0)" ::: "memory");
    __syncthreads();
    if (threadIdx.x == 0) { (void)xb_add(cnt, 1u); if (cnt2) (void)xb_add(cnt2, 1u); }
}
__device__ __forceinline__ void signal_ready(unsigned* cnt) {
    asm volatile("s_waitcnt vmcnt(0)" ::: "memory");
    __syncthreads();
    if (threadIdx.x == 0) (void)xb_add(cnt, 1u);
}
__device__ __forceinline__ void signal_ready_fenced(unsigned* cnt) {
    asm volatile("s_waitcnt vmcnt(0)" ::: "memory");
    __syncthreads();
    if (threadIdx.x == 0) { __builtin_amdgcn_fence(__ATOMIC_RELEASE, "agent"); asm volatile("s_waitcnt vmcnt(0)" ::: "memory"); (void)xb_add(cnt, 1u); }
}
__device__ __forceinline__ void wait_ready(unsigned* cnt, unsigned expected, unsigned* bar) {
    if (threadIdx.x == 0) { XB_SPIN(xb_ld(cnt) < expected, bar); __builtin_amdgcn_fence(__ATOMIC_ACQUIRE, "agent"); asm volatile("s_waitcnt vmcnt(0)" ::: "memory"); }
    __syncthreads();
}
__device__ __forceinline__ void attnA2_phase(char* lds, const bf16* QKV, bf16* AO, CArgs* ap, bool defer, unsigned* ready, unsigned* qdone, unsigned* tdone, unsigned* bar) {
    const int total = 512, stride = (int)gridDim.x;
    int cq = 0;
    for (int L = blockIdx.x; L < total; L += stride) {
        const int k = L >> 3, xcd = L & 7, r = k & 15, grp = (k >> 4) * 8 + xcd, b = grp >> 3, hp = grp & 7, hq = 2 * hp + (r & 1), x = r >> 1;
        const abf* base = (const abf*)QKV + (size_t)b * SEQ * NQKV_A;
#pragma unroll 1
        for (int pass = 0; pass < 2; ++pass) { const int qb = pass ? 15 - x : x;
            attA::Blk2 B; B.Q = base + (size_t)qb * 256 * NQKV_A + hq * 128; B.K = base + DM + hq * 128; B.V = base + 2 * DM + hp * 256;
            B.O = (abf*)AO + ((size_t)b * SEQ + (size_t)qb * 256) * (2 * DM) + hq * 256; B.P0 = qb * 256;
            if (qdone) wait_panels(qdone + 16 * 16 * b, qb + 1, 4u, bar);
            attA::causal_fullv_block(B, lds);
            if (ready) signal_ready2(ready + 16 * (b * 16 + qb), tdone ? tdone + 16 * b : (unsigned*)nullptr);
            if (defer && (CONV_CHUNKS == 4 || pass == 0) && cq < CONV_CHUNKS) { convert_chunk(ap, lds, cq); ++cq; }
        }
    }
    if (defer) for (; cq < CONV_CHUNKS; ++cq) convert_chunk(ap, lds, cq);
}
__device__ __forceinline__ void attnB_phase(Frame& F, const bf16* QKV, const float* sinks, bf16* AC, unsigned* ready, unsigned* qdone, unsigned* tdone, unsigned* bar) {
    for (int u = F.vcu; u < NB * 4 * 32; u += F.G) { const int n = u & 31, kvh = (u >> 5) & 3, b = u >> 7;
        if (qdone) { const int p1 = n >> 1, p0 = n > 0 ? (n - 1) >> 1 : p1; wait_panels(qdone + 16 * (16 * b + p0), p1 - p0 + 1, 4u, bar); }
        attB::swa_unit(b, kvh, n, QKV, sinks, AC, F.lds);
        if (ready) signal_ready2(ready + 16 * (b * 16 + (n >> 1)), tdone ? tdone + 16 * b : (unsigned*)nullptr); }
    __syncthreads();
}

#ifndef SITES
#define SITES 0xffff
#endif
#ifndef PG8_PROBE
#define PG8_PROBE 0
#endif
#ifndef PROBE_LAYER
#define PROBE_LAYER 1
#endif
#ifndef PROBE_SITE
#define PROBE_SITE 0
#endif
#define PROBE_KT (PROBE_SITE == 1 ? 128 : 32)
#ifndef PROBE_DUP
#define PROBE_DUP 0
#endif
#define NREP(bit) ((PROBE_DUP & (bit)) ? 2 : 1)
#define DUMMY_F32 ((float*)WSP(WS_AO))
__device__ __forceinline__ CArgs* kargs() { CArgs* p = (CArgs*)__builtin_amdgcn_kernarg_segment_ptr(); asm volatile("" : "+s"(p)); return p; }
#define AIN(i) (kargs()->in[i])
#define WSP(off) (kargs()->ws + (off))
__host__ __device__ __forceinline__ int panel_of(int c) { return 8 * (c & 7) + ((c >> 3) & 7); }
__device__ __forceinline__ int stage_panel(const float* st, LAS float* mrt) {
    const int pm = panel_of((int)blockIdx.x);
    pg8::stage_mu_r((LAS pg8::f32x2v*)mrt, st, pm, opaque_tid()); return pm;
}
#ifndef STAGGER_TICKS
#define STAGGER_TICKS 0
#endif
__device__ __forceinline__ void phase_stagger() {
    const unsigned long long want = (unsigned long long)(blockIdx.x >> 5) * STAGGER_TICKS, t0 = __builtin_amdgcn_s_memrealtime();
    while (__builtin_amdgcn_s_memrealtime() - t0 < want) __builtin_amdgcn_s_sleep(4);
}
__device__ __forceinline__ void xcc_local_barrier(unsigned* ctl, unsigned x, unsigned* bar) {
    asm volatile("s_waitcnt vmcnt(0)" ::: "memory");
    __syncthreads();
    if (threadIdx.x == 0) {
        __builtin_amdgcn_s_waitcnt(0);
        const unsigned old = xb_add(&ctl[CW_LSUB + 64 * x], 1u), gen = old >> 5;
        if ((old & 31u) == 31u) xb_add(&ctl[CW_LGEN + 64 * x], 1u);
        else XB_SPIN(xb_ld(&ctl[CW_LGEN + 64 * x]) == gen, bar);
        __builtin_amdgcn_fence(__ATOMIC_ACQUIRE, "agent");
        asm volatile("s_waitcnt vmcnt(0)" ::: "memory");
    }
    __syncthreads();
}
__device__ __forceinline__ void panel_barrier(unsigned* ctl, unsigned pm, unsigned* bar) {
    asm volatile("s_waitcnt vmcnt(0)" ::: "memory");
    __syncthreads();
    if (threadIdx.x == 0) {
        __builtin_amdgcn_s_waitcnt(0);
        const unsigned old = xb_add(&ctl[CW_PSUB + 64 * pm], 1u), gen = old >> 2;
        if ((old & 3u) == 3u) xb_add(&ctl[CW_PGEN + 64 * pm], 1u);
        else XB_SPIN(xb_ld(&ctl[CW_PGEN + 64 * pm]) == gen, bar);
        __builtin_amdgcn_fence(__ATOMIC_ACQUIRE, "agent");
        asm volatile("s_waitcnt vmcnt(0)" ::: "memory");
    }
    __syncthreads();
}
#ifndef CHAIN_STAGGER_TICKS
#define CHAIN_STAGGER_TICKS 0
#endif
__device__ __forceinline__ void chain_stagger() {
    const unsigned long long want = (unsigned long long)((blockIdx.x >> 3) & 7) * CHAIN_STAGGER_TICKS, t0 = __builtin_amdgcn_s_memrealtime();
    while (__builtin_amdgcn_s_memrealtime() - t0 < want) __builtin_amdgcn_s_sleep(2);
}
__global__ void __launch_bounds__(NWAVES * 64, 2) fwd_kernel(Args args_unused) {
    extern __shared__ __attribute__((aligned(16))) unsigned char lds[];
    Frame F;
    F.lds = (LAS unsigned char*)lds;
    F.MISC = (volatile LAS unsigned*)(F.lds + MISC_OFF);
    F.G = gridDim.x; { const int bx = blockIdx.x; F.vcu = (F.G % 8 == 0) ? (bx % 8) * (F.G / 8) + bx / 8 : bx; }
    F.ctl = (gu32*)WSP(WS_CTL);
    for (int u = threadIdx.x; u < (LDS_BYTES - LDSCTL_OFF) / 4; u += NWAVES * 64) ((LAS unsigned*)(F.lds + LDSCTL_OFF))[u] = 0u;
    __syncthreads();
    const int lo = kargs()->ph_lo, hi = kargs()->ph_hi;
    XcdBarrier bar; bar.bar = (unsigned*)(F.ctl + CW_BAR); bar.x = 0; bar.st = nullptr;
    if (hi - lo > 1) bar = xcd_barrier_post((unsigned*)(F.ctl + CW_BAR), F.MISC + 8);
    if (hi - lo > 1 && threadIdx.x == 0) (void)__hip_atomic_fetch_or((unsigned*)F.ctl + CW_XMASK + 64 * bar.x, 1u << (blockIdx.x & 7), __ATOMIC_RELAXED, __HIP_MEMORY_SCOPE_AGENT);
    bool local_ok = false;
#define IN(k) (lo <= (k) && (k) < hi)
#if PG8_PROBE == 5
    unsigned long long pr_bar = 0;
#ifndef PROBE_BARSET
#define PROBE_BARSET 0xff
#endif
#define SEAM(k) do { if ((k) + 1 < hi) { const unsigned long long t0_ = __builtin_amdgcn_s_memrealtime(); xcd_barrier(bar); const int k_ = (k); const int cls_ = k_ < 2 ? k_ : (((k_ - 2) & 7) == 0 ? 2 : ((k_ - 2) & 7) == 1 ? 3 : ((k_ - 2) & 7) == 2 ? 4 : ((k_ - 2) & 7) == 3 ? 5 : ((k_ - 2) & 7) == 5 ? 6 : 7); const unsigned long long dt_ = __builtin_amdgcn_s_memrealtime() - t0_; if ((PROBE_BARSET >> cls_) & 1) pr_bar += dt_; if (threadIdx.x == 0) atomicMax((unsigned*)WSP(520 * 1024) + k_, ~(unsigned)dt_); } } while (0)
#else
#define SEAM(k) do { if ((k) + 1 < hi) xcd_barrier(bar); } while (0)
#endif

#define MOD_ ((float*)WSP(WS_MOD))
#define X_ ((float*)WSP(WS_X))
#define HB_ ((bf16*)WSP(WS_HB))
#define QKV_ ((bf16*)WSP(WS_QKV))
#define QKVB_ ((bf16*)WSP(WS_QKVB))
#define READY_(L) ((unsigned*)F.ctl + CW_READY + 16 * 64 * (L))
#define QDONE_(L) ((unsigned*)F.ctl + CW_QDONE + 16 * 64 * (L))
#define TDONE_(L) ((unsigned*)F.ctl + CW_TDONE + 16 * NB * (L))
#define AO_ ((bf16*)WSP(WS_AO))
#define AC_ ((bf16*)WSP(WS_AC))
#define HID_ ((bf16*)WSP(WS_HID))
#define STATS_(s) ((float*)WSP(WS_STATS) + (size_t)(s) * MTOK * 16)
#define MRT_ ((LAS float*)(F.lds + STATTBL_OFF))
#define CS_(s) ((const float*)WSP(WS_CS) + (size_t)(s) * NB * CSTRIDE)
#define CB_(s) ((const float*)WSP(WS_CB) + (size_t)(s) * NB * CSTRIDE)
#define GN_(s) ((const float*)WSP(WS_GN) + (size_t)(s) * NB * DM)
#define ZEROS_ ((const float*)WSP(WS_ZEROS))
#define ONES_ ((const float*)WSP(WS_ONES))
#define IG_(s) ((const float*)WSP(WS_IG) + (size_t)(s) * NB * DM)
#define NEUTRAL_ ((const float*)WSP(WS_NEUTRAL))
#define XB_ ((bf16*)WSP(WS_X))
    constexpr size_t MODL = (size_t)NB * NMOD * DM;
    constexpr int MODB = NMOD * DM;

#if SITES & 1
    if (IN(0)) { for (int rep = 0; rep < NREP(1); ++rep) { p0_prologue(F, kargs()); if (NREP(1) > 1) __syncthreads(); } SEAM(0); }
    if (lo == 0 && hi > 1 && F.G == 256) {
        if (threadIdx.x == 0) { unsigned seen = 0u, good = 1u;
            for (unsigned j = 0; j < 16; ++j) { const unsigned c = xb_ld(&bar.bar[XB_XCNT(j)]), m = xb_ld((unsigned*)F.ctl + CW_XMASK + 64 * j);
                if (c == 0u && m == 0u) continue; if (c != 32u || (m & (m - 1u)) != 0u || (seen & m) != 0u) good = 0u; seen |= m; }
            F.MISC[12] = (good && seen == 0xffu) ? 1u : 0u; }
        __syncthreads(); local_ok = F.MISC[12] != 0u; __syncthreads();
    }
#ifdef NO_LOCAL_BARRIERS
    local_ok = false;
#endif
#define SEAM_L(k) do { if ((k) + 1 < hi) { if (local_ok) panel_barrier((unsigned*)F.ctl, (unsigned)panel_of((int)blockIdx.x), bar.bar); else xcd_barrier(bar); } } while (0)
#endif
#if SITES & 4096
    if (IN(1)) { for (int rep = 0; rep < NREP(4096); ++rep) { h0_phase(F, AIN(0), MOD_ + 1 * DM, MOD_ + 0 * DM, HB_, XB_); fold_phase(F, kargs(), 0, CONV_DEFER ? 2 : 7, true); } SEAM(1); }
#endif

    for (int L = 0; L < DEPTH; ++L) {
        const int pb = 2 + 8 * L, j = L >> 1;
#define MODL_ (MOD_ + (size_t)L * MODL)
        if ((L & 1) == 0) {
#if SITES & 8
            if (IN(pb + 0)) for (int rep = 0; rep < NREP(2); ++rep) {
                if (QKV_DATAFLOW && L >= 2 && rep == 0) wait_ready(TDONE_(L - 2) + 16 * (panel_of((int)blockIdx.x) >> 4), 256u, bar.bar);
                pg8::Gemm g{HB_, (const bf16*)WSP(WS_WQKVA + j * WS_WA_STRIDE), MTOK, NQKV_A, DM};
#if PG8_PROBE
                if (L == PROBE_LAYER && PROBE_SITE == 2) g.probe = (unsigned long long*)WSP(WS_PROBE);
#endif
                pg8::StaticOrder S; S.init(MTOK, NQKV_A, F.G, (int)blockIdx.x);
                pg8::EpiQKV<128> E{QKV_, NQKV_A, ZEROS_, (const float*)WSP(WS_TABA), (const float*)WSP(WS_IDENT), 16, SEQ - 1, L == 0 ? (const float*)WSP(WS_NEUTRAL) : (const float*)STATS_(2 * L - 1), L == 0 ? ZEROS_ : CS_(2 * L - 1), L == 0 ? ZEROS_ : CB_(2 * L - 1), L == 0 ? 0 : CSTRIDE, 12, MRT_, stage_panel(L == 0 ? (const float*)WSP(WS_NEUTRAL) : (const float*)STATS_(2 * L - 1), MRT_)};
                if (STAGGER_TICKS) phase_stagger();
            pg8::gemm_phase<pg8::EpiQKV<128>, pg8::StaticOrder, true, true>(F.lds + RING_OFF, g, S, E);
                if (rep == NREP(2) - 1) { if (QKV_DATAFLOW) signal_ready(QDONE_(L) + 16 * panel_of((int)blockIdx.x)); else SEAM(pb + 0); }
            }
#endif
#if SITES & 2
            if (IN(pb + 1)) { for (int rep = 0; rep < NREP(4); ++rep) {
#if ATTA_FULLV
#if PG8_PROBE == 7 || PG8_PROBE == 8
                const unsigned long long pa_r0 = __builtin_amdgcn_s_memrealtime(), pa_c0 = __builtin_amdgcn_s_memtime();
#endif
                attnA2_phase((char*)lds + RING_OFF, QKV_, AO_, kargs(), CONV_DEFER && L == 0 && rep == 0, (DATAFLOW && rep == NREP(4) - 1) ? READY_(L) : (unsigned*)nullptr, QKV_DATAFLOW ? QDONE_(L) : (unsigned*)nullptr, QKV_DATAFLOW ? TDONE_(L) : (unsigned*)nullptr, bar.bar);
#if PG8_PROBE == 7 || PG8_PROBE == 8
                if (L == 2 && blockIdx.x == 0 && threadIdx.x == 0) { unsigned long long* pr = (unsigned long long*)WSP(WS_PROBE); pr[3] = __builtin_amdgcn_s_memrealtime() - pa_r0; pr[4] = __builtin_amdgcn_s_memtime() - pa_c0; }
#endif
#else
                attnA_phase((char*)lds + RING_OFF, QKV_, AO_);
#endif
            } if (!DATAFLOW || (L0_ATT_GLOBAL && L == 0)) SEAM(pb + 1); }
#endif
#if SITES & 512
            if (IN(pb + 2)) {
                if (CONV_DEFER && FOLD2_AT_C0 && L == 0) { fold_phase(F, kargs(), 2, 7, false); signal_ready_fenced((unsigned*)F.ctl + CW_FOLD2); }
                if (DATAFLOW) wait_ready(READY_(L) + 16 * panel_of((int)blockIdx.x), 16u, bar.bar);
                if (DATAFLOW && XCC_ALIGN && local_ok) xcc_local_barrier((unsigned*)F.ctl, (unsigned)blockIdx.x & 7u, bar.bar);
                if (local_ok && CHAIN_STAGGER_TICKS) chain_stagger();
                const float lam_init = (L == 0) ? 0.2f : 0.47071301658633585f;
                for (int rep = 0; rep < NREP(8); ++rep) combine_phase(F, AO_, AC_, AIN(12) + j * 128, AIN(13) + j * 128, AIN(14) + j * 128, AIN(15) + j * 128, AIN(16) + j * 256, lam_init);
                SEAM_L(pb + 2);
            }
#endif
#if SITES & 16
            if (IN(pb + 3)) for (int rep = 0; rep < NREP(16); ++rep) {
                pg8::Gemm g{AC_, (const bf16*)WSP(WS_WOA + j * WS_WA_STRIDE), MTOK, DM, DM};
#if PG8_PROBE
                if (L == PROBE_LAYER && PROBE_SITE == 3) g.probe = (unsigned long long*)WSP(WS_PROBE);
#endif
                pg8::StaticOrder S; S.init(MTOK, DM, F.G, (int)blockIdx.x);
                pg8::EpiResid E{L == 0 ? (const bf16*)XB_ : (const bf16*)HB_, L == 0 ? ONES_ : IG_(2 * L - 1), L == 0 ? 0 : DM, L == 0 ? NEUTRAL_ : (const float*)STATS_(2 * L - 1), L == 0 ? ONES_ : AIN(6) + (L - 1) * DM, L == 0 ? ZEROS_ : AIN(7) + (L - 1) * DM,
                                 (float*)nullptr, STATS_(2 * L), HB_, GN_(2 * L), DM, DM, MODL_ + 2 * DM, MODB, ZEROS_, ALPHA, 12, MRT_, stage_panel(L == 0 ? NEUTRAL_ : (const float*)STATS_(2 * L - 1), MRT_)};
                if (STAGGER_TICKS) phase_stagger();
            pg8::gemm_phase<pg8::EpiResid, pg8::StaticOrder, true, true>(F.lds + RING_OFF, g, S, E);
                if (rep == NREP(16) - 1) SEAM_L(pb + 3);
            }
#endif
        } else {
#if SITES & 32
            if (IN(pb + 0)) for (int rep = 0; rep < NREP(32); ++rep) {
                if (QKV_DATAFLOW && L >= 2 && rep == 0) wait_ready(TDONE_(L - 2) + 16 * (panel_of((int)blockIdx.x) >> 4), 128u, bar.bar);
                pg8::Gemm g{HB_, (const bf16*)WSP(WS_WQKVB + j * WS_WB_STRIDE), MTOK, NQKV_B, DM}; pg8::StaticOrder S; S.init(MTOK, NQKV_B, F.G, (int)blockIdx.x);
                pg8::EpiQKV<64> E{QKVB_, NQKV_B, (const float*)WSP(WS_BPERM) + j * NQKV_B, (const float*)WSP(WS_TABB), (const float*)WSP(WS_IDENT), 9, SEQ - 1, (const float*)STATS_(2 * L - 1), CS_(2 * L - 1), CB_(2 * L - 1), CSTRIDE, 12, MRT_, stage_panel((const float*)STATS_(2 * L - 1), MRT_)};
                if (STAGGER_TICKS) phase_stagger();
            pg8::gemm_phase<pg8::EpiQKV<64>, pg8::StaticOrder, true, true>(F.lds + RING_OFF, g, S, E);
                if (rep == NREP(32) - 1) { if (QKV_DATAFLOW) signal_ready(QDONE_(L) + 16 * panel_of((int)blockIdx.x)); else SEAM(pb + 0); }
            }
#endif
#if SITES & 4
            if (IN(pb + 1) && CONV_DEFER && L == 1 && !FOLD2_AT_C0) {
                fold_phase(F, kargs(), 2, 7, false); signal_ready_fenced((unsigned*)F.ctl + CW_FOLD2); }
            if (IN(pb + 1)) { for (int rep = 0; rep < NREP(64); ++rep) attnB_phase(F, QKVB_, AIN(19) + j * 32, AC_, (DATAFLOW && rep == NREP(64) - 1) ? READY_(L) : (unsigned*)nullptr, QKV_DATAFLOW ? QDONE_(L) : (unsigned*)nullptr, QKV_DATAFLOW ? TDONE_(L) : (unsigned*)nullptr, bar.bar); if (!DATAFLOW) SEAM(pb + 1); }
#endif
#if SITES & 64
            if (IN(pb + 3)) for (int rep = 0; rep < NREP(128); ++rep) {
                if (DATAFLOW && rep == 0) wait_ready(READY_(L) + 16 * panel_of((int)blockIdx.x), 8u, bar.bar);
                if (DATAFLOW && XCC_ALIGN && local_ok && rep == 0) xcc_local_barrier((unsigned*)F.ctl, (unsigned)blockIdx.x & 7u, bar.bar);
                if (local_ok && CHAIN_STAGGER_TICKS) chain_stagger();
                pg8::Gemm g{AC_, (const bf16*)WSP(WS_WOB + j * WS_WB_STRIDE), MTOK, DM, DM}; pg8::StaticOrder S; S.init(MTOK, DM, F.G, (int)blockIdx.x);
                pg8::EpiResid E{(const bf16*)HB_, IG_(2 * L - 1), DM, (const float*)STATS_(2 * L - 1), AIN(6) + (L - 1) * DM, AIN(7) + (L - 1) * DM,
                                 (float*)nullptr, STATS_(2 * L), HB_, GN_(2 * L), DM, DM, MODL_ + 2 * DM, MODB, AIN(21) + j * DM, ALPHA, 12, MRT_, stage_panel((const float*)STATS_(2 * L - 1), MRT_)};
                if (STAGGER_TICKS) phase_stagger();
            pg8::gemm_phase<pg8::EpiResid, pg8::StaticOrder, true, true>(F.lds + RING_OFF, g, S, E);
                if (rep == NREP(128) - 1) SEAM_L(pb + 3);
            }
#endif
        }
#if SITES & 128
        if (IN(pb + 5)) for (int rep = 0; rep < NREP(512); ++rep) {
            if (CONV_DEFER && L == 1 && rep == 0) wait_ready((unsigned*)F.ctl + CW_FOLD2, gridDim.x, bar.bar);
            pg8::Gemm g{HB_, (const bf16*)WSP(WS_WUP + L * WS_WMLP_STRIDE), MTOK, DFF, DM};
#if PG8_PROBE
            if (L == PROBE_LAYER && PROBE_SITE == 0) g.probe = (unsigned long long*)WSP(WS_PROBE);
#endif
            pg8::StaticOrder S; S.init(MTOK, DFF, F.G, (int)blockIdx.x);
            pg8::EpiRelu2 E{HID_, DFF, (const float*)STATS_(2 * L), CS_(2 * L), CB_(2 * L), CSTRIDE, 12, MRT_, stage_panel((const float*)STATS_(2 * L), MRT_), QKV_};
            if (STAGGER_TICKS) phase_stagger();
            pg8::gemm_phase<pg8::EpiRelu2, pg8::StaticOrder, true, true>(F.lds + RING_OFF, g, S, E);
            if (rep == NREP(512) - 1) SEAM_L(pb + 5);
        }
#endif
#if SITES & 256
        if (IN(pb + 6)) for (int rep = 0; rep < NREP(1024); ++rep) {
            pg8::Gemm g{HID_, (const bf16*)WSP(WS_WDN + L * WS_WMLP_STRIDE), MTOK, DM, DFF};
#if PG8_PROBE
            if (L == PROBE_LAYER && PROBE_SITE == 1) g.probe = (unsigned long long*)WSP(WS_PROBE);
#endif
            pg8::StaticOrder S; S.init(MTOK, DM, F.G, (int)blockIdx.x);
            pg8::EpiResid E{(const bf16*)HB_, IG_(2 * L), DM, (const float*)STATS_(2 * L), AIN(4) + L * DM, AIN(5) + L * DM,
                             L == DEPTH - 1 ? X_ : (float*)nullptr, STATS_(2 * L + 1), L == DEPTH - 1 ? (bf16*)nullptr : HB_, GN_(2 * L + 1), DM, DM, MODL_ + 5 * DM, MODB, ZEROS_, ALPHA, 12, MRT_, stage_panel((const float*)STATS_(2 * L), MRT_)};
            if (STAGGER_TICKS) phase_stagger();
            pg8::gemm_phase<pg8::EpiResid, pg8::StaticOrder, true, true>(F.lds + RING_OFF, g, S, E);
            if (rep == NREP(1024) - 1) { if (CONV_DEFER && (!DATAFLOW || L0_DOWN_GLOBAL) && L == 0) SEAM(pb + 6); else SEAM_L(pb + 6); }
        }
#endif
    }
    if (IN(2 + 8 * DEPTH)) final_ln_phase(F, X_, STATS_(2 * DEPTH - 1), kargs()->out, AIN(6) + (DEPTH - 1) * DM, AIN(7) + (DEPTH - 1) * DM);
#if PG8_PROBE == 5
    if (threadIdx.x == 0) atomicAdd((unsigned long long*)WSP(512 * 1024), pr_bar);
#endif
#if CONV_PROBE
    if (blockIdx.x == PROBE_WG && threadIdx.x == 0) { const unsigned long long t0 = __builtin_amdgcn_s_memrealtime(), ticks = 5ull * *(const unsigned long long*)WSP(512 * 1024 + 64);
        while (__builtin_amdgcn_s_memrealtime() - t0 < ticks) __builtin_amdgcn_s_sleep(8); }
#endif
#if PG8_PROBE
    if (IN(2 + 8 * DEPTH)) { xcd_barrier(bar);
        if (blockIdx.x == 0 && threadIdx.x == 0) { const unsigned long long* pr = (const unsigned long long*)WSP(WS_PROBE); float v = 0.f;
            if (PG8_PROBE == 1) v = ((float)pr[4] * 100.0f / (float)pr[3] - 1000.0f) * 0.1f;
            if (PG8_PROBE == 2) v = ((float)pr[0] / (float)(pr[2] * (unsigned long long)PROBE_KT) - 2000.0f) * 0.1f;
            if (PG8_PROBE == 3) v = (float)pr[1] / (float)pr[2] * 0.01f;
            if (PG8_PROBE == 5) v = (float)(*(const unsigned long long*)WSP(512 * 1024)) / (float)gridDim.x * 0.001f;
            if (PG8_PROBE == 5 && PROBE_BARSET == 0) { unsigned sum = 0; for (int i = 0; i < N_PHASES; ++i) { const unsigned w = ((const unsigned*)WSP(520 * 1024))[i]; if (w) sum += ~w; } v = (float)sum * 0.001f; }
            if (PG8_PROBE == 7) v = ((float)pr[4] * 100.0f / (float)pr[3] - 1000.0f) * 0.1f;
            if (PG8_PROBE == 8) v = (float)pr[3] * 0.001f;
            if (PG8_PROBE == 9 || PG8_PROBE == 10) v = ((float)pr[0] / (float)(pr[2] - 1) - 4000.0f) * 0.05f;
            if (PG8_PROBE == 11) v = (float)(*(const unsigned long long*)WSP(512 * 1024 + 64)) * 0.01f;
            if (PG8_PROBE == 4) v = (float)pr[3] * 0.001f;
            { const unsigned long long t0 = __builtin_amdgcn_s_memrealtime(); const unsigned long long ticks = (unsigned long long)(fmaxf(v, 0.f) * 500.0f);
              while (__builtin_amdgcn_s_memrealtime() - t0 < ticks) __builtin_amdgcn_s_sleep(8); } } }
#endif
#undef IN
#undef SEAM
}

extern "C" void kernel_launch(void* const* d_in, const int* in_sizes, int n_in, void* d_out, int out_size, void* d_ws, size_t ws_size, hipStream_t stream) {
    static int grid = 0;
    if (grid == 0) {
        if (n_in != 22 || in_sizes[0] != MTOK * DM || out_size != MTOK * DM || ws_size < WS_END) {
            fprintf(stderr, "kernel_launch: unexpected shapes (n_in %d, in0 %d, out %d, ws %zu; need ws >= %zu); nothing launched\n", n_in, n_in > 0 ? in_sizes[0] : -1, out_size, ws_size, (size_t)WS_END); grid = -1; return; }
        int dev = 0, cus = 0, per_cu = 0;
        if (hipGetDevice(&dev) != hipSuccess || hipDeviceGetAttribute(&cus, hipDeviceAttributeMultiprocessorCount, dev) != hipSuccess) { fprintf(stderr, "kernel_launch: device query failed\n"); grid = -1; return; }
        if (hipFuncSetAttribute((const void*)fwd_kernel, hipFuncAttributeMaxDynamicSharedMemorySize, LDS_BYTES) != hipSuccess) { fprintf(stderr, "kernel_launch: hipFuncSetAttribute failed\n"); grid = -1; return; }
        if (hipOccupancyMaxActiveBlocksPerMultiprocessor(&per_cu, (const void*)fwd_kernel, NWAVES * 64, LDS_BYTES) != hipSuccess || per_cu < 1)
            fprintf(stderr, "kernel_launch: note: occupancy query reports %d workgroups per CU\n", per_cu);
        (void)hipGetLastError();
        grid = cus;
        { const int Ns[5] = {NQKV_A, NQKV_B, DM, DFF, DM}; bool ok = true;
          if (grid != 256) ok = false;
          for (int gi = 0; gi < 5 && ok; ++gi) for (int c = 0; c < grid && ok; ++c) { pg8::StaticOrder S; S.init(MTOK, Ns[gi], grid, c); pg8::Unit u;
              for (int i = 0; S.next(i, u); ++i) if (u.pm != panel_of(c)) { ok = false; break; } }
          if (!ok) { fprintf(stderr, "kernel_launch: unit order does not keep a workgroup on one row panel for a grid of %d; nothing launched\n", grid); grid = -1; return; } }
    }
    if (grid < 0) return;
    if (hipMemsetAsync((char*)d_ws + WS_CTL, 0, CTL_ZERO_BYTES, stream) != hipSuccess) { fprintf(stderr, "kernel_launch: memset failed\n"); return; }
    Args a{};
    for (int i = 0; i < 22; ++i) a.in[i] = (const float*)d_in[i];
    a.out = (float*)d_out; a.ws = (unsigned char*)d_ws;
#if MK_PER_PHASE
    for (int p = 0; p < N_PHASES; ++p) {
        if (p >= 2 && p < 2 + 8 * DEPTH) { const int sl = (p - 2) & 7, Lp = (p - 2) >> 3; if (sl == 4 || sl == 7 || (sl == 2 && (Lp & 1))) continue; }
        a.ph_lo = p; a.ph_hi = p + 1;
        hipLaunchKernelGGL(fwd_kernel, dim3(grid), dim3(NWAVES * 64), LDS_BYTES, stream, a);
    }
#else
    a.ph_lo = 0; a.ph_hi = N_PHASES;
    hipLaunchKernelGGL(fwd_kernel, dim3(grid), dim3(NWAVES * 64), LDS_BYTES, stream, a);
#endif
    const hipError_t le = hipPeekAtLastError();
    if (le != hipSuccess) fprintf(stderr, "kernel_launch: launch failed: %s\n", hipGetErrorName(le));
}
```

```cpp
#include <hip/hip_runtime.h>
#include <hip/hip_bf16.h>
#include <cstdio>
#include <cstdint>

constexpr int DM = 2048, NB = 4, SEQ = 4096, DEPTH = 4, MTOK = NB * SEQ, DFF = 8192;
constexpr int NQKV_A = 3 * DM;
constexpr int NQKV_B = 2560;
constexpr float LN_EPS = 1e-5f;
constexpr float ALPHA = 1.681792830507429f;
constexpr int NMOD = 6;
__device__ __forceinline__ int opaque_tid() { int t = (int)threadIdx.x; asm volatile("" : "+v"(t)); return t; }
#ifndef PG8_RELAX
#define PG8_RELAX 0
#endif
#ifndef CONV_PROBE
#define CONV_PROBE 0
#endif
#ifndef PROBE_WG
#define PROBE_WG 0
#endif
#ifndef DATAFLOW
#define DATAFLOW 1
#endif
#ifndef FOLD2_AT_C0
#define FOLD2_AT_C0 1
#endif
#ifndef L0_DOWN_GLOBAL
#define L0_DOWN_GLOBAL 0
#endif
#ifndef XCC_ALIGN
#define XCC_ALIGN 0
#endif
#ifndef QKV_DATAFLOW
#define QKV_DATAFLOW 0
#endif
#ifndef HID_PERM
#define HID_PERM 0
#endif
#ifndef L0_ATT_GLOBAL
#define L0_ATT_GLOBAL 1
#endif
#ifndef CONV_DEFER
#define CONV_DEFER 1
#endif
#ifndef ATTA_FULLV
#define ATTA_FULLV 1
#endif
template <int K> __device__ __forceinline__ float lane_xor(float v) {
    if constexpr (K == 32) { const auto rr = __builtin_amdgcn_permlane32_swap(__float_as_uint(v), __float_as_uint(v), false, false);
        return __uint_as_float(((opaque_tid() & 32) ? rr[0] : rr[1])); }
    else return __uint_as_float((unsigned)__builtin_amdgcn_ds_swizzle((int)__float_as_uint(v), (K << 10) | 0x1F));
}
__device__ __forceinline__ float half_sum32(float v) { const auto rr = __builtin_amdgcn_permlane32_swap(__float_as_uint(v), __float_as_uint(v), false, false); return __uint_as_float(rr[0]) + __uint_as_float(rr[1]); }
__device__ __forceinline__ float half_max32(float v) { const auto rr = __builtin_amdgcn_permlane32_swap(__float_as_uint(v), __float_as_uint(v), false, false); return fmaxf(__uint_as_float(rr[0]), __uint_as_float(rr[1])); }
typedef unsigned wt_u32x4 __attribute__((ext_vector_type(4)));
__device__ __forceinline__ void store16_wt(void* p, wt_u32x4 v) { asm volatile("global_store_dwordx4 %0, %1, off sc1\n\ts_nop 1" :: "v"(p), "v"(v) : "memory"); }
__device__ __forceinline__ void store4_wt(void* p, unsigned v) { asm volatile("global_store_dword %0, %1, off sc1\n\ts_nop 1" :: "v"(p), "v"(v) : "memory"); }

#define GAS __attribute__((address_space(1)))
#define LAS __attribute__((address_space(3)))
typedef unsigned short bf16;
typedef unsigned v4u __attribute__((ext_vector_type(4)));
typedef float f32x4 __attribute__((ext_vector_type(4)));
typedef short bf16x8 __attribute__((ext_vector_type(8)));
typedef GAS unsigned gu32;
typedef GAS unsigned long long gu64;
#define RLX_AGENT __ATOMIC_RELAXED, __HIP_MEMORY_SCOPE_AGENT
#define LDS_WAIT() asm volatile("s_waitcnt lgkmcnt(0)" ::: "memory")
#define VM_WAIT() asm volatile("s_waitcnt vmcnt(0)" ::: "memory")
__device__ __forceinline__ unsigned long long rt() { return __builtin_amdgcn_s_memrealtime(); }
__device__ __forceinline__ unsigned f2bf(float f) { unsigned u = __builtin_bit_cast(unsigned, f); return (u + 0x7fffu + ((u >> 16) & 1u)) >> 16; }
__device__ __forceinline__ unsigned pk2(float lo, float hi) { return f2bf(lo) | (f2bf(hi) << 16); }

#define XB_TMO      128
#define XB_XCNT(j)  (256  + 64 * (j))
#define XB_XSUB(j)  (1280 + 64 * (j))
#define XB_XGEN(j)  (2304 + 64 * (j))
#define XB_TOP      3328
#define XB_TOPGEN   3392
#define XCD_BAR_WORDS 3456
#define XB_SPIN_CAP (1u << 18)

__device__ __forceinline__ unsigned xb_ld(unsigned* p)              { return __hip_atomic_load(p, __ATOMIC_RELAXED, __HIP_MEMORY_SCOPE_AGENT); }
__device__ __forceinline__ unsigned xb_add(unsigned* p, unsigned v) { return __hip_atomic_fetch_add(p, v, __ATOMIC_RELAXED, __HIP_MEMORY_SCOPE_AGENT); }
__device__ __forceinline__ unsigned xb_xcc_id() { return (unsigned)__builtin_amdgcn_s_getreg((3 << 11) | 20) & 0xFu; }
#define XB_SPIN(cond, bar) do { unsigned _sp = 0; while (cond) { __builtin_amdgcn_s_sleep(1); \
    if ((++_sp & 255u) == 0u) { if (xb_ld(&(bar)[XB_TMO])) break; if (_sp > XB_SPIN_CAP) { atomicAdd(&(bar)[XB_TMO], 1u); break; } } } } while (0)

struct XcdBarrier {
    unsigned* bar; unsigned x;
    volatile LAS unsigned* st;
};

__device__ __forceinline__ XcdBarrier xcd_barrier_post(unsigned* bar, volatile LAS unsigned* st) {
    XcdBarrier b; b.bar = bar; b.x = xb_xcc_id(); b.st = st;
    if (threadIdx.x == 0) (void)xb_add(&bar[XB_XCNT(b.x)], 1u);
    return b;
}
__device__ __forceinline__ void xcd_barrier_complete(unsigned* bar, unsigned x, unsigned& nloc, unsigned& nx) {
    const unsigned G = gridDim.x * gridDim.y * gridDim.z;
    unsigned sum, cnt, mine, sp = 0u;
    for (;;) {
        sum = 0u; cnt = 0u; mine = 0u;
#pragma unroll
        for (unsigned j = 0; j < 16; ++j) { const unsigned c = xb_ld(&bar[XB_XCNT(j)]); sum += c; cnt += (c > 0u) ? 1u : 0u; mine = (j == x) ? c : mine; }
        if (sum == G) break;
        __builtin_amdgcn_s_sleep(1);
        if ((++sp & 255u) == 0u) { if (xb_ld(&bar[XB_TMO])) break; if (sp > XB_SPIN_CAP) { atomicAdd(&bar[XB_TMO], 1u); break; } }
    }
    nloc = mine > 0u ? mine : 1u; nx = cnt > 0u ? cnt : 1u;
}

__device__ __forceinline__ void xcd_barrier(const XcdBarrier& b) {
    asm volatile("s_waitcnt vmcnt(0)" ::: "memory");
    __syncthreads();
    if (threadIdx.x == 0) {
        unsigned* bar = b.bar;
        __builtin_amdgcn_s_waitcnt(0);
        unsigned nloc = b.st[0], nx = b.st[1];
        unsigned bx = b.x; asm volatile("" : "+s"(bx));
        if (nloc == 0u) { xcd_barrier_complete(bar, bx, nloc, nx); b.st[0] = nloc; b.st[1] = nx; }
        const unsigned old = xb_add(&bar[XB_XSUB(bx)], 1u);
        const unsigned gen = old / nloc;
        if (old + 1u == (gen + 1u) * nloc) {
            __builtin_amdgcn_fence(__ATOMIC_RELEASE, "agent");
            asm volatile("s_waitcnt vmcnt(0)" ::: "memory");
            const unsigned og = xb_add(&bar[XB_TOP], 1u);
            const unsigned tg = og / nx;
            if (og + 1u == (tg + 1u) * nx) xb_add(&bar[XB_TOPGEN], 1u);
            else XB_SPIN(xb_ld(&bar[XB_TOPGEN]) == tg, bar);
            __builtin_amdgcn_fence(__ATOMIC_ACQUIRE, "agent");
            xb_add(&bar[XB_XGEN(bx)], 1u);
            asm volatile("s_waitcnt vmcnt(0)" ::: "memory");
        } else {
            XB_SPIN(xb_ld(&bar[XB_XGEN(bx)]) == gen, bar);
            __builtin_amdgcn_fence(__ATOMIC_ACQUIRE, "agent");
            asm volatile("s_waitcnt vmcnt(0)" ::: "memory");
        }
    }
    __syncthreads();
}

namespace pg8 {
#define PG8_LAS __attribute__((address_space(3)))
typedef unsigned short bf16_t;
typedef short bf16x8 __attribute__((ext_vector_type(8)));
typedef float f32x4 __attribute__((ext_vector_type(4)));
typedef unsigned u32x4 __attribute__((ext_vector_type(4)));
constexpr int BM = 256, BK = 64, HALF = 128, HTB = HALF * BK * 2  , STAGE_BYTES = 8 * HTB, NXCD = 8, WGM = 8;

__host__ __device__ __forceinline__ int lds_byte(int r, int c) { const int st = (r >> 4) * 2 + (c >> 5), rr = r & 15, cc = c & 31, ob = rr * 64 + cc * 2; return st * 1024 + (ob ^ (((ob >> 9) & 1) << 5)); }
__host__ __device__ __forceinline__ void stage_rc(int b, int& R, int& C) { const int st = b / 1024, sb = b % 1024, swz = sb ^ (((sb >> 9) & 1) << 5); R = (st >> 1) * 16 + swz / 64; C = (st & 1) * 32 + (swz % 64) / 2; }
__host__ __device__ __forceinline__ int perm32(int rho) { const int n = rho >> 4, i = rho & 15; return 8 * (i >> 2) + 4 * n + (i & 3); }

struct Unit { int pm, pn; };
struct Gemm { const bf16_t* A; const bf16_t* Bt; int M, N, K; unsigned long long* probe = nullptr; };

struct StaticOrder {
    int nM, nN, nwg, G, c;
    __host__ __device__ void init(int M, int N, int G_, int c_) { nM = M / BM; nN = N / BM; nwg = nM * nN; G = G_; c = c_; }
    __host__ __device__ bool next(int i, Unit& u) const {
        const long L = (long)i * G + c; if (L >= nwg) return false;
        int wgid = (int)L; { const int q = nwg / NXCD, r = nwg % NXCD, xcd = wgid % NXCD, off = wgid / NXCD; wgid = (xcd < r ? xcd * (q + 1) : r * (q + 1) + (xcd - r) * q) + off; }
        const int nig = WGM * nN, gid = wgid / nig, fm = gid * WGM, gsz = (nM - fm) < WGM ? (nM - fm) : WGM;
        u.pm = fm + ((wgid % nig) % gsz); u.pn = (wgid % nig) / gsz; return true;
    }
    __device__ __forceinline__ void a_ready(const Unit&) const {}
    __device__ __forceinline__ void done(const Unit&) const {}
};

__device__ __forceinline__ unsigned cvt_pk_bf16(float lo, float hi) { unsigned r; asm volatile("v_cvt_pk_bf16_f32 %0, %1, %2" : "=v"(r) : "v"(lo), "v"(hi)); return r; }
typedef float f32x2 __attribute__((ext_vector_type(2)));

typedef float f32x2v __attribute__((ext_vector_type(2)));
typedef unsigned u32x2v __attribute__((ext_vector_type(2)));
constexpr float kInvD = 1.0f / 2048.0f, kEps = 1e-5f;
__device__ __forceinline__ void row_mu_r(const float* st, int row, float& mu, float& r) {
    const f32x4* p = (const f32x4*)(st + 16 * (size_t)row); const f32x4 a = p[0], b = p[1], c = p[2], d = p[3];
    const float s = ((a[0] + a[2]) + (b[0] + b[2])) + ((c[0] + c[2]) + (d[0] + d[2])), q = ((a[1] + a[3]) + (b[1] + b[3])) + ((c[1] + c[3]) + (d[1] + d[3]));
    mu = s * kInvD; const float var = fmaxf(q * kInvD - mu * mu, 0.f); r = __builtin_amdgcn_rsqf(var + kEps);
}
__device__ __forceinline__ void stage_mu_r(PG8_LAS f32x2v* mr, const float* st, int pm, int t) {
    if (t < 256) { float mu, r; row_mu_r(st, pm * BM + t, mu, r); mr[t] = (f32x2v){mu, r}; }
    asm volatile("s_waitcnt lgkmcnt(0)" ::: "memory"); __builtin_amdgcn_s_barrier(); asm volatile("" ::: "memory");
}
__device__ __forceinline__ u32x4 pack_bf16x8(const f32x4 v0, const f32x4 v1) { u32x4 w; w.x = cvt_pk_bf16(v0[0], v0[1]); w.y = cvt_pk_bf16(v0[2], v0[3]); w.z = cvt_pk_bf16(v1[0], v1[1]); w.w = cvt_pk_bf16(v1[2], v1[3]); return w; }
template <int HD> struct EpiQKV {
    static constexpr bool PERM = true, AFTER_DRAIN = false; static constexpr int NSTORES = 16;
    bf16_t* O; int ldc; const float* bias; const float* tab; const float* ident; int rope_tiles; int seq_mask;
    const float* st; const float* cs; const float* cb; int cstride; int seq_shift; PG8_LAS float* mrt; int staged_pm;
    __device__ __forceinline__ void operator()(f32x4 (&acc)[2][2][4][2], const Unit& u, int wr, int wc, int fr, int fq) const {
        asm volatile("" : "+v"(fr), "+v"(fq));
        const int row0 = u.pm * BM + wr * 64 + fr, col0 = u.pn * BM + wc * 32 + 8 * fq, lrow0 = wr * 64 + fr;
        PG8_LAS f32x2v* mr = (PG8_LAS f32x2v*)mrt; (void)staged_pm;
        const bool rope = u.pn < rope_tiles;
        const char* tbase = rope ? (const char*)tab : (const char*)ident; const unsigned tmul = rope ? (unsigned)(HD * 4) : 0u;
        const size_t cofs = (size_t)((u.pm * BM) >> seq_shift) * cstride + col0;
#pragma unroll
        for (int bj = 0; bj < 2; ++bj) {
            f32x4 bv[2], cbv[2], csv[2];
#pragma unroll
            for (int n = 0; n < 2; ++n) { bv[n] = *(const f32x4*)(bias + col0 + bj * HALF + 4 * n); cbv[n] = *(const f32x4*)(cb + cofs + bj * HALF + 4 * n); csv[n] = *(const f32x4*)(cs + cofs + bj * HALF + 4 * n); }
            const unsigned tcol = rope ? (unsigned)(((col0 + bj * HALF) & (HD - 1)) >> 1) * 8u : 0u;
#pragma unroll
            for (int ai = 0; ai < 2; ++ai) {
                f32x4 tb[4][2];
#pragma unroll
                for (int m = 0; m < 4; ++m) { const unsigned tof = (unsigned)((row0 + ai * HALF + m * 16) & seq_mask) * tmul + tcol;
                    tb[m][0] = *(const f32x4*)(tbase + tof); tb[m][1] = *(const f32x4*)(tbase + tof + 16u); }
                asm volatile("" : "+v"(tb[0][0]), "+v"(tb[0][1]), "+v"(tb[1][0]), "+v"(tb[1][1]), "+v"(tb[2][0]), "+v"(tb[2][1]), "+v"(tb[3][0]), "+v"(tb[3][1]));
                if (ai == 0) { bv[0] += cbv[0]; bv[1] += cbv[1]; }
#pragma unroll
                for (int m = 0; m < 4; ++m) { const f32x2v q = mr[lrow0 + ai * HALF + m * 16]; const float mu = q.x, r = q.y;
                    const f32x4 v0 = (acc[ai][bj][m][0] - csv[0] * mu) * r + bv[0], v1 = (acc[ai][bj][m][1] - csv[1] * mu) * r + bv[1];
                    const f32x4 t0 = tb[m][0], t1 = tb[m][1];
                    acc[ai][bj][m][0] = (f32x4){v0[0] * t0[0] - v0[1] * t0[1], v0[1] * t0[0] + v0[0] * t0[1], v0[2] * t0[2] - v0[3] * t0[3], v0[3] * t0[2] + v0[2] * t0[3]};
                    acc[ai][bj][m][1] = (f32x4){v1[0] * t1[0] - v1[1] * t1[1], v1[1] * t1[0] + v1[0] * t1[1], v1[2] * t1[2] - v1[3] * t1[3], v1[3] * t1[2] + v1[2] * t1[3]}; }
                asm volatile("" : "+v"(acc[ai][bj][0][0]), "+v"(acc[ai][bj][0][1]), "+v"(acc[ai][bj][1][0]), "+v"(acc[ai][bj][1][1]), "+v"(acc[ai][bj][2][0]), "+v"(acc[ai][bj][2][1]), "+v"(acc[ai][bj][3][0]), "+v"(acc[ai][bj][3][1]) :: "memory");
            }
        }
#pragma unroll
        for (int ai = 0; ai < 2; ++ai)
#pragma unroll
            for (int m = 0; m < 4; ++m) { bf16_t* rowp = O + (size_t)(row0 + ai * HALF + m * 16) * ldc + col0;
#pragma unroll
                for (int bj = 0; bj < 2; ++bj) { const u32x4 w_ = pack_bf16x8(acc[ai][bj][m][0], acc[ai][bj][m][1]);
                    if (QKV_DATAFLOW) store16_wt(rowp + bj * HALF, w_); else *(u32x4*)(rowp + bj * HALF) = w_; } }
    }
};
struct EpiRelu2 {
    static constexpr bool PERM = true, AFTER_DRAIN = false; static constexpr int NSTORES = 16;
    bf16_t* O; int ldc; const float* st; const float* cs; const float* cb; int cstride; int seq_shift; PG8_LAS float* mrt; int staged_pm; bf16_t* dup;
    __device__ __forceinline__ void operator()(f32x4 (&acc)[2][2][4][2], const Unit& u, int wr, int wc, int fr, int fq) const {
        asm volatile("" : "+v"(fr), "+v"(fq));
        const int row0 = u.pm * BM + wr * 64 + fr, col0 = u.pn * BM + wc * 32 + 8 * fq, lrow0 = wr * 64 + fr;
        const size_t cofs = (size_t)((u.pm * BM) >> seq_shift) * cstride + col0;
        PG8_LAS f32x2v* mr = (PG8_LAS f32x2v*)mrt; (void)staged_pm;
        f32x4 cbv[2][2], csv[2][2];
#pragma unroll
        for (int bj = 0; bj < 2; ++bj)
#pragma unroll
            for (int n = 0; n < 2; ++n) { cbv[bj][n] = *(const f32x4*)(cb + cofs + bj * HALF + 4 * n); csv[bj][n] = *(const f32x4*)(cs + cofs + bj * HALF + 4 * n); }
        asm volatile("" ::: "memory");
#pragma unroll
        for (int ai = 0; ai < 2; ++ai)
#pragma unroll
            for (int m = 0; m < 4; ++m) { bf16_t* rowp = O + (size_t)(row0 + ai * HALF + m * 16) * ldc + col0; const f32x2v q = mr[lrow0 + ai * HALF + m * 16]; u32x4 wv[2]; (void)rowp; (void)wv;
#pragma unroll
                for (int bj = 0; bj < 2; ++bj) { f32x4 v0 = (acc[ai][bj][m][0] - csv[bj][0] * q.x) * q.y + cbv[bj][0], v1 = (acc[ai][bj][m][1] - csv[bj][1] * q.x) * q.y + cbv[bj][1];
#pragma unroll
                    for (int e = 0; e < 4; ++e) { const float a = fmaxf(v0[e], 0.f), b = fmaxf(v1[e], 0.f); v0[e] = a * a; v1[e] = b * b; }
#if HID_PERM
                    wv[bj] = pack_bf16x8(v0, v1); }
                { const bool lo = fr < 8; const u32x4 snd = lo ? wv[1] : wv[0]; u32x4 rcv;
#pragma unroll
                  for (int e = 0; e < 4; ++e) rcv[e] = (unsigned)__builtin_amdgcn_update_dpp(0, (int)snd[e], 0x128, 0xf, 0xf, false);
                  const u32x4 dA = lo ? wv[0] : rcv, dB = lo ? rcv : wv[1];
                  bf16_t* pA = O + (size_t)(u.pm * BM + wr * 64 + ai * HALF + m * 16 + (fr & 7)) * ldc + u.pn * BM + wc * 64 + (lo ? 0 : 32) + 8 * fq;
                  *(u32x4*)pA = dA; *(u32x4*)(pA + (size_t)8 * ldc) = dB; } }
#else
                    { const u32x4 w_ = pack_bf16x8(v0, v1); *(u32x4*)(rowp + bj * HALF) = w_; } } }
#endif
    }
};
struct EpiResid {
    static constexpr bool PERM = true, AFTER_DRAIN = false; static constexpr int NSTORES = 16;
    const bf16_t* rb; const float* ig; int igstride; const float* pst; const float* pg; const float* pb; float* outf; float* st; bf16_t* hb; const float* gn; int gnstride;
    int ldc; const float* gate; int gstride; const float* bias; float alpha; int seq_shift;
    PG8_LAS float* tbl; int staged_pm;
    __device__ __forceinline__ void operator()(f32x4 (&acc)[2][2][4][2], const Unit& u, int wr, int wc, int fr, int fq) const {
        asm volatile("" : "+v"(fr), "+v"(fq));
        const int lrow0 = wr * 64 + fr, col0 = u.pn * BM + wc * 32 + 8 * fq;
        const int b = (u.pm * BM) >> seq_shift, t = (wr * 4 + wc) * 64 + fq * 16 + fr;
        const float* gb = gate + (size_t)b * gstride + col0; const float* gnb = gn + (size_t)b * gnstride + col0; const float* igb = ig + (size_t)b * igstride + col0;
        PG8_LAS f32x2v* mr = (PG8_LAS f32x2v*)tbl; PG8_LAS f32x2v* ps = (PG8_LAS f32x2v*)tbl + 256;
        (void)staged_pm;
        const unsigned rowb = (unsigned)((u.pm * BM + lrow0) * ldc + col0) * 2u;
        const unsigned rstep = (unsigned)ldc * 32u;
#pragma unroll
        for (int bj = 0; bj < 2; ++bj) { const int c = bj * HALF;
            u32x4 xs[2][4];
#pragma unroll
            for (int ai = 0; ai < 2; ++ai)
#pragma unroll
                for (int m = 0; m < 4; ++m) xs[ai][m] = *(const u32x4*)((const char*)rb + (rowb + (unsigned)(ai * 8 + m) * rstep + (unsigned)c * 2u));
            f32x4 gv[2], c1[2], c2[2], c3[2];
#pragma unroll
            for (int n = 0; n < 2; ++n) { gv[n] = *(const f32x4*)(gb + c + 4 * n); c1[n] = *(const f32x4*)(igb + c + 4 * n); c2[n] = *(const f32x4*)(pg + col0 + c + 4 * n);
                c3[n] = *(const f32x4*)(pb + col0 + c + 4 * n); }
            const f32x4 bz0 = *(const f32x4*)(bias + col0 + c), bz1 = *(const f32x4*)(bias + col0 + c + 4);
            asm volatile("" : "+v"(xs[0][0]), "+v"(xs[0][1]), "+v"(xs[0][2]), "+v"(xs[0][3]), "+v"(xs[1][0]), "+v"(xs[1][1]), "+v"(xs[1][2]), "+v"(xs[1][3]));
#pragma unroll
            for (int n = 0; n < 2; ++n) { gv[n] = gv[n] + 1.0f; c1[n] = c1[n] * alpha  ; c2[n] = c2[n] * alpha; c3[n] = c3[n] * alpha + gv[n] * (n ? bz1 : bz0); }
#pragma unroll
            for (int ai = 0; ai < 2; ++ai)
#pragma unroll
                for (int m = 0; m < 4; ++m) { const f32x2v q = mr[lrow0 + ai * HALF + m * 16]; const u32x4 x = xs[ai][m];
                    const f32x4 x0 = {__uint_as_float(x.x << 16), __uint_as_float(x.x & 0xffff0000u), __uint_as_float(x.y << 16), __uint_as_float(x.y & 0xffff0000u)};
                    const f32x4 x1 = {__uint_as_float(x.z << 16), __uint_as_float(x.z & 0xffff0000u), __uint_as_float(x.w << 16), __uint_as_float(x.w & 0xffff0000u)};
                    acc[ai][bj][m][0] = (x0 * c1[0] - c2[0] * q.x) * q.y + c3[0] + gv[0] * acc[ai][bj][m][0];
                    acc[ai][bj][m][1] = (x1 * c1[1] - c2[1] * q.x) * q.y + c3[1] + gv[1] * acc[ai][bj][m][1]; }
            asm volatile("" : "+v"(acc[0][bj][0][0]), "+v"(acc[0][bj][1][0]), "+v"(acc[0][bj][2][0]), "+v"(acc[0][bj][3][0]), "+v"(acc[1][bj][0][0]), "+v"(acc[1][bj][1][0]), "+v"(acc[1][bj][2][0]), "+v"(acc[1][bj][3][0]),
                              "+v"(acc[0][bj][0][1]), "+v"(acc[0][bj][1][1]), "+v"(acc[0][bj][2][1]), "+v"(acc[0][bj][3][1]), "+v"(acc[1][bj][0][1]), "+v"(acc[1][bj][1][1]), "+v"(acc[1][bj][2][1]), "+v"(acc[1][bj][3][1]) :: "memory");
        }
        unsigned rowb2 = rowb; asm volatile("" : "+v"(rowb2));
#pragma unroll
        for (int ai = 0; ai < 2; ++ai)
#pragma unroll
            for (int m = 0; m < 4; ++m) { const int lrow = lrow0 + ai * HALF + m * 16;
                float s_ = 0.f, q_ = 0.f;
#pragma unroll
                for (int bj = 0; bj < 2; ++bj)
#pragma unroll
                    for (int n = 0; n < 2; ++n) { const f32x4 v = acc[ai][bj][m][n]; s_ += (v[0] + v[1]) + (v[2] + v[3]); q_ += (v[0] * v[0] + v[1] * v[1]) + (v[2] * v[2] + v[3] * v[3]); }
                s_ += lane_xor<16>(s_); s_ = half_sum32(s_); q_ += lane_xor<16>(q_); q_ = half_sum32(q_);
                if (fq == 0) ps[lrow * 4 + wc] = (f32x2v){s_, q_}; }
        if (hb) {
            f32x4 gnv[2][2];
#pragma unroll
            for (int bj = 0; bj < 2; ++bj)
#pragma unroll
                for (int n = 0; n < 2; ++n) gnv[bj][n] = *(const f32x4*)(gnb + bj * HALF + 4 * n);
#pragma unroll
            for (int ai = 0; ai < 2; ++ai)
#pragma unroll
                for (int m = 0; m < 4; ++m) { const unsigned ob = rowb2 + (unsigned)(ai * 8 + m) * rstep;
#pragma unroll
                    for (int bj = 0; bj < 2; ++bj) *(u32x4*)((char*)hb + (ob + (unsigned)bj * 256u)) = pack_bf16x8(acc[ai][bj][m][0] * gnv[bj][0], acc[ai][bj][m][1] * gnv[bj][1]); }
        } else {
#pragma unroll
            for (int ai = 0; ai < 2; ++ai)
#pragma unroll
                for (int m = 0; m < 4; ++m) { const unsigned ob = (rowb2 + (unsigned)(ai * 8 + m) * rstep) * 2u;
#pragma unroll
                    for (int bj = 0; bj < 2; ++bj) { *(f32x4*)((char*)outf + (ob + (unsigned)bj * 512u)) = acc[ai][bj][m][0]; *(f32x4*)((char*)outf + (ob + (unsigned)bj * 512u + 16u)) = acc[ai][bj][m][1]; } }
        }
        asm volatile("s_waitcnt lgkmcnt(0)" ::: "memory"); __builtin_amdgcn_s_barrier(); asm volatile("" ::: "memory");
        if (t < 256) { const f32x2v a = ps[t * 4 + 0], b2 = ps[t * 4 + 1], c = ps[t * 4 + 2], d = ps[t * 4 + 3];
            *(f32x2v*)(st + 16 * (size_t)(u.pm * BM + t) + 2 * u.pn) = (f32x2v){(a.x + b2.x) + (c.x + d.x), (a.y + b2.y) + (c.y + d.y)}; }
    }
};

template <class Epi, class Sched, bool ALIGN_EPI = false, bool SP2 = false>
__device__ __forceinline__ void gemm_phase(PG8_LAS unsigned char* lds, const Gemm g, const Sched& S, const Epi& E) {
    const int tid = opaque_tid(), wid = __builtin_amdgcn_readfirstlane(tid >> 6), lane = tid & 63, wr = wid >> 2, wc = wid & 3, fr = lane & 15, fq = lane >> 4;
    const int K = g.K, nt = K / BK;
    unsigned voffA[2], voffB[2];
#pragma unroll
    for (int i = 0; i < 2; ++i) { int R, C; stage_rc(tid * 16 + i * 8192, R, C); const int Rb = Epi::PERM ? ((R & ~31) + perm32(R & 31)) : R;
        voffA[i] = (unsigned)(R * K + C) * 2u; voffB[i] = (unsigned)(Rb * K + C) * 2u; }
    const size_t kstep = (size_t)(BK * 2);
    const size_t hstep = (size_t)HALF * K * 2;
    const size_t tstep = 2 * hstep;
    const unsigned ldsw = (unsigned)wid * 1024u;
    const int aoff = lds_byte(wr * 64 + fr, fq * 8), boff = lds_byte(wc * 32 + fr, fq * 8);
#define PG8_SA(b, h) (((b) * 2 + (h)) * HTB)
#define PG8_SB(b, h) ((4 + (b) * 2 + (h)) * HTB)
#define PG8_STAGE(bufoff, gbase, voff) do { _Pragma("unroll") for (int _i = 0; _i < 2; ++_i) \
        __builtin_amdgcn_global_load_lds((const unsigned*)((const char*)(gbase) + (voff)[_i]), (PG8_LAS unsigned*)(lds + (bufoff) + ldsw + _i * 8192), 16, 0, 0); } while (0)
#define PG8_LDA(dst, b, h) do { _Pragma("unroll") for (int m = 0; m < 4; ++m) _Pragma("unroll") for (int k = 0; k < 2; ++k) dst[m][k] = *(const PG8_LAS bf16x8*)(lds + PG8_SA(b, h) + aoff + m * 2048 + k * 1024); } while (0)
#define PG8_LDB(dst, b, h) do { _Pragma("unroll") for (int n = 0; n < 2; ++n) _Pragma("unroll") for (int k = 0; k < 2; ++k) dst[n][k] = *(const PG8_LAS bf16x8*)(lds + PG8_SB(b, h) + boff + n * 2048 + k * 1024); } while (0)
#define PG8_MMA(ai, bj, At, Bt) do { __builtin_amdgcn_s_setprio(1); _Pragma("unroll") for (int m = 0; m < 4; ++m) _Pragma("unroll") for (int n = 0; n < 2; ++n) _Pragma("unroll") for (int k = 0; k < 2; ++k) \
        acc[ai][bj][m][n] = __builtin_amdgcn_mfma_f32_16x16x32_bf16(Bt[n][k], At[m][k], acc[ai][bj][m][n], 0, 0, 0); __builtin_amdgcn_s_setprio(0); } while (0)
#define PG8_WAIT_V(n) asm volatile("s_waitcnt vmcnt(" #n ")" ::: "memory")
#define PG8_WAIT_L(n) asm volatile("s_waitcnt lgkmcnt(" #n ")" ::: "memory")
#if PG8_RELAX
#define PG8_WAIT_VR() do { asm volatile("s_waitcnt vmcnt(%0)" :: "n"(8 + Epi::NSTORES) : "memory"); if (!PG8_RELAX || relax_ == 0) { PG8_WAIT_V(8); } } while (0)
#else
#define PG8_WAIT_VR() PG8_WAIT_V(8)
#endif
#define PG8_BAR __builtin_amdgcn_s_barrier()
#define PG8_SCHED __builtin_amdgcn_sched_barrier(0)
    Unit cur, nxt; int ui = 0;
    if (!S.next(0, cur)) return;
#if PG8_PROBE
    unsigned long long pr_tk = 0, pr_te = 0; const unsigned long long pr_r0 = __builtin_amdgcn_s_memrealtime(), pr_c0 = __builtin_amdgcn_s_memtime();
#endif
    f32x4 acc[2][2][4][2];
#pragma unroll
    for (int a = 0; a < 2; ++a)
#pragma unroll
        for (int b = 0; b < 2; ++b)
#pragma unroll
            for (int m = 0; m < 4; ++m)
#pragma unroll
                for (int n = 0; n < 2; ++n) acc[a][b][m][n] = (f32x4){0.f, 0.f, 0.f, 0.f};
    bf16x8 At[4][2], B0[2][2], B1[2][2];
    const char* cA = (const char*)g.A + (size_t)cur.pm * tstep; const char* cB = (const char*)g.Bt + (size_t)cur.pn * tstep;
    S.a_ready(cur);
    if constexpr (SP2) {
        PG8_STAGE(PG8_SB(0, 0), cB, voffB); PG8_STAGE(PG8_SB(0, 1), cB + hstep, voffB); PG8_STAGE(PG8_SA(0, 0), cA, voffA); PG8_STAGE(PG8_SA(0, 1), cA + hstep, voffA);
        if (wr == 1) PG8_BAR;
        PG8_WAIT_V(2); PG8_BAR;
        PG8_STAGE(PG8_SB(1, 0), cB + kstep, voffB); PG8_STAGE(PG8_SA(1, 0), cA + kstep, voffA); PG8_STAGE(PG8_SB(1, 1), cB + hstep + kstep, voffB);
        PG8_WAIT_V(6); PG8_BAR;
    } else {
        PG8_STAGE(PG8_SB(0, 0), cB, voffB); PG8_STAGE(PG8_SA(0, 0), cA, voffA); PG8_STAGE(PG8_SB(0, 1), cB + hstep, voffB); PG8_STAGE(PG8_SA(0, 1), cA + hstep, voffA);
        if (wr == 1) PG8_BAR;
        PG8_WAIT_V(4); PG8_BAR;
        PG8_STAGE(PG8_SB(1, 0), cB + kstep, voffB); PG8_STAGE(PG8_SA(1, 0), cA + kstep, voffA); PG8_STAGE(PG8_SB(1, 1), cB + hstep + kstep, voffB);
        PG8_WAIT_V(6); PG8_BAR;
    }
    for (;;) {
        const bool has_next = S.next(ui + 1, nxt);
        const char* nA = has_next ? (const char*)g.A + (size_t)nxt.pm * tstep : cA; const char* nB = has_next ? (const char*)g.Bt + (size_t)nxt.pn * tstep : cB;
#if PG8_PROBE
        const unsigned long long pr_ta = __builtin_amdgcn_s_memtime();
#endif
        for (int t = 0; t < nt; t += 2) {
            const bool last = (t == nt - 2);
#if PG8_PROBE >= 9 && PG8_PROBE <= 10
            int pr_tv = (PG8_PROBE == 9 ? 0 : 8); asm volatile("" : "+v"(pr_tv)); const bool pr_sel = (ui > 0) && (t == __builtin_amdgcn_readfirstlane(pr_tv)); const unsigned pr_i0 = (unsigned)__builtin_amdgcn_s_memtime();
#endif
#if PG8_RELAX
            int relax_v = ((t == 0) && (ui > 0)) ? 1 : 0; asm volatile("" : "+v"(relax_v)); const int relax_ = __builtin_amdgcn_readfirstlane(relax_v);
#endif
            const char* a1 = cA + (size_t)(t + 1) * kstep;
            const char* a2 = last ? nA : cA + (size_t)(t + 2) * kstep; const char* b2 = last ? nB : cB + (size_t)(t + 2) * kstep;
            const char* a3 = a2 + kstep; const char* b3 = b2 + kstep;
            if (last && has_next) S.a_ready(nxt);
            if constexpr (SP2) {
            PG8_LDB(B0, 0, 0); PG8_LDB(B1, 0, 1); PG8_SCHED; PG8_LDA(At, 0, 0); PG8_STAGE(PG8_SA(1, 1), a1 + hstep, voffA);
            PG8_WAIT_VR(); PG8_WAIT_L(0); PG8_BAR; PG8_MMA(0, 0, At, B0); PG8_MMA(0, 1, At, B1); PG8_BAR; PG8_SCHED;
            PG8_LDA(At, 0, 1); PG8_STAGE(PG8_SB(0, 0), b2, voffB); PG8_STAGE(PG8_SB(0, 1), b2 + hstep, voffB); PG8_STAGE(PG8_SA(0, 0), a2, voffA);
            PG8_WAIT_VR(); PG8_WAIT_L(0); PG8_BAR; PG8_MMA(1, 0, At, B0); PG8_MMA(1, 1, At, B1); PG8_BAR; PG8_SCHED;
            PG8_LDB(B0, 1, 0); PG8_LDB(B1, 1, 1); PG8_SCHED; PG8_LDA(At, 1, 0); PG8_STAGE(PG8_SA(0, 1), a2 + hstep, voffA);
            PG8_WAIT_V(8); PG8_WAIT_L(0); PG8_BAR; PG8_MMA(0, 0, At, B0); PG8_MMA(0, 1, At, B1); PG8_BAR; PG8_SCHED;
            PG8_LDA(At, 1, 1); PG8_STAGE(PG8_SB(1, 0), b3, voffB); PG8_STAGE(PG8_SB(1, 1), b3 + hstep, voffB); PG8_STAGE(PG8_SA(1, 0), a3, voffA);
            PG8_WAIT_V(8); PG8_WAIT_L(0); PG8_BAR; PG8_MMA(1, 0, At, B0); PG8_MMA(1, 1, At, B1); PG8_BAR; PG8_SCHED;
            } else {
            PG8_LDB(B0, 0, 0); PG8_SCHED; PG8_LDA(At, 0, 0); PG8_STAGE(PG8_SA(1, 1), a1 + hstep, voffA);
            PG8_WAIT_L(8); PG8_BAR; PG8_WAIT_L(0); PG8_MMA(0, 0, At, B0); PG8_BAR; PG8_SCHED;
            PG8_LDB(B1, 0, 1); PG8_STAGE(PG8_SB(0, 0), b2, voffB);
            PG8_BAR; PG8_WAIT_L(0); PG8_MMA(0, 1, At, B1); PG8_BAR;
            PG8_LDA(At, 0, 1); PG8_STAGE(PG8_SA(0, 0), a2, voffA);
            PG8_BAR; PG8_WAIT_L(0); PG8_MMA(1, 0, At, B0); PG8_BAR; PG8_SCHED;
            PG8_STAGE(PG8_SB(0, 1), b2 + hstep, voffB);
            PG8_WAIT_V(6); PG8_BAR; PG8_MMA(1, 1, At, B1); PG8_BAR;
            PG8_LDB(B0, 1, 0); PG8_SCHED; PG8_LDA(At, 1, 0); PG8_STAGE(PG8_SA(0, 1), a2 + hstep, voffA);
            PG8_WAIT_L(8); PG8_BAR; PG8_WAIT_L(0); PG8_MMA(0, 0, At, B0); PG8_BAR; PG8_SCHED;
            PG8_LDB(B1, 1, 1); PG8_STAGE(PG8_SB(1, 0), b3, voffB);
            PG8_BAR; PG8_WAIT_L(0); PG8_MMA(0, 1, At, B1); PG8_BAR;
            PG8_LDA(At, 1, 1); PG8_STAGE(PG8_SA(1, 0), a3, voffA);
            PG8_BAR; PG8_WAIT_L(0); PG8_MMA(1, 0, At, B0); PG8_BAR; PG8_SCHED;
            PG8_STAGE(PG8_SB(1, 1), b3 + hstep, voffB);
            PG8_WAIT_V(6); PG8_BAR; PG8_MMA(1, 1, At, B1); PG8_BAR;
            }
#if PG8_PROBE >= 9 && PG8_PROBE <= 10
            if (pr_sel) pr_tk += (unsigned)((unsigned)__builtin_amdgcn_s_memtime() - pr_i0);
#endif
        }
#if PG8_PROBE
        const unsigned long long pr_tb = __builtin_amdgcn_s_memtime(); if (!(PG8_PROBE >= 9 && PG8_PROBE <= 10)) pr_tk += pr_tb - pr_ta;
#endif
        if constexpr (ALIGN_EPI) { if (wr == 0) PG8_BAR; }
        if constexpr (!Epi::AFTER_DRAIN) { E(acc, cur, wr, wc, fr, fq); S.done(cur); }
#if PG8_PROBE
        { const unsigned long long pr_tc = __builtin_amdgcn_s_memtime(); pr_te += pr_tc - pr_tb; }
#endif
        if (!has_next) break;
#pragma unroll
        for (int a = 0; a < 2; ++a)
#pragma unroll
            for (int b = 0; b < 2; ++b)
#pragma unroll
                for (int m = 0; m < 4; ++m)
#pragma unroll
                    for (int n = 0; n < 2; ++n) acc[a][b][m][n] = (f32x4){0.f, 0.f, 0.f, 0.f};
        cur = nxt; cA = nA; cB = nB; ++ui;
        if constexpr (ALIGN_EPI) { if (wr == 1) PG8_BAR; }
    }
#if PG8_PROBE
    if (g.probe && blockIdx.x == 0 && tid == 0) { g.probe[0] = pr_tk; g.probe[1] = pr_te; g.probe[2] = (unsigned long long)(ui + 1); g.probe[3] = __builtin_amdgcn_s_memrealtime() - pr_r0; g.probe[4] = __builtin_amdgcn_s_memtime() - pr_c0; }
#endif
    PG8_WAIT_V(0);
    if constexpr (!ALIGN_EPI) { if (wr == 0) PG8_BAR; }
    PG8_BAR;
    if constexpr (Epi::AFTER_DRAIN) { E.fused(acc, cur, wr, wc, fr, fq, lds, wid, lane); S.done(cur); }
#undef PG8_SA
#undef PG8_SB
#undef PG8_STAGE
#undef PG8_LDA
#undef PG8_LDB
#undef PG8_MMA
#undef PG8_WAIT_V
#undef PG8_WAIT_L
#undef PG8_WAIT_VR
#undef PG8_BAR
#undef PG8_SCHED
}
}

namespace attA {
constexpr int D = 128;
constexpr int LDQ = NQKV_A, LDKV = NQKV_A, LDO = 2 * DM;
constexpr float THR = 8.f;
constexpr bool WSKIP = false;
constexpr float SCALE = 0.08838834764831845f;
constexpr int NW = 8, QBLK = 32, KVBLK = 64, QB = NW * QBLK;
constexpr int SHM_V = KVBLK * D * 2, SHM_K = KVBLK * D * 2;
constexpr int LDS_BYTES = 2 * SHM_V + 2 * SHM_K + NW * 64 * 4;
using bf16 = __hip_bfloat16;
typedef short bf16x8 __attribute__((ext_vector_type(8)));
typedef short s16x4 __attribute__((ext_vector_type(4)));
typedef float f32x16 __attribute__((ext_vector_type(16)));
typedef float f32x4 __attribute__((ext_vector_type(4)));
typedef unsigned u32x4 __attribute__((ext_vector_type(4)));
template <class A, class Bt> struct same_t { static constexpr bool v = false; };
template <class A> struct same_t<A, A> { static constexpr bool v = true; };

#define KSWZ(row, colB) ((row) * 256 + ((colB) ^ (((row) & 7) << 4)))
#define SBAR() __builtin_amdgcn_sched_barrier(0)
__device__ __forceinline__ int v_st(int k, int c) { const int kk = (k & ~0xC) | ((k & 4) << 1) | ((k & 8) >> 1); return ((kk >> 3) * 4 + (c >> 5)) * 512 + ((kk & 7) * 32 + (c & 31)) * 2; }
__device__ __forceinline__ int v_rd_base(int lane) { return ((lane & 3) << 3) | (((lane >> 2) & 3) << 6) | (((lane >> 4) & 1) << 5) | (((lane >> 5) & 1) << 8); }
constexpr int v_rd_off(int d0, int ks, int half) { return d0 * 512 + ks * 4096 + half * 2048; }
__device__ __forceinline__ int crow(int r, int hi) { return (r & 3) + 8 * (r >> 2) + 4 * hi; }
__device__ __forceinline__ unsigned cvtpk(float lo, float hi) {
    unsigned r; asm volatile("v_cvt_pk_bf16_f32 %0, %1, %2" : "=v"(r) : "v"(lo), "v"(hi)); return r;
}
__device__ __forceinline__ bf16x8 pack8(f32x4 a, f32x4 b) {
    u32x4 w = {cvtpk(a[0], a[1]), cvtpk(a[2], a[3]), cvtpk(b[0], b[1]), cvtpk(b[2], b[3])};
    return *reinterpret_cast<bf16x8*>(&w);
}
template <class T> __device__ __forceinline__ bf16x8 load8(const T* p) {
    if constexpr (same_t<T, float>::v) { return pack8(*(const f32x4*)p, *(const f32x4*)(p + 4)); }
    else { return *reinterpret_cast<const bf16x8*>(p); }
}
__device__ __forceinline__ void mask_tile(f32x16& p0, f32x16& p1, int dq, unsigned W) {
    const float NEG = -__builtin_inff();
#pragma unroll
    for (int r = 0; r < 16; ++r) {
        const int c = (r & 3) + 8 * (r >> 2);
        if ((unsigned)(dq - c) >= W) p0[r] = NEG;
        if ((unsigned)(dq - c - 32) >= W) p1[r] = NEG;
    }
}
__device__ __forceinline__ void partialSM(f32x16& p0, f32x16& p1, float& m_reg, float& mn, float& alpha) {
    float pmax = p0[0]; for (int r = 1; r < 16; ++r) pmax = fmaxf(pmax, p0[r]); for (int r = 0; r < 16; ++r) pmax = fmaxf(pmax, p1[r]);
    { auto rr = __builtin_amdgcn_permlane32_swap(__float_as_uint(pmax), __float_as_uint(pmax), false, false);
      pmax = fmaxf(__uint_as_float(rr[0]), __uint_as_float(rr[1])); }
    constexpr float C2 = 1.4426950408889634f * SCALE;
    if (__builtin_expect(__all((pmax - m_reg) * SCALE <= THR), 1)) { mn = m_reg; alpha = 1.f; }
    else { mn = fmaxf(m_reg, pmax); alpha = __builtin_amdgcn_exp2f((m_reg - mn) * C2); m_reg = mn; }
    const float mnL = -mn * C2;
    for (int r = 0; r < 16; ++r) p0[r] = fmaf(p0[r], C2, mnL); for (int r = 0; r < 16; ++r) p1[r] = fmaf(p1[r], C2, mnL);
    for (int r = 0; r < 16; ++r) p0[r] = __builtin_amdgcn_exp2f(p0[r]);
}
__device__ __forceinline__ void finishSM(f32x16& p0, f32x16& p1, float alpha, float& l_reg, bf16x8& pa0, bf16x8& pa1, bf16x8& pa2, bf16x8& pa3) {
    for (int r = 0; r < 16; ++r) p1[r] = __builtin_amdgcn_exp2f(p1[r]);
    float ps = 0; for (int r = 0; r < 16; ++r) ps += p0[r]; for (int r = 0; r < 16; ++r) ps += p1[r];
    { auto rr = __builtin_amdgcn_permlane32_swap(__float_as_uint(ps), __float_as_uint(ps), false, false);
      ps = __uint_as_float(rr[0]) + __uint_as_float(rr[1]); }
    l_reg = l_reg * alpha + ps;
#define PK4(P, B_, OUT) do { unsigned a0 = cvtpk(P[B_+0], P[B_+1]), a1 = cvtpk(P[B_+2], P[B_+3]);                          \
        unsigned b0 = cvtpk(P[B_+4], P[B_+5]), b1 = cvtpk(P[B_+6], P[B_+7]);                                             \
        auto r0 = __builtin_amdgcn_permlane32_swap(a0, b0, false, false); auto r1 = __builtin_amdgcn_permlane32_swap(a1, b1, false, false); \
        u32x4 w = {r0[0], r1[0], r0[1], r1[1]}; OUT = *reinterpret_cast<bf16x8*>(&w); } while (0)
    PK4(p0, 0, pa0); PK4(p0, 8, pa1); PK4(p1, 0, pa2); PK4(p1, 8, pa3);
#undef PK4
}
template <int KB, bool SK>
__device__ __forceinline__ void qkt(f32x16& p0, f32x16& p1, const char* K_lds, int r32, int hi, const bf16x8* qr, bool act) {
    if (SK && !act) { const float NEG = -__builtin_inff();
#pragma unroll
        for (int r = 0; r < 16; ++r) { p0[r] = NEG; p1[r] = NEG; } return; }
    p0 = f32x16{}; p1 = f32x16{};
    const char* kb[4];
#pragma unroll
    for (int dd = 0; dd < 4; ++dd) kb[dd] = K_lds + KB * SHM_K + KSWZ(r32, (dd * 16 + hi * 8) * 2);
#pragma unroll
    for (int d0 = 0; d0 < 8; ++d0) { const char* a = kb[d0 & 3] + (d0 >> 2) * 128;
        bf16x8 b0 = *reinterpret_cast<const bf16x8*>(a);
        bf16x8 b1 = *reinterpret_cast<const bf16x8*>(a + 32 * 256);
        p0 = __builtin_amdgcn_mfma_f32_32x32x16_bf16(b0, qr[d0], p0, 0, 0, 0);
        p1 = __builtin_amdgcn_mfma_f32_32x32x16_bf16(b1, qr[d0], p1, 0, 0, 0); }
}
template <int VB, bool SK>
__device__ __forceinline__ void pv_tile(f32x16* o, int vb0, bf16x8 pa0, bf16x8 pa1, bf16x8 pa2, bf16x8 pa3, bool act) {
    if (SK && !act) return;
#define TRRD(dst, off) asm volatile("ds_read_b64_tr_b16 %0, %1 offset:%2" : "=&v"(dst) : "v"(vb0), "i"(off) : "memory")
#define PV_D0(d0) do { s16x4 l0, l1, l2, l3, h0, h1, h2, h3; constexpr int b_ = VB * SHM_V + v_rd_off(d0, 0, 0);     \
        TRRD(l0, b_); TRRD(h0, b_ + 2048); TRRD(l1, b_ + 4096); TRRD(h1, b_ + 6144); TRRD(l2, b_ + 8192); TRRD(h2, b_ + 10240); TRRD(l3, b_ + 12288); TRRD(h3, b_ + 14336); \
        asm volatile("s_waitcnt lgkmcnt(0)" ::: "memory"); SBAR();                 \
        o[d0] = __builtin_amdgcn_mfma_f32_32x32x16_bf16(pa0, (bf16x8){l0[0], l0[1], l0[2], l0[3], h0[0], h0[1], h0[2], h0[3]}, o[d0], 0, 0, 0);   \
        o[d0] = __builtin_amdgcn_mfma_f32_32x32x16_bf16(pa1, (bf16x8){l1[0], l1[1], l1[2], l1[3], h1[0], h1[1], h1[2], h1[3]}, o[d0], 0, 0, 0);   \
        o[d0] = __builtin_amdgcn_mfma_f32_32x32x16_bf16(pa2, (bf16x8){l2[0], l2[1], l2[2], l2[3], h2[0], h2[1], h2[2], h2[3]}, o[d0], 0, 0, 0);   \
        o[d0] = __builtin_amdgcn_mfma_f32_32x32x16_bf16(pa3, (bf16x8){l3[0], l3[1], l3[2], l3[3], h3[0], h3[1], h3[2], h3[3]}, o[d0], 0, 0, 0); } while (0)
    PV_D0(0); PV_D0(1); PV_D0(2); PV_D0(3);
#undef PV_D0
#undef TRRD
}

template <class TIn, class TOut> struct BlockRef { const TIn* Q; const TIn* K; const TIn* V; TOut* O; int P0; };
template <class TIn> struct Seam {
    bf16x8 qr[8];
    bf16x8 st_v0, st_v1, st_k0, st_k1; f32x4 sf0, sf1, sf2, sf3;
    f32x4 tq[16];
};
__device__ __forceinline__ int swa_jlo(int P0, int W) { const int lowk = P0 - W + 1; return lowk > 0 ? lowk / KVBLK : 0; }
#define ROW(p, k0, rr) ((p) + (size_t)((k0) + (rr)) * LDKV + sc)
#define VMW() asm volatile("s_waitcnt vmcnt(0)" ::: "memory")
#define VMWN(n) asm volatile("s_waitcnt vmcnt(%0)" :: "i"(n) : "memory")
#define SLOAD_H(Kp, Vp, k0) do { S.st_v0 = load8<TIn>(ROW(Vp, k0, sr)); S.st_v1 = load8<TIn>(ROW(Vp, k0, 32 + sr));              \
                         S.st_k0 = load8<TIn>(ROW(Kp, k0, sr)); S.st_k1 = load8<TIn>(ROW(Kp, k0, 32 + sr)); } while (0)
#define SWRITE_HK(bf) do { *(bf16x8*)(K_lds + (bf) * SHM_K + kws) = S.st_k0; *(bf16x8*)(K_lds + (bf) * SHM_K + kws + 32 * 256) = S.st_k1; } while (0)
#define SWRITE_HV(bf) do { *(bf16x8*)(V_lds + (bf) * SHM_V + vst0) = S.st_v0; *(bf16x8*)(V_lds + (bf) * SHM_V + vst1) = S.st_v1; } while (0)
#define SWRITE_H(bf) do { SWRITE_HV(bf); SWRITE_HK(bf); } while (0)
#define SLOAD_F(p, k0) do { S.sf0 = *(const f32x4*)ROW(p, k0, sr); S.sf1 = *(const f32x4*)(ROW(p, k0, sr) + 4);                \
                            S.sf2 = *(const f32x4*)ROW(p, k0, 32 + sr); S.sf3 = *(const f32x4*)(ROW(p, k0, 32 + sr) + 4); } while (0)
#define SWRITE_KF(bf) do { *(bf16x8*)(K_lds + (bf) * SHM_K + kws) = pack8(S.sf0, S.sf1); *(bf16x8*)(K_lds + (bf) * SHM_K + kws + 32 * 256) = pack8(S.sf2, S.sf3); } while (0)
#define SWRITE_VF(bf) do { *(bf16x8*)(V_lds + (bf) * SHM_V + vst0) = pack8(S.sf0, S.sf1); *(bf16x8*)(V_lds + (bf) * SHM_V + vst1) = pack8(S.sf2, S.sf3); } while (0)
template <class TIn, class TOut>
__device__ __forceinline__ void causal_swa_prime(const BlockRef<TIn, TOut>& cur, int W, char* lds, Seam<TIn>& S) {
    constexpr bool F32 = same_t<TIn, float>::v;
    const int tid = opaque_tid(), wid = __builtin_amdgcn_readfirstlane(tid >> 6), lane = tid & 63, r32 = lane & 31, hi = lane >> 5;
    const int sr = tid >> 4, sc = (tid & 15) * 8, kws = KSWZ(sr, sc * 2); char* K_lds = lds + 2 * SHM_V;
    const int kb0 = swa_jlo(cur.P0, W) * KVBLK;
    for (int d0 = 0; d0 < 8; ++d0) S.qr[d0] = load8<TIn>(cur.Q + (size_t)(wid * QBLK + r32) * LDQ + d0 * 16 + hi * 8);
    if constexpr (F32) { SLOAD_F((const float*)cur.K, kb0); VMW(); SWRITE_KF(0); SBAR(); SLOAD_F((const float*)cur.V, kb0); }
    else { SLOAD_H(cur.K, cur.V, kb0); VMW(); SWRITE_HK(0); }
    __syncthreads();
}
template <class TIn, class TOut>
__device__ __forceinline__ void causal_swa_block(const BlockRef<TIn, TOut>& cur, const BlockRef<TIn, TOut>& nxt, int skv, int W, char* lds, Seam<TIn>& S) {
    constexpr bool F32 = same_t<TIn, float>::v;
    const int tid = opaque_tid(), wid = __builtin_amdgcn_readfirstlane(tid >> 6), lane = tid & 63, r32 = lane & 31, hi = lane >> 5;
    const int j_lo = swa_jlo(cur.P0, W);
    int j_hi = (cur.P0 + QB - 1) / KVBLK + 1; if (j_hi > skv / KVBLK) j_hi = skv / KVBLK;
    const int NT = j_hi - j_lo;
    const int kbn = swa_jlo(nxt.P0, W) * KVBLK;
    const int qlo = cur.P0 + wid * QBLK, qm = qlo + r32 - 4 * hi;
    char* V_lds = lds; char* K_lds = lds + 2 * SHM_V;
    float* ws = (float*)(lds + 2 * SHM_V + 2 * SHM_K) + wid * 64; float* li_l = ws, * al_l = ws + 32;
    float m_reg = -1e30f, l_reg = 0; f32x16 o[4] = {};
    const int sr = tid >> 4, sc = (tid & 15) * 8, vst0 = v_st(sr, sc), vst1 = v_st(32 + sr, sc), kws = KSWZ(sr, sc * 2);
    const int vb0 = (int)(uintptr_t)V_lds + v_rd_base(lane);
    const TIn* Kh = cur.K; const TIn* Vh = cur.V;
#define RESC(a) do { if (__any((a) < 1.f)) { if (hi == 0) al_l[r32] = (a); asm volatile("s_waitcnt lgkmcnt(0)" ::: "memory");              \
                     for (int d_ = 0; d_ < 4; ++d_) for (int r = 0; r < 16; ++r) o[d_][r] *= al_l[crow(r, hi)]; } } while (0)
#define KBASE(t) ((j_lo + (t)) * KVBLK)
#define ACT(t) (KBASE(t) <= qlo + QBLK - 1 && KBASE(t) + KVBLK - 1 >= qlo - W + 1)
#define MASKT(P0_, P1_, t) do { const int kb_ = KBASE(t); if ((!SK || ACT(t)) && (kb_ + KVBLK - 1 > qlo || kb_ <= qlo + QBLK - 1 - W)) mask_tile(P0_, P1_, qm - kb_, (unsigned)W); } while (0)
    constexpr int NQL = F32 ? 16 : 8;
    constexpr bool SK = WSKIP && !F32;
#define SEAM_K0() do { VMWN(NQL); if constexpr (F32) { SWRITE_KF(0); SBAR(); SLOAD_F((const float*)nxt.V, kbn); } else { SWRITE_HK(0); } SBAR(); } while (0)
    f32x16 pA0, pA1, pB0, pB1; float mnA, mnB, alA, alB; bf16x8 pa0, pa1, pa2, pa3;
    if constexpr (F32) { VMW(); SWRITE_VF(0); SBAR(); } else { SWRITE_HV(0); SBAR(); }
    if (NT > 1) { if constexpr (F32) SLOAD_F((const float*)Kh, KBASE(1)); else SLOAD_H(Kh, Vh, KBASE(1)); }
    SBAR(); qkt<0, SK>(pA0, pA1, K_lds, r32, hi, S.qr, ACT(0));
    if constexpr (F32) { if (NT > 1) { VMW(); SWRITE_KF(1); SBAR(); SLOAD_F((const float*)Vh, KBASE(1)); } }
    MASKT(pA0, pA1, 0); partialSM(pA0, pA1, m_reg, mnA, alA);
    if (NT > 1) { VMW(); if constexpr (F32) { SWRITE_VF(1); SBAR(); if (NT > 2) SLOAD_F((const float*)Kh, KBASE(2)); } else SWRITE_H(1); }
    __syncthreads();
#define HALF_STEP(PX0, PX1, mnX, alX, PY0, PY1, alY, t, KB, VB, SB) do {                                                      \
        SBAR(); qkt<KB, SK>(PX0, PX1, K_lds, r32, hi, S.qr, ACT(t));                                             \
        finishSM(PY0, PY1, alY, l_reg, pa0, pa1, pa2, pa3); SBAR();                                                           \
        if ((t) + 1 < NT) { if constexpr (F32) { VMW(); SWRITE_KF(SB); SBAR(); SLOAD_F((const float*)Vh, KBASE((t) + 1)); }  \
                            else { SLOAD_H(Kh, Vh, KBASE((t) + 1)); } SBAR(); }                                               \
        pv_tile<VB, SK>(o, vb0, pa0, pa1, pa2, pa3, ACT((t) - 1)); MASKT(PX0, PX1, (t)); partialSM(PX0, PX1, m_reg, mnX, alX);                                        \
        __syncthreads();                                                                                                      \
        if ((t) + 1 < NT) { VMW(); if constexpr (F32) { SWRITE_VF(SB); SBAR(); if ((t) + 2 < NT) SLOAD_F((const float*)Kh, KBASE((t) + 2)); } \
                            else { SWRITE_H(SB); } }                                                                          \
        RESC(alX); __syncthreads(); } while (0)
    for (int t = 1; t + 1 < NT; t += 2) {
        HALF_STEP(pB0, pB1, mnB, alB, pA0, pA1, alA, t, 1, 0, 0);
        HALF_STEP(pA0, pA1, mnA, alA, pB0, pB1, alB, t + 1, 0, 1, 1);
    }
    const bool even = (NT & 1) == 0;
    if (even) { SBAR(); qkt<1, SK>(pB0, pB1, K_lds, r32, hi, S.qr, ACT(NT - 1)); SBAR(); }
#define QROW(e) (nxt.Q + (size_t)(wid * QBLK + r32) * LDQ + ((e) >> 1) * 16 + hi * 8 + ((e) & 1) * 4)
    if constexpr (F32) { SLOAD_F((const float*)nxt.K, kbn); SBAR();
#pragma unroll
        for (int e = 0; e < 8; ++e) S.tq[e] = *(const f32x4*)QROW(e); }
    else { SLOAD_H(nxt.K, nxt.V, kbn); SBAR();
#pragma unroll
        for (int d0 = 0; d0 < 8; ++d0) S.qr[d0] = load8<TIn>(nxt.Q + (size_t)(wid * QBLK + r32) * LDQ + d0 * 16 + hi * 8); }
    SBAR();
    finishSM(pA0, pA1, alA, l_reg, pa0, pa1, pa2, pa3); SBAR();
    if constexpr (F32) {
#pragma unroll
        for (int e = 8; e < 16; ++e) S.tq[e] = *(const f32x4*)QROW(e); SBAR(); }
#undef QROW
    pv_tile<0, SK>(o, vb0, pa0, pa1, pa2, pa3, ACT(even ? NT - 2 : NT - 1));
    if (even) { MASKT(pB0, pB1, NT - 1); partialSM(pB0, pB1, m_reg, mnB, alB); __syncthreads(); RESC(alB);
        finishSM(pB0, pB1, alB, l_reg, pa0, pa1, pa2, pa3); SBAR(); pv_tile<1, SK>(o, vb0, pa0, pa1, pa2, pa3, ACT(NT - 1)); }
    SBAR(); SEAM_K0();
    if (hi == 0) li_l[r32] = l_reg; asm volatile("s_waitcnt lgkmcnt(0)" ::: "memory");
    float rli[16];
#pragma unroll
    for (int r = 0; r < 16; ++r) rli[r] = __builtin_amdgcn_rcpf(li_l[crow(r, hi)]);
    TOut* Ow = cur.O + (size_t)(wid * QBLK) * LDO;
#pragma unroll
    for (int r = 0; r < 16; ++r) { const int orow = crow(r, hi);
#pragma unroll
        for (int d0 = 0; d0 < 4; ++d0) { const float v = o[d0][r] * rli[r];
            if constexpr (same_t<TOut, float>::v) { Ow[(size_t)orow * LDO + d0 * 32 + r32] = v; }
            else { const float vn = __shfl_xor(v, 1);
                   if ((r32 & 1) == 0) *(unsigned*)(Ow + (size_t)orow * LDO + d0 * 32 + r32) = cvtpk(v, vn); } } }
    if constexpr (F32) {
#pragma unroll
        for (int d0 = 0; d0 < 8; ++d0) S.qr[d0] = pack8(S.tq[2 * d0], S.tq[2 * d0 + 1]); }
    __syncthreads();
#undef RESC
#undef KBASE
#undef ACT
#undef MASKT
#undef SEAM_K0
#undef HALF_STEP
}
#undef ROW
#undef VMW
#undef VMWN
#undef SLOAD_H
#undef SWRITE_HK
#undef SWRITE_HV
#undef SWRITE_H
#undef SLOAD_F
#undef SWRITE_KF
#undef SWRITE_VF

#ifndef ATTA_LATE_FROM
#define ATTA_LATE_FROM 4
#endif
#ifndef ATTA_LATE_ODD
#define ATTA_LATE_ODD 0
#endif
#ifndef ATTA_STAMP_WAVE
#define ATTA_STAMP_WAVE 7
#endif
#ifndef ATTA_STAMP_SEL
#define ATTA_STAMP_SEL 0
#endif
#ifndef ATTA_STAMP
#define ATTA_STAMP 0
#endif
#ifndef ATTA_PRIO
#define ATTA_PRIO 1
#endif
#ifndef ATTA_T64
#define ATTA_T64 0
#endif
#ifndef ATTA_VPF
#define ATTA_VPF 1
#endif
#ifndef ATTA_PINGPONG
#define ATTA_PINGPONG 0
#endif
constexpr int SHM_V2 = KVBLK * 256 * 2;
constexpr int NVB = 3;
constexpr int LDS2_BYTES = NVB * SHM_V2 + 2 * SHM_K;
struct Blk2 { const bf16* Q; const bf16* K; const bf16* V; bf16* O; int P0; unsigned long long* stamp; };

template <int HF>
__device__ __forceinline__ void pv_half(f32x16 (&o)[8], const bf16x8& pa0, const bf16x8& pa1, int vb) {
#define TRRD(dst, off) asm volatile("ds_read_b64_tr_b16 %0, %1 offset:%2" : "=&v"(dst) : "v"(vb), "i"(off) : "memory")
#define RD4(l0, h0, l1, h1, d0) do { constexpr int b_ = ((d0) >> 2) * 16384 + ((d0) & 3) * 512 + HF * 8192;     \
        TRRD(l0, b_); TRRD(h0, b_ + 2048); TRRD(l1, b_ + 4096); TRRD(h1, b_ + 6144); } while (0)
#define MM2(l0, h0, l1, h1, d0) do { if (ATTA_PRIO == 2) __builtin_amdgcn_s_setprio(1); \
        o[d0] = __builtin_amdgcn_mfma_f32_32x32x16_bf16(pa0, (bf16x8){l0[0], l0[1], l0[2], l0[3], h0[0], h0[1], h0[2], h0[3]}, o[d0], 0, 0, 0); \
        o[d0] = __builtin_amdgcn_mfma_f32_32x32x16_bf16(pa1, (bf16x8){l1[0], l1[1], l1[2], l1[3], h1[0], h1[1], h1[2], h1[3]}, o[d0], 0, 0, 0); if (ATTA_PRIO == 2) __builtin_amdgcn_s_setprio(0); } while (0)
#define LWAIT() do { asm volatile("s_waitcnt lgkmcnt(0)" ::: "memory"); SBAR(); } while (0)
#if ATTA_VPF == 2
#define LWAIT4() do { asm volatile("s_waitcnt lgkmcnt(4)" ::: "memory"); SBAR(); } while (0)
    s16x4 a0, a1, a2, a3, b0, b1, b2, b3, c0, c1, c2, c3;
    RD4(a0, a1, a2, a3, 0); RD4(b0, b1, b2, b3, 1);
    LWAIT4(); RD4(c0, c1, c2, c3, 2); SBAR(); MM2(a0, a1, a2, a3, 0); SBAR();
    LWAIT4(); RD4(a0, a1, a2, a3, 3); SBAR(); MM2(b0, b1, b2, b3, 1); SBAR();
    LWAIT4(); RD4(b0, b1, b2, b3, 4); SBAR(); MM2(c0, c1, c2, c3, 2); SBAR();
    LWAIT4(); RD4(c0, c1, c2, c3, 5); SBAR(); MM2(a0, a1, a2, a3, 3); SBAR();
    LWAIT4(); RD4(a0, a1, a2, a3, 6); SBAR(); MM2(b0, b1, b2, b3, 4); SBAR();
    LWAIT4(); RD4(b0, b1, b2, b3, 7); SBAR(); MM2(c0, c1, c2, c3, 5); SBAR();
    LWAIT4(); MM2(a0, a1, a2, a3, 6); SBAR();
    LWAIT(); MM2(b0, b1, b2, b3, 7);
#undef LWAIT4
#else
    s16x4 a0, a1, a2, a3, b0, b1, b2, b3;
    RD4(a0, a1, a2, a3, 0);
    LWAIT(); RD4(b0, b1, b2, b3, 1); SBAR(); MM2(a0, a1, a2, a3, 0); SBAR();
    LWAIT(); RD4(a0, a1, a2, a3, 2); SBAR(); MM2(b0, b1, b2, b3, 1); SBAR();
    LWAIT(); RD4(b0, b1, b2, b3, 3); SBAR(); MM2(a0, a1, a2, a3, 2); SBAR();
    LWAIT(); RD4(a0, a1, a2, a3, 4); SBAR(); MM2(b0, b1, b2, b3, 3); SBAR();
    LWAIT(); RD4(b0, b1, b2, b3, 5); SBAR(); MM2(a0, a1, a2, a3, 4); SBAR();
    LWAIT(); RD4(a0, a1, a2, a3, 6); SBAR(); MM2(b0, b1, b2, b3, 5); SBAR();
    LWAIT(); RD4(b0, b1, b2, b3, 7); SBAR(); MM2(a0, a1, a2, a3, 6); SBAR();
    LWAIT(); MM2(b0, b1, b2, b3, 7);
#endif
#undef LWAIT
#undef MM2
#undef RD4
#undef TRRD
}

template <int BF, bool LATE>
__device__ __forceinline__ void fullv_tile(f32x16 (&o)[8], float& m_reg, float& l_reg, const bf16x8 (&qr)[8], const char* K_lds, int vcur, int vprev, float* al_l, int t, int qlo, int qm, int r32, int hi,
                                           char* pp_l, unsigned long long (&st)[6]) {
    constexpr float C2 = 1.4426950408889634f * SCALE;
    const char* kb[4];
#pragma unroll
    for (int dd = 0; dd < 4; ++dd) kb[dd] = K_lds + BF * SHM_K + KSWZ(r32, (dd * 16 + hi * 8) * 2);
#pragma unroll
    for (int hf = 0; hf < 2; ++hf) {
        if constexpr (LATE) { const bf16x8 q0 = *(const bf16x8*)pp_l, q1 = *(const bf16x8*)(pp_l + 1024);
            if (hf == 0) pv_half<1>(o, q0, q1, vprev); else pv_half<0>(o, q0, q1, vcur); }
        const int kbase = t * KVBLK + hf * 32;
        if (kbase > qlo + QBLK - 1) { if constexpr (LATE) { *(bf16x8*)pp_l = bf16x8{}; *(bf16x8*)(pp_l + 1024) = bf16x8{}; } continue; }
#if ATTA_STAMP
        const unsigned long long ts0 = __builtin_amdgcn_s_memtime();
#endif
        f32x16 p = f32x16{};
#pragma unroll
        for (int d0 = 0; d0 < 8; ++d0) { const bf16x8 kf = *reinterpret_cast<const bf16x8*>(kb[d0 & 3] + (d0 >> 2) * 128 + hf * (32 * 256));
            p = __builtin_amdgcn_mfma_f32_32x32x16_bf16(kf, qr[d0], p, 0, 0, 0); }
        if (kbase + 31 > qlo) {
            const float NEG = -__builtin_inff(); const int dq = qm - kbase;
#pragma unroll
            for (int r = 0; r < 16; ++r) { const int c = (r & 3) + 8 * (r >> 2); if (dq - c < 0) p[r] = NEG; } }
#if ATTA_STAMP
        asm volatile("" :: "v"(p[0]), "v"(p[15]) : "memory"); const unsigned long long ts1 = __builtin_amdgcn_s_memtime();
#endif
        float pmax = p[0];
#pragma unroll
        for (int r = 1; r < 16; ++r) pmax = fmaxf(pmax, p[r]);
        { auto rr = __builtin_amdgcn_permlane32_swap(__float_as_uint(pmax), __float_as_uint(pmax), false, false); pmax = fmaxf(__uint_as_float(rr[0]), __uint_as_float(rr[1])); }
        float mn = m_reg, alpha = 1.f;
        if (!__builtin_expect(__all((pmax - m_reg) * SCALE <= THR), 1)) { mn = fmaxf(m_reg, pmax); alpha = __builtin_amdgcn_exp2f((m_reg - mn) * C2); m_reg = mn; }
        if (__any(alpha < 1.f)) { if (hi == 0) al_l[r32] = alpha; asm volatile("s_waitcnt lgkmcnt(0)" ::: "memory");
#pragma unroll
            for (int d_ = 0; d_ < 8; ++d_)
#pragma unroll
                for (int r = 0; r < 16; ++r) { const float a_ = al_l[crow(r, hi)]; asm volatile("v_mul_f32 %0, %0, %1" : "+v"(o[d_][r]) : "v"(a_)); } }
        const float mnL = -mn * C2; float ps = 0.f;
#pragma unroll
        for (int r = 0; r < 16; ++r) { p[r] = __builtin_amdgcn_exp2f(fmaf(p[r], C2, mnL)); ps += p[r]; }
        { auto rr = __builtin_amdgcn_permlane32_swap(__float_as_uint(ps), __float_as_uint(ps), false, false); ps = __uint_as_float(rr[0]) + __uint_as_float(rr[1]); }
        l_reg = l_reg * alpha + ps;
        bf16x8 pa0, pa1;
#define PK4(P, B_, OUT) do { unsigned a0 = cvtpk(P[B_+0], P[B_+1]), a1 = cvtpk(P[B_+2], P[B_+3]); unsigned b0 = cvtpk(P[B_+4], P[B_+5]), b1 = cvtpk(P[B_+6], P[B_+7]); \
        auto r0 = __builtin_amdgcn_permlane32_swap(a0, b0, false, false); auto r1 = __builtin_amdgcn_permlane32_swap(a1, b1, false, false); \
        u32x4 w = {r0[0], r1[0], r0[1], r1[1]}; OUT = *reinterpret_cast<bf16x8*>(&w); } while (0)
        PK4(p, 0, pa0); PK4(p, 8, pa1);
#undef PK4
#if ATTA_STAMP
        asm volatile("" :: "v"(pa0), "v"(pa1) : "memory"); const unsigned long long ts2 = __builtin_amdgcn_s_memtime();
#endif
        if constexpr (LATE) { *(bf16x8*)pp_l = pa0; *(bf16x8*)(pp_l + 1024) = pa1; }
        else { if (hf == 0) pv_half<0>(o, pa0, pa1, vcur); else pv_half<1>(o, pa0, pa1, vcur); }
#if ATTA_STAMP
        { const unsigned long long ts3 = __builtin_amdgcn_s_memtime(); st[0] += ts1 - ts0; st[1] += ts2 - ts1; st[2] += ts3 - ts2; }
#endif
    }
}

template <int BF>
__device__ __forceinline__ void fullv_tile64(f32x16 (&o)[8], float& m_reg, float& l_reg, const bf16x8 (&qr)[8], const char* K_lds, int vcur, float* al_l, int t, int qlo, int qm, int r32, int hi) {
    constexpr float C2 = 1.4426950408889634f * SCALE;
    const int kbase = t * KVBLK;
    if (kbase > qlo + QBLK - 1) return;
    const char* kb[4];
#pragma unroll
    for (int dd = 0; dd < 4; ++dd) kb[dd] = K_lds + BF * SHM_K + KSWZ(r32, (dd * 16 + hi * 8) * 2);
    f32x16 p0 = f32x16{}, p1 = f32x16{};
#pragma unroll
    for (int d0 = 0; d0 < 8; ++d0) { const bf16x8 kf0 = *reinterpret_cast<const bf16x8*>(kb[d0 & 3] + (d0 >> 2) * 128), kf1 = *reinterpret_cast<const bf16x8*>(kb[d0 & 3] + (d0 >> 2) * 128 + 32 * 256);
        p0 = __builtin_amdgcn_mfma_f32_32x32x16_bf16(kf0, qr[d0], p0, 0, 0, 0); p1 = __builtin_amdgcn_mfma_f32_32x32x16_bf16(kf1, qr[d0], p1, 0, 0, 0); }
    if (kbase + 63 > qlo) {
        const float NEG = -__builtin_inff(); const int dq = qm - kbase;
#pragma unroll
        for (int r = 0; r < 16; ++r) { const int c = (r & 3) + 8 * (r >> 2); if (dq - c < 0) p0[r] = NEG; if (dq - 32 - c < 0) p1[r] = NEG; } }
    float pmax = fmaxf(p0[0], p1[0]);
#pragma unroll
    for (int r = 1; r < 16; ++r) pmax = fmaxf(pmax, fmaxf(p0[r], p1[r]));
    { auto rr = __builtin_amdgcn_permlane32_swap(__float_as_uint(pmax), __float_as_uint(pmax), false, false); pmax = fmaxf(__uint_as_float(rr[0]), __uint_as_float(rr[1])); }
    float mn = m_reg, alpha = 1.f;
    if (!__builtin_expect(__all((pmax - m_reg) * SCALE <= THR), 1)) { mn = fmaxf(m_reg, pmax); alpha = __builtin_amdgcn_exp2f((m_reg - mn) * C2); m_reg = mn; }
    if (__any(alpha < 1.f)) { if (hi == 0) al_l[r32] = alpha; asm volatile("s_waitcnt lgkmcnt(0)" ::: "memory");
#pragma unroll
        for (int d_ = 0; d_ < 8; ++d_)
#pragma unroll
            for (int r = 0; r < 16; ++r) { const float a_ = al_l[crow(r, hi)]; asm volatile("v_mul_f32 %0, %0, %1" : "+v"(o[d_][r]) : "v"(a_)); } }
    const float mnL = -mn * C2; float ps0 = 0.f, ps1 = 0.f;
#pragma unroll
    for (int r = 0; r < 16; ++r) { p0[r] = __builtin_amdgcn_exp2f(fmaf(p0[r], C2, mnL)); ps0 += p0[r]; p1[r] = __builtin_amdgcn_exp2f(fmaf(p1[r], C2, mnL)); ps1 += p1[r]; }
    float ps = ps0 + ps1;
    { auto rr = __builtin_amdgcn_permlane32_swap(__float_as_uint(ps), __float_as_uint(ps), false, false); ps = __uint_as_float(rr[0]) + __uint_as_float(rr[1]); }
    l_reg = l_reg * alpha + ps;
    bf16x8 pa0, pa1, pa2, pa3;
#define PK4(P, B_, OUT) do { unsigned a0 = cvtpk(P[B_+0], P[B_+1]), a1 = cvtpk(P[B_+2], P[B_+3]); unsigned b0 = cvtpk(P[B_+4], P[B_+5]), b1 = cvtpk(P[B_+6], P[B_+7]); \
        auto r0 = __builtin_amdgcn_permlane32_swap(a0, b0, false, false); auto r1 = __builtin_amdgcn_permlane32_swap(a1, b1, false, false); \
        u32x4 w = {r0[0], r1[0], r0[1], r1[1]}; OUT = *reinterpret_cast<bf16x8*>(&w); } while (0)
    PK4(p0, 0, pa0); PK4(p0, 8, pa1); PK4(p1, 0, pa2); PK4(p1, 8, pa3);
#undef PK4
    pv_half<0>(o, pa0, pa1, vcur); pv_half<1>(o, pa2, pa3, vcur);
}

template <bool LATE_>
__device__ __forceinline__ void causal_fullv_block_impl(const Blk2& cur, char* lds) {
    const int tid = opaque_tid(), wid = __builtin_amdgcn_readfirstlane(tid >> 6), lane = tid & 63, r32 = lane & 31, hi = lane >> 5;
    char* V_lds = lds; char* K_lds = lds + NVB * SHM_V2;
    float* ws = (float*)(lds + 132096) + wid * 64; float* li_l = ws; float* al_l = ws + 32;
    const int NT = (cur.P0 + QB) / KVBLK;
    const int qlo = cur.P0 + wid * QBLK, qm = qlo + r32 - 4 * hi;
    const int vb0 = (int)(uintptr_t)V_lds + v_rd_base(lane);
    unsigned koff[2];
#pragma unroll
    for (int e = 0; e < 2; ++e) { const int rl = 4 * e + (lane >> 4), c = (lane & 15) ^ (rl & 7); koff[e] = (unsigned)((8 * wid + rl) * LDKV + c * 8) * 2u; }
    const int kkl = (lane & 31) >> 2, klane = ((kkl >> 2) << 3) | (kkl & 3);
    const unsigned voff = (unsigned)((klane + 16 * (wid >> 1) + 4 * (wid & 1)) * LDKV + 32 * (lane >> 5) + 8 * (lane & 3)) * 2u;
    typedef __attribute__((address_space(3))) unsigned las_u32;
    las_u32* const lds3 = (las_u32*)lds;
#define GLDS(gp, lo) __builtin_amdgcn_global_load_lds((const unsigned*)(gp), (las_u32*)((__attribute__((address_space(3))) char*)lds3 + (lo)), 16, 0, 0)
#define DMA_TILE(k0, bf, vo) do { const char* kp_ = (const char*)(cur.K + (size_t)(k0) * LDKV); const char* vp_ = (const char*)(cur.V + (size_t)(k0) * LDKV) + voff; \
        GLDS(kp_ + koff[0], NVB * SHM_V2 + (bf) * SHM_K + 2048 * wid); GLDS(kp_ + koff[1], NVB * SHM_V2 + (bf) * SHM_K + 2048 * wid + 1024); \
        GLDS(vp_, (vo) + 2048 * wid); GLDS(vp_ + 128, (vo) + 2048 * wid + 1024); GLDS(vp_ + 256, (vo) + 16384 + 2048 * wid); GLDS(vp_ + 384, (vo) + 16384 + 2048 * wid + 1024); } while (0)
#define DMA_WAIT() asm volatile("s_waitcnt vmcnt(0)" ::: "memory")
    bf16x8 qr[8];
#pragma unroll
    for (int d0 = 0; d0 < 8; ++d0) qr[d0] = load8<bf16>(cur.Q + (size_t)(wid * QBLK + r32) * LDQ + d0 * 16 + hi * 8);
    DMA_TILE(0, 0, 0); DMA_WAIT();
    __syncthreads();
    float m_reg = -1e30f, l_reg = 0.f; f32x16 o[8];
#pragma unroll
    for (int d_ = 0; d_ < 8; ++d_) o[d_] = f32x16{};
    constexpr bool late = LATE_;
    char* pp_l = lds + 134144 + (ATTA_LATE_ODD ? (wid >> 1) : (wid & 3)) * 2048 + lane * 16;
    if (late) { *(bf16x8*)pp_l = bf16x8{}; *(bf16x8*)(pp_l + 1024) = bf16x8{}; }
    unsigned long long st[6] = {0, 0, 0, 0, 0, 0};
#if ATTA_STAMP
    const unsigned long long tb0 = __builtin_amdgcn_s_memtime();
#endif
    int vo_p = 0, vo_c = 0;
    if (!ATTA_PINGPONG && ATTA_PRIO == 1 && wid >= 4) __builtin_amdgcn_s_setprio(1);
#define NEXT_VO(v) ((v) == (NVB - 1) * SHM_V2 ? 0 : (v) + SHM_V2)
    for (int t = 0; t < NT; t += 2) {
        const int vo_n = NEXT_VO(vo_c), vo_nn = NEXT_VO(vo_n);
        DMA_TILE((t + 1) * KVBLK, 1, vo_n);
#if ATTA_T64
        fullv_tile64<0>(o, m_reg, l_reg, qr, K_lds, vb0 + vo_c, al_l, t, qlo, qm, r32, hi);
#else
        fullv_tile<0, LATE_>(o, m_reg, l_reg, qr, K_lds, vb0 + vo_c, vb0 + vo_p, al_l, t, qlo, qm, r32, hi, pp_l, st);
#endif
#if ATTA_STAMP
        { const unsigned long long tw0 = __builtin_amdgcn_s_memtime(); DMA_WAIT(); const unsigned long long tw1 = __builtin_amdgcn_s_memtime(); __syncthreads(); const unsigned long long tw2 = __builtin_amdgcn_s_memtime(); st[3] += tw1 - tw0; st[5] += tw2 - tw1; }
#else
        DMA_WAIT();
        __syncthreads();
#endif
        if (t + 2 < NT) DMA_TILE((t + 2) * KVBLK, 0, vo_nn);
#if ATTA_T64
        fullv_tile64<1>(o, m_reg, l_reg, qr, K_lds, vb0 + vo_n, al_l, t + 1, qlo, qm, r32, hi);
#else
        fullv_tile<1, LATE_>(o, m_reg, l_reg, qr, K_lds, vb0 + vo_n, vb0 + vo_c, al_l, t + 1, qlo, qm, r32, hi, pp_l, st);
#endif
#if ATTA_STAMP
        { const unsigned long long tw0 = __builtin_amdgcn_s_memtime(); DMA_WAIT(); const unsigned long long tw1 = __builtin_amdgcn_s_memtime(); __syncthreads(); const unsigned long long tw2 = __builtin_amdgcn_s_memtime(); st[3] += tw1 - tw0; st[5] += tw2 - tw1; }
#else
        DMA_WAIT();
        __syncthreads();
#endif
        vo_p = vo_n; vo_c = vo_nn;
    }
    if (late) { const bf16x8 q0 = *(const bf16x8*)pp_l, q1 = *(const bf16x8*)(pp_l + 1024); pv_half<1>(o, q0, q1, vb0 + vo_p); }
#undef NEXT_VO
#undef DMA_TILE
#undef DMA_WAIT
#undef GLDS
#undef NEXT_VO
    __builtin_amdgcn_s_setprio(0);
#if ATTA_STAMP
    if (blockIdx.x == 0 && wid == ATTA_STAMP_WAVE && lane == 0) { atomicAdd(cur.stamp + 0, st[0]); atomicAdd(cur.stamp + 1, st[1]); atomicAdd(cur.stamp + 2, st[2]); atomicAdd(cur.stamp + 3, st[3]); atomicAdd(cur.stamp + 5, st[5]); atomicAdd(cur.stamp + 4, __builtin_amdgcn_s_memtime() - tb0); }
#endif
    if (ATTA_PINGPONG) __syncthreads();
    if (hi == 0) li_l[r32] = l_reg; asm volatile("s_waitcnt lgkmcnt(0)" ::: "memory");
    char* stg = lds + wid * 16384;
#pragma unroll
    for (int r = 0; r < 16; ++r) { const float rl = __builtin_amdgcn_rcpf(li_l[crow(r, hi)]); const int orow = crow(r, hi);
#pragma unroll
        for (int d0 = 0; d0 < 8; ++d0) { const float v = o[d0][r] * rl; *(unsigned short*)(stg + orow * 512 + (d0 * 32 + r32) * 2) = (unsigned short)cvtpk(v, v); } }
    asm volatile("s_waitcnt lgkmcnt(0)" ::: "memory");
    bf16* Ow = cur.O + (size_t)(wid * QBLK) * LDO;
#pragma unroll
    for (int i = 0; i < 16; ++i) { const int row = 2 * i + (lane >> 5), ch = lane & 31;
        const u32x4 v = *(const u32x4*)(stg + row * 512 + ch * 16); store16_wt(Ow + (size_t)row * LDO + ch * 8, v); }
    __syncthreads();
}
__device__ __forceinline__ void causal_fullv_block(const Blk2& cur, char* lds) {
    const int wid_ = __builtin_amdgcn_readfirstlane(opaque_tid() >> 6);
    if (ATTA_PINGPONG && (ATTA_LATE_ODD ? (wid_ & 1) != 0 : wid_ >= ATTA_LATE_FROM)) causal_fullv_block_impl<true>(cur, lds); else causal_fullv_block_impl<false>(cur, lds);
}
#undef KSWZ
#undef SBAR
}

namespace attB {
typedef short bf16x8 __attribute__((ext_vector_type(8)));
typedef short s16x4 __attribute__((ext_vector_type(4)));
typedef float f32x16 __attribute__((ext_vector_type(16)));
typedef unsigned u32x4 __attribute__((ext_vector_type(4)));
typedef unsigned short bf16_t;
constexpr int HD = 64, LD = NQKV_B, KOFF = 2048, VOFF = 2304, LDO = DM;
constexpr int LDS_K = 0, LDS_V = 32768, LDS_S = 65536, LDS_O = 69632, LDS_BYTES = LDS_O + 8 * 4096;
constexpr float C2 = 0.125f * 1.4426950408889634f;
__device__ __forceinline__ int crow(int r, int hi) { return (r & 3) + 8 * (r >> 2) + 4 * hi; }
__device__ __forceinline__ unsigned cvtpk(float lo, float hi) { unsigned r; asm volatile("v_cvt_pk_bf16_f32 %0, %1, %2" : "=v"(r) : "v"(lo), "v"(hi)); return r; }
typedef short v4i16_t __attribute__((ext_vector_type(4)));
__device__ __forceinline__ s16x4 vtr(LAS const unsigned char* p) { return __builtin_bit_cast(s16x4, __builtin_amdgcn_ds_read_tr16_b64_v4i16((LAS v4i16_t*)p)); }

__device__ __forceinline__ void swa_unit(int b, int kvh, int n, const bf16_t* __restrict__ QKV, const float* __restrict__ sinks, bf16_t* __restrict__ O, LAS unsigned char* lds) {
    const int tid = opaque_tid(), lane = tid & 63, r32 = lane & 31, hi = lane >> 5, wid = __builtin_amdgcn_readfirstlane(tid >> 6);
    __syncthreads();
    const size_t tok0 = (size_t)b * SEQ;
#pragma unroll
    for (int i = 0; i < 4; ++i) {
        const int c = tid + 512 * i, row = c >> 3, ch = c & 7, t = n * 128 - 128 + row;
        u32x4 kv = {0u, 0u, 0u, 0u}, vv = {0u, 0u, 0u, 0u};
        if (t >= 0) { const bf16_t* p = QKV + (tok0 + (size_t)t) * LD + kvh * HD + ch * 8; kv = *(const u32x4*)(p + KOFF); vv = *(const u32x4*)(p + VOFF); }
        *(LAS u32x4*)(lds + LDS_K + row * 128 + ((ch ^ ((row >> 1) & 7)) << 4)) = kv;
        *(LAS u32x4*)(lds + LDS_V + row * 128 + (ch << 4)) = vv;
    }
    __syncthreads();
    const int hq = kvh * 8 + wid;
    const float sink2 = sinks[hq] * 1.4426950408889634f;
    LAS float* scr = (LAS float*)(lds + LDS_S) + wid * 32;
    const int vq = (lane & 15) >> 2, vp = lane & 3, vg1 = (lane >> 4) & 1;
    LAS const unsigned char* vbase = lds + LDS_V + (4 * hi + vq) * 128 + (16 * vg1 + 4 * vp) * 2;
    const float NEG = -__builtin_inff();
    for (int qs = 0; qs < 4; ++qs) {
        const size_t tq = tok0 + (size_t)(n * 128 + 32 * qs + r32);
        bf16x8 qr[4];
#pragma unroll
        for (int d0 = 0; d0 < 4; ++d0) qr[d0] = *(const bf16x8*)(QKV + tq * LD + hq * HD + d0 * 16 + hi * 8);
        f32x16 p[5];
#pragma unroll
        for (int tt = 0; tt < 5; ++tt) {
            const int kt = qs + tt; const bool dead = (n == 0) && (kt < 4);
            p[tt] = f32x16{};
            if (!dead) { const int krow = kt * 32 + r32;
#pragma unroll
                for (int d0 = 0; d0 < 4; ++d0) { const bf16x8 kf = *(LAS const bf16x8*)(lds + LDS_K + krow * 128 + (((d0 * 2 + hi) ^ ((krow >> 1) & 7)) << 4));
                    p[tt] = __builtin_amdgcn_mfma_f32_32x32x16_bf16(kf, qr[d0], p[tt], 0, 0, 0); } }
#pragma unroll
            for (int r = 0; r < 16; ++r) { const int c = crow(r, hi); bool valid = !dead;
                if (tt == 0) valid = valid && (c > r32);
                if (tt == 4) valid = valid && (c <= r32);
                p[tt][r] = valid ? p[tt][r] * C2 : NEG; }
        }
        float mx = sink2;
#pragma unroll
        for (int tt = 0; tt < 5; ++tt)
#pragma unroll
            for (int r = 0; r < 16; ++r) mx = fmaxf(mx, p[tt][r]);
        mx = half_max32(mx);
        float sum = 0.f;
#pragma unroll
        for (int tt = 0; tt < 5; ++tt)
#pragma unroll
            for (int r = 0; r < 16; ++r) { const float e = __builtin_amdgcn_exp2f(p[tt][r] - mx); p[tt][r] = e; sum += e; }
        sum = half_sum32(sum);
        sum += __builtin_amdgcn_exp2f(sink2 - mx);
        if (hi == 0) scr[r32] = 1.0f / sum;
        f32x16 o[2]; o[0] = f32x16{}; o[1] = f32x16{};
#pragma unroll
        for (int tt = 0; tt < 5; ++tt) {
            const int kt = qs + tt; const bool dead = (n == 0) && (kt < 4);
            if (!dead) {
#pragma unroll
                for (int s = 0; s < 2; ++s) {
                    u32x4 w; w.x = cvtpk(p[tt][8 * s + 0], p[tt][8 * s + 1]); w.y = cvtpk(p[tt][8 * s + 2], p[tt][8 * s + 3]); w.z = cvtpk(p[tt][8 * s + 4], p[tt][8 * s + 5]); w.w = cvtpk(p[tt][8 * s + 6], p[tt][8 * s + 7]);
                    const bf16x8 pa = __builtin_bit_cast(bf16x8, w);
#pragma unroll
                    for (int d0 = 0; d0 < 2; ++d0) { LAS const unsigned char* vp_ = vbase + (kt * 32 + 16 * s) * 128 + d0 * 64;
                        const s16x4 lo = vtr(vp_), hh = vtr(vp_ + 8 * 128);
                        const bf16x8 vf = {lo[0], lo[1], lo[2], lo[3], hh[0], hh[1], hh[2], hh[3]};
                        o[d0] = __builtin_amdgcn_mfma_f32_32x32x16_bf16(pa, vf, o[d0], 0, 0, 0); }
                }
            }
        }
        bf16_t* Ow = O + (tok0 + (size_t)(n * 128 + 32 * qs)) * LDO + hq * HD;
        LAS unsigned char* stg = lds + LDS_O + wid * 4096;
#pragma unroll
        for (int r = 0; r < 16; ++r) { const int orow = crow(r, hi); const float ri = scr[orow];
#pragma unroll
            for (int d0 = 0; d0 < 2; ++d0) { const float v = o[d0][r] * ri; *(LAS unsigned short*)(stg + orow * 128 + (d0 * 32 + r32) * 2) = (unsigned short)cvtpk(v, v); } }
        asm volatile("s_waitcnt lgkmcnt(0)" ::: "memory");
#pragma unroll
        for (int i = 0; i < 4; ++i) { const int row = 8 * i + (lane >> 3), ch = lane & 7;
            const u32x4 v = *(LAS const u32x4*)(stg + row * 128 + ch * 16); store16_wt(Ow + (size_t)row * LDO + ch * 8, v); }
    }
}
}

constexpr int NWAVES = 8;
#ifndef MK_PER_PHASE
#define MK_PER_PHASE 0
#endif
constexpr int N_PHASES = 3 + 8 * DEPTH;

constexpr size_t MiB = 1u << 20;
constexpr size_t WS_CTL = 0, CTL_ZERO_BYTES = 1 * MiB;
constexpr size_t WS_STATS = 1198 * MiB;
constexpr size_t WS_MOD = 2 * MiB;
constexpr size_t WS_TABA = 3 * MiB;
constexpr size_t WS_TABB = 5 * MiB;
constexpr size_t WS_BPERM = 6 * MiB;
constexpr size_t WS_WUP = 8 * MiB, WS_WDN = 40 * MiB, WS_WMLP_STRIDE = 64 * MiB;
constexpr size_t WS_WQKVA = 264 * MiB, WS_WOA = 288 * MiB, WS_WA_STRIDE = 32 * MiB;
constexpr size_t WS_WQKVB = 328 * MiB, WS_WOB = 338 * MiB, WS_WB_STRIDE = 18 * MiB;
constexpr size_t WS_X = 364 * MiB;
constexpr size_t WS_HB = 492 * MiB;
constexpr size_t WS_QKV = 556 * MiB;
constexpr size_t WS_AO = 748 * MiB;
constexpr size_t WS_AC = 876 * MiB;
constexpr size_t WS_HID = 940 * MiB;
constexpr size_t WS_CS = 1196 * MiB, WS_CB = 1197 * MiB;
constexpr size_t WS_GN = 6 * MiB + 64 * 1024;
constexpr int CSTRIDE = 8192;
constexpr size_t WS_ZEROS = 768 * 1024;
constexpr size_t WS_ONES = 6 * MiB + 32 * 1024;
constexpr size_t WS_IDENT = 6 * MiB + 48 * 1024;
constexpr size_t WS_IG = 6 * MiB + 640 * 1024;
constexpr size_t WS_NEUTRAL = 1 * MiB;
constexpr size_t WS_PROBE = 7 * MiB;
constexpr size_t WS_QKVB = 1206 * MiB;
constexpr size_t WS_END = 1286 * MiB;
constexpr int CW_TMO = 0, CW_CODE = 1, CW_BAR = 4096;
constexpr int CW_PSUB = 16384, CW_PGEN = 20480;
constexpr int CW_XMASK = 8192, CW_LSUB = 8192 + 1024, CW_LGEN = 8192 + 2048;

constexpr int RING_OFF = 0, RING_BYTES = 131072;
constexpr int LDSCTL_OFF = RING_BYTES, MISC_OFF = LDSCTL_OFF + 320, STATTBL_OFF = LDSCTL_OFF + 1024;
constexpr int LDS_BYTES = 147456;
static_assert(attA::LDS_BYTES <= RING_BYTES && attA::LDS2_BYTES <= RING_BYTES && attB::LDS_BYTES <= RING_BYTES, "attention scratch fits the ring region");

struct Frame {
    LAS unsigned char* lds;
    volatile LAS unsigned* MISC;
    gu32* ctl;
    int vcu, G;
};
#define FR_IDS() const int f_tid = opaque_tid(), f_lane = f_tid & 63, f_wave = __builtin_amdgcn_readfirstlane(f_tid >> 6); (void)f_tid; (void)f_lane; (void)f_wave

__device__ __forceinline__ float wave_sum(float v) {
    v += lane_xor<1>(v); v += lane_xor<2>(v); v += lane_xor<4>(v); v += lane_xor<8>(v); v += lane_xor<16>(v);
    return half_sum32(v);
}
__device__ __forceinline__ float bf2f(unsigned short u) { return __uint_as_float((unsigned)u << 16); }

__device__ __forceinline__ int dest_row(int n, int mode) {
    if (mode == 1 && n < 4096) { const int j = n & 127; return (n & ~127) + (((j & 63) << 1) | (j >> 6)); }
    if (mode == 2 && n < 2304) { const int j = n & 63; return (n & ~63) + (((j & 31) << 1) | (j >> 5)); }
    return n;
}
struct ConvDesc { bf16* dst; int K, mode, n0, k0; };
__device__ __forceinline__ int kpos(int k, int mode) { return mode == 3 ? ((k & ~255) | (((((k >> 5) & 3) << 1) | ((k >> 7) & 1)) << 5) | (k & 31)) : k; }
#ifndef CONV_SHAPE
#define CONV_SHAPE 0
#endif
#if CONV_SHAPE == 0
__device__ __forceinline__ void conv_issue(const float* W, int K, int N, bf16* WT, int mode, int item, int lane, ConvDesc& D, float (&wv)[32]) {
    const int nblk = N / 32, kb = item / nblk, nb = item % nblk, k0 = 64 * kb, n0 = 32 * nb;
    const float* p = W + (size_t)(k0 + (lane >> 5)) * N + n0 + (lane & 31);
#pragma unroll
    for (int i = 0; i < 32; ++i) wv[i] = p[(size_t)(2 * i) * N];
    D.dst = WT; D.K = K; D.mode = mode; D.n0 = n0; D.k0 = k0;
}
__device__ __forceinline__ void conv_finish(const ConvDesc& D, const float (&wv)[32], LAS float* scr, int lane) {
#pragma unroll
    for (int i = 0; i < 32; ++i) { const int kk = 2 * i + (lane >> 5); scr[kk * 33 + (lane & 31)] = wv[i]; }
    LDS_WAIT(); asm volatile("" ::: "memory");
    const int c = lane & 7;
#pragma unroll
    for (int j = 0; j < 4; ++j) { const int n = (lane >> 3) + 8 * j; const LAS float* s = scr + (8 * c) * 33 + n;
        v4u o; o.x = pk2(s[0 * 33], s[1 * 33]); o.y = pk2(s[2 * 33], s[3 * 33]); o.z = pk2(s[4 * 33], s[5 * 33]); o.w = pk2(s[6 * 33], s[7 * 33]);
        *(GAS v4u*)(D.dst + (size_t)dest_row(D.n0 + n, D.mode) * D.K + kpos(D.k0 + 8 * c, D.mode)) = o; }
    LDS_WAIT(); asm volatile("" ::: "memory");
}
#else
__device__ __forceinline__ void conv_issue(const float* W, int K, int N, bf16* WT, int mode, int item, int lane, ConvDesc& D, float (&wv)[32]) {
    const int nblk = N / 64, kb = item / nblk, nb = item % nblk, k0 = 32 * kb, n0 = 64 * nb;
    const float* p = W + (size_t)k0 * N + n0 + lane;
#pragma unroll
    for (int i = 0; i < 32; ++i) wv[i] = p[(size_t)i * N];
    D.dst = WT; D.K = K; D.mode = mode; D.n0 = n0; D.k0 = k0;
}
__device__ __forceinline__ void conv_finish(const ConvDesc& D, const float (&wv)[32], LAS float* scr, int lane) {
#pragma unroll
    for (int i = 0; i < 32; ++i) scr[i * 65 + lane] = wv[i];
    LDS_WAIT(); asm volatile("" ::: "memory");
    const int c = lane & 3;
#pragma unroll
    for (int j = 0; j < 4; ++j) { const int n = (lane >> 2) + 16 * j; const LAS float* s = scr + (8 * c) * 65 + n;
        v4u o; o.x = pk2(s[0 * 65], s[1 * 65]); o.y = pk2(s[2 * 65], s[3 * 65]); o.z = pk2(s[4 * 65], s[5 * 65]); o.w = pk2(s[6 * 65], s[7 * 65]);
        *(GAS v4u*)(D.dst + (size_t)dest_row(D.n0 + n, D.mode) * D.K + kpos(D.k0 + 8 * c, D.mode)) = o; }
    LDS_WAIT(); asm volatile("" ::: "memory");
}
#endif
__device__ __forceinline__ void sincos_d(double x, double& sn, double& cs) {
    const double k = __builtin_rint(x * 0.63661977236758134308);
    double r = __builtin_fma(-k, 1.57079632673412561417e+00, x); r = __builtin_fma(-k, 6.07710050650619224932e-11, r);
    const double r2 = r * r;
    double ps = -1.0 / 1307674368000.0; ps = ps * r2 + 1.0 / 6227020800.0; ps = ps * r2 - 1.0 / 39916800.0; ps = ps * r2 + 1.0 / 362880.0; ps = ps * r2 - 1.0 / 5040.0; ps = ps * r2 + 1.0 / 120.0; ps = ps * r2 - 1.0 / 6.0; ps = ps * r2 * r + r;
    double pc = 1.0 / 20922789888000.0; pc = pc * r2 - 1.0 / 87178291200.0; pc = pc * r2 + 1.0 / 479001600.0; pc = pc * r2 - 1.0 / 3628800.0; pc = pc * r2 + 1.0 / 40320.0; pc = pc * r2 - 1.0 / 720.0; pc = pc * r2 + 1.0 / 24.0; pc = pc * r2 - 0.5; pc = pc * r2 + 1.0;
    const int q = (int)k & 3;
    sn = (q == 0) ? ps : (q == 1) ? pc : (q == 2) ? -ps : -pc;
    cs = (q == 0) ? pc : (q == 1) ? -ps : (q == 2) ? -pc : ps;
}
__device__ __forceinline__ void rope_entry(float* tab, int idx, int half, double base_ratio) {
    const int s = idx / half, j = idx % half;
    double inv = 1.0, rr = base_ratio;
    for (int t = j; t; t >>= 1) { if (t & 1) inv *= rr; rr *= rr; }
    const float invf = (float)inv, angf = (float)s * invf;
    double sn, cs; sincos_d((double)angf, sn, cs);
    tab[2 * (size_t)idx] = (float)cs; tab[2 * (size_t)idx + 1] = (float)sn;
}

struct Args { const float* in[22]; float* out; unsigned char* ws; int ph_lo, ph_hi; };
typedef __attribute__((address_space(4))) const Args CArgs;

constexpr int CONV_ITEMS = 4 * 16384 + 2 * 8192 + 2 * 4608;
constexpr int CONV_NOW = 16384 + 8192 + 4608;
constexpr int CONV_LATER = CONV_ITEMS - CONV_NOW;
__device__ __forceinline__ int now_item(int d) { return d < 16384 ? d : d < 24576 ? 65536 + (d - 16384) : 81920 + (d - 24576); }
__device__ __forceinline__ void convert_issue(CArgs* ap, int it, int lane, ConvDesc& D, float (&wv)[32]) {
    unsigned char* ws = ap->ws;
    int r = it; const float* W; bf16* WT; int K, N, mode = 0, item;
    if (r < 65536) { const int L = r >> 14, rr = r & 16383;
        if (rr < 8192) { W = ap->in[8] + (size_t)L * DM * DFF; K = DM; N = DFF; WT = (bf16*)(ws + WS_WUP + L * WS_WMLP_STRIDE); item = rr; }
        else { W = ap->in[9] + (size_t)L * DFF * DM; K = DFF; N = DM; WT = (bf16*)(ws + WS_WDN + L * WS_WMLP_STRIDE); item = rr - 8192; mode = HID_PERM ? 3 : 0; } }
    else { r -= 65536;
        if (r < 16384) { const int j = r >> 13, rr = r & 8191;
            if (rr < 6144) { W = ap->in[10] + (size_t)j * DM * NQKV_A; K = DM; N = NQKV_A; WT = (bf16*)(ws + WS_WQKVA + j * WS_WA_STRIDE); mode = 1; item = rr; }
            else { W = ap->in[11] + (size_t)j * DM * DM; K = DM; N = DM; WT = (bf16*)(ws + WS_WOA + j * WS_WA_STRIDE); item = rr - 6144; } }
        else { r -= 16384; const int j = r / 4608, rr = r % 4608;
            if (rr < 2560) { W = ap->in[17] + (size_t)j * DM * NQKV_B; K = DM; N = NQKV_B; WT = (bf16*)(ws + WS_WQKVB + j * WS_WB_STRIDE); mode = 2; item = rr; }
            else { W = ap->in[20] + (size_t)j * DM * DM; K = DM; N = DM; WT = (bf16*)(ws + WS_WOB + j * WS_WB_STRIDE); item = rr - 2560; } } }
    conv_issue(W, K, N, WT, mode, item, lane, D, wv);
}
__device__ __forceinline__ void convert_item(CArgs* ap, int it, LAS float* scr, int lane) {
    ConvDesc D; float wv[32]; convert_issue(ap, it, lane, D, wv); conv_finish(D, wv, scr, lane);
}
#ifndef CONV_NCH
#define CONV_NCH 4
#endif
constexpr int CONV_CHUNKS = CONV_NCH;
__device__ __forceinline__ int deferred_item(int d) { return d < 49152 ? 16384 + d : d < 57344 ? 73728 + (d - 49152) : 86528 + (d - 57344); }
__device__ __forceinline__ void convert_chunk(CArgs* ap, char* ring, int q) {
    FR_IDS();
#if CONV_PROBE
    if (f_tid == 0) *(unsigned long long*)(ring + 140000) = __builtin_amdgcn_s_memrealtime();
#endif
    LAS float* scr = (LAS float*)(ring + f_wave * 16384);
    const int gw = (int)blockIdx.x * NWAVES + f_wave, NGW = (int)gridDim.x * NWAVES;
    constexpr int PER = (CONV_LATER + 2048 * CONV_CHUNKS - 1) / (2048 * CONV_CHUNKS);
    const int per = (NGW == 2048) ? PER : (CONV_LATER + NGW * CONV_CHUNKS - 1) / (NGW * CONV_CHUNKS);
    const int d0 = gw + NGW * (q * per);
    ConvDesc da, db; float va[32], vb[32];
    bool ha = d0 < CONV_LATER, hb = false;
    if (ha) convert_issue(ap, deferred_item(d0), f_lane, da, va);
    for (int jj = 0; jj < per; jj += 2) {
        const int d1 = d0 + NGW * (jj + 1), d2 = d0 + NGW * (jj + 2);
        hb = (jj + 1 < per) && d1 < CONV_LATER;
        if (hb) convert_issue(ap, deferred_item(d1), f_lane, db, vb);
        if (ha) conv_finish(da, va, scr, f_lane);
        ha = (jj + 2 < per) && d2 < CONV_LATER;
        if (ha) convert_issue(ap, deferred_item(d2), f_lane, da, va);
        if (hb) conv_finish(db, vb, scr, f_lane);
    }
    __syncthreads();
#if CONV_PROBE
    if (blockIdx.x == PROBE_WG && f_tid == 0) atomicAdd((unsigned long long*)(ap->ws + 512 * 1024 + 64), __builtin_amdgcn_s_memrealtime() - *(unsigned long long*)(ring + 140000));
#endif
}
__device__ __forceinline__ void p0_prologue(Frame& F, CArgs* ap) {
    FR_IDS();
    unsigned char* ws = ap->ws;
    {
        LAS float* cact = (LAS float*)F.lds;
        LAS float* part = (LAS float*)(F.lds + 32768);
        const float* cin = ap->in[1];
        for (int i = f_tid; i < NB * DM; i += NWAVES * 64) { const float c = cin[i]; cact[i] = c / (1.0f + expf(-c)); }
        __syncthreads();
        float* mod = (float*)(ws + WS_MOD);
        for (int it = F.vcu; it < 256; it += F.G) {
            const int L = it >> 6, cb = it & 63;
            if (f_lane < 48) {
                const float* Wp = ap->in[2] + ((size_t)L * DM + 256 * f_wave) * (NMOD * DM) + 192 * cb + 4 * f_lane;
                f32x4 a0 = {0.f, 0.f, 0.f, 0.f}, a1 = a0, a2 = a0, a3 = a0;
#pragma unroll 8
                for (int kk = 0; kk < 256; ++kk) { const f32x4 w = *(const f32x4*)(Wp + (size_t)kk * (NMOD * DM)); const int k = 256 * f_wave + kk;
                    a0 += w * cact[k]; a1 += w * cact[DM + k]; a2 += w * cact[2 * DM + k]; a3 += w * cact[3 * DM + k]; }
                LAS f32x4* pp = (LAS f32x4*)(part + (f_wave * NB) * 192) + f_lane;
                pp[0] = a0; pp[48] = a1; pp[96] = a2; pp[144] = a3;
            }
            __syncthreads();
            for (int o = f_tid; o < NB * 192; o += NWAVES * 64) { const int b = o / 192, cc = o % 192; float s = 0.f;
#pragma unroll
                for (int w = 0; w < 8; ++w) s += part[(w * NB + b) * 192 + cc];
                mod[((size_t)L * NB + b) * (NMOD * DM) + 192 * cb + cc] = s + ap->in[3][(size_t)L * (NMOD * DM) + 192 * cb + cc]; }
            __syncthreads();
        }
    }
    {
        LAS float* scr = (LAS float*)(F.lds + RING_OFF + f_wave * 16384);
        const int gw = F.vcu * NWAVES + f_wave, NGW = F.G * NWAVES;
#if CONV_DEFER
        for (int d = gw; d < CONV_NOW; d += NGW) convert_item(ap, now_item(d), scr, f_lane);
#else
        for (int d = gw; d < CONV_ITEMS; d += NGW) convert_item(ap, d, scr, f_lane);
#endif
    }
    {
        const int gt = F.vcu * (NWAVES * 64) + f_tid, NGT = F.G * NWAVES * 64;
        float* tabA = (float*)(ws + WS_TABA); float* tabB = (float*)(ws + WS_TABB);
        for (int idx = gt; idx < SEQ * 64; idx += NGT) rope_entry(tabA, idx, 64, 0.86596432336006535);
        for (int idx = gt; idx < SEQ * 32; idx += NGT) rope_entry(tabB, idx, 32, 0.74989420933245582);
        for (int idx = gt; idx < DM; idx += NGT) ((float*)(ws + WS_ONES))[idx] = 1.0f;
        if (gt < 8) ((float*)(ws + WS_IDENT))[gt] = (gt & 1) ? 0.f : 1.f;
        for (int idx = gt; idx < MTOK * 16; idx += NGT) ((float*)(ws + WS_NEUTRAL))[idx] = ((idx & 15) == 1) ? 2048.0f * (1.0f - LN_EPS) : 0.f;
        float* bp = (float*)(ws + WS_BPERM);
        for (int idx = gt; idx < 2 * NQKV_B; idx += NGT) { const int j = idx / NQKV_B, n = idx % NQKV_B;
            int src = n; if (n < 2304) { const int p = n & 63; src = (n & ~63) + (p >> 1) + 32 * (p & 1); }
            bp[idx] = ap->in[18][(size_t)j * NQKV_B + src]; }
    }
}
__device__ __forceinline__ void h0_phase(Frame& F, const float* x, const float* sc, const float* sh, bf16* hb, bf16* xb) {
    FR_IDS();
    const int m0 = 256 * (8 * ((int)blockIdx.x & 7) + (((int)blockIdx.x >> 3) & 7)) + ((int)blockIdx.x >> 6) * 64 + f_wave * 8;
    for (int m = m0; m < m0 + 8; ++m) {
        const int b = m / SEQ;
        const GAS f32x4* xr = (const GAS f32x4*)(x + (size_t)m * DM) + f_lane;
        const f32x4* scp = (const f32x4*)(sc + (size_t)b * (NMOD * DM)) + f_lane; const f32x4* shp = (const f32x4*)(sh + (size_t)b * (NMOD * DM)) + f_lane;
        GAS unsigned long long* o8 = (GAS unsigned long long*)(hb + (size_t)m * DM) + f_lane; GAS unsigned long long* x8 = (GAS unsigned long long*)(xb + (size_t)m * DM) + f_lane;
#pragma unroll
        for (int j = 0; j < 8; ++j) { const f32x4 xv = xr[64 * j]; const f32x4 v = xv * (scp[64 * j] + 1.0f) + shp[64 * j];
            o8[64 * j] = (unsigned long long)pk2(v.x, v.y) | ((unsigned long long)pk2(v.z, v.w) << 32);
            x8[64 * j] = (unsigned long long)pk2(xv.x, xv.y) | ((unsigned long long)pk2(xv.z, xv.w) << 32); }
    }
}
__device__ __forceinline__ void final_ln_phase(Frame& F, const float* vin, const float* st, float* xout, const float* g, const float* bln) {
    FR_IDS();
    const int m0 = 256 * (8 * ((int)blockIdx.x & 7) + (((int)blockIdx.x >> 3) & 7)) + ((int)blockIdx.x >> 6) * 64 + f_wave * 8;
    for (int m = m0; m < m0 + 8; ++m) {
        float mu, r; pg8::row_mu_r(st, m, mu, r);
        const GAS f32x4* xr = (const GAS f32x4*)(vin + (size_t)m * DM) + f_lane;
        const f32x4* gp = (const f32x4*)g + f_lane; const f32x4* bp = (const f32x4*)bln + f_lane;
        GAS f32x4* xo = (GAS f32x4*)(xout + (size_t)m * DM) + f_lane;
#pragma unroll
        for (int j = 0; j < 8; ++j) xo[64 * j] = (xr[64 * j] - mu) * r * gp[64 * j] + bp[64 * j];
    }
}
__device__ __forceinline__ void fold_phase(Frame& F, CArgs* ap, int s_lo, int s_hi, bool gn) {
    FR_IDS();
    unsigned char* ws = ap->ws;
    LAS float* GL = (LAS float*)F.lds;
    const float* mod = (const float*)(ws + WS_MOD);
    for (int s = 0; s < 7; ++s) {
        const bool do_c = s >= s_lo && s < s_hi, do_g = gn && F.vcu == s;
        if (!do_c && !do_g) continue;
        const int L = s >> 1, odd = s & 1, Lc = L + odd;
        const float* g = (odd ? ap->in[6] : ap->in[4]) + (size_t)L * DM; const float* bl = (odd ? ap->in[7] : ap->in[5]) + (size_t)L * DM;
        const float* mc = mod + (size_t)Lc * NB * NMOD * DM + (odd ? 0 : 3 * DM);
        __syncthreads();
        {
            const int k = 4 * f_tid;
            const f32x4 gv = *(const f32x4*)(g + k), blv = *(const f32x4*)(bl + k);
            f32x4 scv[NB], shv[NB];
#pragma unroll
            for (int b = 0; b < NB; ++b) { scv[b] = *(const f32x4*)(mc + (size_t)b * NMOD * DM + DM + k) + 1.0f; shv[b] = *(const f32x4*)(mc + (size_t)b * NMOD * DM + k); }
#pragma unroll
            for (int b = 0; b < NB; ++b) { const f32x4 G = gv * scv[b];
                *(LAS f32x4*)(GL + b * DM + k) = G; *(LAS f32x4*)(GL + (4 + b) * DM + k) = blv * scv[b] + shv[b];
                if (do_g) { *(f32x4*)((float*)(ws + WS_GN) + ((size_t)s * NB + b) * DM + k) = G;
                    *(f32x4*)((float*)(ws + WS_IG) + ((size_t)s * NB + b) * DM + k) = (f32x4){1.0f / scv[b][0], 1.0f / scv[b][1], 1.0f / scv[b][2], 1.0f / scv[b][3]}; } }
        }
        __syncthreads();
        if (!do_c) continue;
        const bf16* Wt; int N;
        if (!odd) { Wt = (const bf16*)(ws + WS_WUP + Lc * WS_WMLP_STRIDE); N = DFF; }
        else if (Lc & 1) { Wt = (const bf16*)(ws + WS_WQKVB + (Lc >> 1) * WS_WB_STRIDE); N = NQKV_B; }
        else { Wt = (const bf16*)(ws + WS_WQKVA + (Lc >> 1) * WS_WA_STRIDE); N = NQKV_A; }
        float* cs = (float*)(ws + WS_CS) + (size_t)s * NB * CSTRIDE; float* cb = (float*)(ws + WS_CB) + (size_t)s * NB * CSTRIDE;
        const int n0 = F.vcu * NWAVES + f_wave, NGW = F.G * NWAVES;
        for (int nb = n0; nb < N; nb += 4 * NGW) {
            v4u wv[4][4];
#pragma unroll
            for (int j = 0; j < 4; ++j) { const int n = nb + j * NGW < N ? nb + j * NGW : nb;
#pragma unroll
                for (int i = 0; i < 4; ++i) wv[j][i] = *(const GAS v4u*)(Wt + (size_t)n * DM + 8 * (f_lane + 64 * i)); }
#pragma unroll
            for (int j = 0; j < 4; ++j) { const int n = nb + j * NGW; if (n >= N) break;
                asm volatile("" ::: "memory");
                float a[8] = {0.f, 0.f, 0.f, 0.f, 0.f, 0.f, 0.f, 0.f};
#pragma unroll
                for (int i = 0; i < 4; ++i) { const int k0 = 8 * (f_lane + 64 * i); const v4u w4 = wv[j][i];
                    float w[8]; w[0] = __uint_as_float(w4.x << 16); w[1] = __uint_as_float(w4.x & 0xffff0000u); w[2] = __uint_as_float(w4.y << 16); w[3] = __uint_as_float(w4.y & 0xffff0000u);
                    w[4] = __uint_as_float(w4.z << 16); w[5] = __uint_as_float(w4.z & 0xffff0000u); w[6] = __uint_as_float(w4.w << 16); w[7] = __uint_as_float(w4.w & 0xffff0000u);
#pragma unroll
                    for (int v = 0; v < 8; ++v) { const f32x4 g0 = *(const LAS f32x4*)(GL + v * DM + k0), g1 = *(const LAS f32x4*)(GL + v * DM + k0 + 4);
                        a[v] += (w[0] * g0[0] + w[1] * g0[1]) + (w[2] * g0[2] + w[3] * g0[3]) + (w[4] * g1[0] + w[5] * g1[1]) + (w[6] * g1[2] + w[7] * g1[3]); } }
#pragma unroll
                for (int v = 0; v < 8; ++v) a[v] = wave_sum(a[v]);
                if (f_lane == 0) {
#pragma unroll
                    for (int b = 0; b < 4; ++b) { cs[(size_t)b * CSTRIDE + n] = a[b]; cb[(size_t)b * CSTRIDE + n] = a[4 + b]; } }
            }
        }
    }
    __syncthreads();
}
__device__ __forceinline__ void combine_phase(Frame& F, const bf16* AO, bf16* AC, const float* lq1, const float* lk1, const float* lq2, const float* lk2, const float* gsub, float lam_init) {
    FR_IDS();
    const float d1 = wave_sum(lq1[f_lane] * lk1[f_lane] + lq1[f_lane + 64] * lk1[f_lane + 64]);
    const float d2 = wave_sum(lq2[f_lane] * lk2[f_lane] + lq2[f_lane + 64] * lk2[f_lane + 64]);
    const float lam = expf(d1) - expf(d2) + lam_init;
    const f32x4 gs = *((const f32x4*)gsub + f_lane) * (1.0f - lam_init);
    const int m0 = 256 * (8 * ((int)blockIdx.x & 7) + (((int)blockIdx.x >> 3) & 7)) + ((int)blockIdx.x >> 6) * 64 + f_wave * 8;
    for (int m = m0; m < m0 + 8; ++m) {
        const GAS unsigned long long* ip = (const GAS unsigned long long*)(AO + (size_t)m * (2 * DM)) + f_lane;
        GAS unsigned long long* op = (GAS unsigned long long*)(AC + (size_t)m * DM) + f_lane;
        unsigned long long r1[8], r2[8];
#pragma unroll
        for (int h = 0; h < 8; ++h) { r1[h] = ip[(2 * h) * 64]; r2[h] = ip[(2 * h + 1) * 64]; }
#pragma unroll
        for (int h = 0; h < 8; ++h) {
            f32x4 d;
            d.x = bf2f((unsigned short)(r1[h])) - lam * bf2f((unsigned short)(r2[h]));
            d.y = bf2f((unsigned short)(r1[h] >> 16)) - lam * bf2f((unsigned short)(r2[h] >> 16));
            d.z = bf2f((unsigned short)(r1[h] >> 32)) - lam * bf2f((unsigned short)(r2[h] >> 32));
            d.w = bf2f((unsigned short)(r1[h] >> 48)) - lam * bf2f((unsigned short)(r2[h] >> 48));
            const float ss = wave_sum((d.x * d.x + d.y * d.y) + (d.z * d.z + d.w * d.w));
            const float r = 1.f / sqrtf(ss * (1.f / 256.f) + LN_EPS);
            const f32x4 o = d * r * gs;
            op[h * 64] = (unsigned long long)pk2(o.x, o.y) | ((unsigned long long)pk2(o.z, o.w) << 32);
        }
    }
}
typedef attA::bf16 abf;
typedef attA::BlockRef<abf, abf> ARef;
__device__ __forceinline__ ARef attA_ref(const bf16* QKV, bf16* AO, int L, int pass) {
    const int k = L >> 3, xcd = L & 7, gi = k >> 5, r = k & 31;
    const int grp = gi * 8 + xcd, b = grp >> 3, hp = grp & 7;
    const int hq = 2 * hp + (r & 1), vh = (r >> 1) & 1, x = r >> 2;
    const int qb = pass ? 15 - x : x;
    const abf* base = (const abf*)QKV + (size_t)b * SEQ * NQKV_A;
    ARef R; R.Q = base + (size_t)qb * 256 * NQKV_A + hq * 128; R.K = base + DM + hq * 128; R.V = base + 2 * DM + hp * 256 + vh * 128;
    R.O = (abf*)AO + ((size_t)b * SEQ + (size_t)qb * 256) * (2 * DM) + hq * 256 + vh * 128; R.P0 = qb * 256;
    return R;
}
__device__ __forceinline__ void attnA_phase(char* lds, const bf16* QKV, bf16* AO) {
    const int total = 1024, stride = (int)gridDim.x;
    int L = blockIdx.x; if (L >= total) return;
    int pass = 0;
    ARef cur = attA_ref(QKV, AO, L, 0);
    attA::Seam<abf> S;
    attA::causal_swa_prime<abf, abf>(cur, SEQ, lds, S);
    for (;;) {
        const bool more_pass = pass == 0, more_item = L + stride < total, last = !more_pass && !more_item;
        int passn = pass + 1, Ln = L;
        if (!more_pass) { passn = 0; Ln = more_item ? L + stride : L; }
        const ARef nxt = last ? cur : attA_ref(QKV, AO, Ln, passn);
        attA::causal_swa_block<abf, abf>(cur, nxt, SEQ, SEQ, lds, S);
        if (last) break;
        cur = nxt; pass = passn; L = Ln;
    }
}
constexpr int CW_READY = 24576;
constexpr int CW_FOLD2 = CW_READY + 16 * 64 * DEPTH;
constexpr int CW_QDONE = CW_FOLD2 + 16;
constexpr int CW_TDONE = CW_QDONE + 16 * 64 * DEPTH;
__device__ __forceinline__ void wait_panels(unsigned* base, int npan, unsigned expected, unsigned* bar) {
    const int t = opaque_tid();
    if (t < 64) {
        unsigned sp = 0;
        for (;;) { const unsigned c = t < npan ? xb_ld(base + 16 * t) : expected;
            if (__builtin_amdgcn_ballot_w64(c < expected) == 0ull) break;
            __builtin_amdgcn_s_sleep(1);
            if ((++sp & 255u) == 0u) { if (xb_ld(&bar[XB_TMO])) break; if (sp > XB_SPIN_CAP) { if (t == 0) atomicAdd(&bar[XB_TMO], 1u); break; } } }
        if (t == 0) { __builtin_amdgcn_fence(__ATOMIC_ACQUIRE, "agent"); asm volatile("s_waitcnt vmcnt(0)" ::: "memory"); }
    }
    __syncthreads();
}
__device__ __forceinline__ void signal_ready2(unsigned* cnt, unsigned* cnt2) {
    asm volatile("s_waitcnt vmcnt(0)" ::: "memory");
    __syncthreads();
    if (threadIdx.x == 0) { (void)xb_add(cnt, 1u); if (cnt2) (void)xb_add(cnt2, 1u); }
}
__device__ __forceinline__ void signal_ready(unsigned* cnt) {
    asm volatile("s_waitcnt vmcnt(0)" ::: "memory");
    __syncthreads();
    if (threadIdx.x == 0) (void)xb_add(cnt, 1u);
}
__device__ __forceinline__ void signal_ready_fenced(unsigned* cnt) {
    asm volatile("s_waitcnt vmcnt(0)" ::: "memory");
    __syncthreads();
    if (threadIdx.x == 0) { __builtin_amdgcn_fence(__ATOMIC_RELEASE, "agent"); asm volatile("s_waitcnt vmcnt(0)" ::: "memory"); (void)xb_add(cnt, 1u); }
}
__device__ __forceinline__ void wait_ready(unsigned* cnt, unsigned expected, unsigned* bar) {
    if (threadIdx.x == 0) { XB_SPIN(xb_ld(cnt) < expected, bar); __builtin_amdgcn_fence(__ATOMIC_ACQUIRE, "agent"); asm volatile("s_waitcnt vmcnt(0)" ::: "memory"); }
    __syncthreads();
}
__device__ __forceinline__ void attnA2_phase(char* lds, const bf16* QKV, bf16* AO, CArgs* ap, bool defer, unsigned* ready, unsigned* qdone, unsigned* tdone, unsigned* bar) {
    const int total = 512, stride = (int)gridDim.x;
    int cq = 0;
    for (int L = blockIdx.x; L < total; L += stride) {
        const int k = L >> 3, xcd = L & 7, r = k & 15, grp = (k >> 4) * 8 + xcd, b = grp >> 3, hp = grp & 7, hq = 2 * hp + (r & 1), x = r >> 1;
        const abf* base = (const abf*)QKV + (size_t)b * SEQ * NQKV_A;
#pragma unroll 1
        for (int pass = 0; pass < 2; ++pass) { const int qb = pass ? 15 - x : x;
            attA::Blk2 B; B.Q = base + (size_t)qb * 256 * NQKV_A + hq * 128; B.K = base + DM + hq * 128; B.V = base + 2 * DM + hp * 256;
            B.O = (abf*)AO + ((size_t)b * SEQ + (size_t)qb * 256) * (2 * DM) + hq * 256; B.P0 = qb * 256; B.stamp = (unsigned long long*)(ap->ws + 512 * 1024 + 128);
            if (qdone) wait_panels(qdone + 16 * 16 * b, qb + 1, 4u, bar);
            attA::causal_fullv_block(B, lds);
            if (ready) signal_ready2(ready + 16 * (b * 16 + qb), tdone ? tdone + 16 * b : (unsigned*)nullptr);
            if (defer && (CONV_CHUNKS == 4 || pass == 0) && cq < CONV_CHUNKS) { convert_chunk(ap, lds, cq); ++cq; }
        }
    }
    if (defer) for (; cq < CONV_CHUNKS; ++cq) convert_chunk(ap, lds, cq);
}
__device__ __forceinline__ void attnB_phase(Frame& F, const bf16* QKV, const float* sinks, bf16* AC, unsigned* ready, unsigned* qdone, unsigned* tdone, unsigned* bar) {
    for (int u = F.vcu; u < NB * 4 * 32; u += F.G) { const int n = u & 31, kvh = (u >> 5) & 3, b = u >> 7;
        if (qdone) { const int p1 = n >> 1, p0 = n > 0 ? (n - 1) >> 1 : p1; wait_panels(qdone + 16 * (16 * b + p0), p1 - p0 + 1, 4u, bar); }
        attB::swa_unit(b, kvh, n, QKV, sinks, AC, F.lds);
        if (ready) signal_ready2(ready + 16 * (b * 16 + (n >> 1)), tdone ? tdone + 16 * b : (unsigned*)nullptr); }
    __syncthreads();
}

#ifndef SITES
#define SITES 0xffff
#endif
#ifndef PG8_PROBE
#define PG8_PROBE 0
#endif
#ifndef PROBE_LAYER
#define PROBE_LAYER 1
#endif
#ifndef PROBE_SITE
#define PROBE_SITE 0
#endif
#define PROBE_KT (PROBE_SITE == 1 ? 128 : 32)
#ifndef PROBE_DUP
#define PROBE_DUP 0
#endif
#ifndef PROBE_NREP
#define PROBE_NREP 2
#endif
#define NREP(bit) ((PROBE_DUP & (bit)) ? PROBE_NREP : 1)
#define DUMMY_F32 ((float*)WSP(WS_AO))
__device__ __forceinline__ CArgs* kargs() { CArgs* p = (CArgs*)__builtin_amdgcn_kernarg_segment_ptr(); asm volatile("" : "+s"(p)); return p; }
#define AIN(i) (kargs()->in[i])
#define WSP(off) (kargs()->ws + (off))
__host__ __device__ __forceinline__ int panel_of(int c) { return 8 * (c & 7) + ((c >> 3) & 7); }
__device__ __forceinline__ int stage_panel(const float* st, LAS float* mrt) {
    const int pm = panel_of((int)blockIdx.x);
    pg8::stage_mu_r((LAS pg8::f32x2v*)mrt, st, pm, opaque_tid()); return pm;
}
#ifndef STAGGER_TICKS
#define STAGGER_TICKS 0
#endif
__device__ __forceinline__ void phase_stagger() {
    const unsigned long long want = (unsigned long long)(blockIdx.x >> 5) * STAGGER_TICKS, t0 = __builtin_amdgcn_s_memrealtime();
    while (__builtin_amdgcn_s_memrealtime() - t0 < want) __builtin_amdgcn_s_sleep(4);
}
__device__ __forceinline__ void xcc_local_barrier(unsigned* ctl, unsigned x, unsigned* bar) {
    asm volatile("s_waitcnt vmcnt(0)" ::: "memory");
    __syncthreads();
    if (threadIdx.x == 0) {
        __builtin_amdgcn_s_waitcnt(0);
        const unsigned old = xb_add(&ctl[CW_LSUB + 64 * x], 1u), gen = old >> 5;
        if ((old & 31u) == 31u) xb_add(&ctl[CW_LGEN + 64 * x], 1u);
        else XB_SPIN(xb_ld(&ctl[CW_LGEN + 64 * x]) == gen, bar);
        __builtin_amdgcn_fence(__ATOMIC_ACQUIRE, "agent");
        asm volatile("s_waitcnt vmcnt(0)" ::: "memory");
    }
    __syncthreads();
}
__device__ __forceinline__ void panel_barrier(unsigned* ctl, unsigned pm, unsigned* bar) {
    asm volatile("s_waitcnt vmcnt(0)" ::: "memory");
    __syncthreads();
    if (threadIdx.x == 0) {
        __builtin_amdgcn_s_waitcnt(0);
        const unsigned old = xb_add(&ctl[CW_PSUB + 64 * pm], 1u), gen = old >> 2;
        if ((old & 3u) == 3u) xb_add(&ctl[CW_PGEN + 64 * pm], 1u);
        else XB_SPIN(xb_ld(&ctl[CW_PGEN + 64 * pm]) == gen, bar);
        __builtin_amdgcn_fence(__ATOMIC_ACQUIRE, "agent");
        asm volatile("s_waitcnt vmcnt(0)" ::: "memory");
    }
    __syncthreads();
}
#ifndef CHAIN_STAGGER_TICKS
#define CHAIN_STAGGER_TICKS 0
#endif
__device__ __forceinline__ void chain_stagger() {
    const unsigned long long want = (unsigned long long)((blockIdx.x >> 3) & 7) * CHAIN_STAGGER_TICKS, t0 = __builtin_amdgcn_s_memrealtime();
    while (__builtin_amdgcn_s_memrealtime() - t0 < want) __builtin_amdgcn_s_sleep(2);
}
__global__ void __launch_bounds__(NWAVES * 64, 2) fwd_kernel(Args args_unused) {
    extern __shared__ __attribute__((aligned(16))) unsigned char lds[];
    Frame F;
    F.lds = (LAS unsigned char*)lds;
    F.MISC = (volatile LAS unsigned*)(F.lds + MISC_OFF);
    F.G = gridDim.x; { const int bx = blockIdx.x; F.vcu = (F.G % 8 == 0) ? (bx % 8) * (F.G / 8) + bx / 8 : bx; }
    F.ctl = (gu32*)WSP(WS_CTL);
    for (int u = threadIdx.x; u < (LDS_BYTES - LDSCTL_OFF) / 4; u += NWAVES * 64) ((LAS unsigned*)(F.lds + LDSCTL_OFF))[u] = 0u;
    __syncthreads();
    const int lo = kargs()->ph_lo, hi = kargs()->ph_hi;
    XcdBarrier bar; bar.bar = (unsigned*)(F.ctl + CW_BAR); bar.x = 0; bar.st = nullptr;
    if (hi - lo > 1) bar = xcd_barrier_post((unsigned*)(F.ctl + CW_BAR), F.MISC + 8);
    if (hi - lo > 1 && threadIdx.x == 0) (void)__hip_atomic_fetch_or((unsigned*)F.ctl + CW_XMASK + 64 * bar.x, 1u << (blockIdx.x & 7), __ATOMIC_RELAXED, __HIP_MEMORY_SCOPE_AGENT);
    bool local_ok = false;
#define IN(k) (lo <= (k) && (k) < hi)
#if PG8_PROBE == 5
    unsigned long long pr_bar = 0;
#ifndef PROBE_BARSET
#define PROBE_BARSET 0xff
#endif
#define SEAM(k) do { if ((k) + 1 < hi) { const unsigned long long t0_ = __builtin_amdgcn_s_memrealtime(); xcd_barrier(bar); const int k_ = (k); const int cls_ = k_ < 2 ? k_ : (((k_ - 2) & 7) == 0 ? 2 : ((k_ - 2) & 7) == 1 ? 3 : ((k_ - 2) & 7) == 2 ? 4 : ((k_ - 2) & 7) == 3 ? 5 : ((k_ - 2) & 7) == 5 ? 6 : 7); const unsigned long long dt_ = __builtin_amdgcn_s_memrealtime() - t0_; if ((PROBE_BARSET >> cls_) & 1) pr_bar += dt_; if (threadIdx.x == 0) atomicMax((unsigned*)WSP(520 * 1024) + k_, ~(unsigned)dt_); } } while (0)
#else
#define SEAM(k) do { if ((k) + 1 < hi) xcd_barrier(bar); } while (0)
#endif

#define MOD_ ((float*)WSP(WS_MOD))
#define X_ ((float*)WSP(WS_X))
#define HB_ ((bf16*)WSP(WS_HB))
#define QKV_ ((bf16*)WSP(WS_QKV))
#define QKVB_ ((bf16*)WSP(WS_QKVB))
#define READY_(L) ((unsigned*)F.ctl + CW_READY + 16 * 64 * (L))
#define QDONE_(L) ((unsigned*)F.ctl + CW_QDONE + 16 * 64 * (L))
#define TDONE_(L) ((unsigned*)F.ctl + CW_TDONE + 16 * NB * (L))
#define AO_ ((bf16*)WSP(WS_AO))
#define AC_ ((bf16*)WSP(WS_AC))
#define HID_ ((bf16*)WSP(WS_HID))
#define STATS_(s) ((float*)WSP(WS_STATS) + (size_t)(s) * MTOK * 16)
#define MRT_ ((LAS float*)(F.lds + STATTBL_OFF))
#define CS_(s) ((const float*)WSP(WS_CS) + (size_t)(s) * NB * CSTRIDE)
#define CB_(s) ((const float*)WSP(WS_CB) + (size_t)(s) * NB * CSTRIDE)
#define GN_(s) ((const float*)WSP(WS_GN) + (size_t)(s) * NB * DM)
#define ZEROS_ ((const float*)WSP(WS_ZEROS))
#define ONES_ ((const float*)WSP(WS_ONES))
#define IG_(s) ((const float*)WSP(WS_IG) + (size_t)(s) * NB * DM)
#define NEUTRAL_ ((const float*)WSP(WS_NEUTRAL))
#define XB_ ((bf16*)WSP(WS_X))
    constexpr size_t MODL = (size_t)NB * NMOD * DM;
    constexpr int MODB = NMOD * DM;

#if SITES & 1
    if (IN(0)) { for (int rep = 0; rep < NREP(1); ++rep) { p0_prologue(F, kargs()); if (NREP(1) > 1) __syncthreads(); } SEAM(0); }
    if (lo == 0 && hi > 1 && F.G == 256) {
        if (threadIdx.x == 0) { unsigned seen = 0u, good = 1u;
            for (unsigned j = 0; j < 16; ++j) { const unsigned c = xb_ld(&bar.bar[XB_XCNT(j)]), m = xb_ld((unsigned*)F.ctl + CW_XMASK + 64 * j);
                if (c == 0u && m == 0u) continue; if (c != 32u || (m & (m - 1u)) != 0u || (seen & m) != 0u) good = 0u; seen |= m; }
            F.MISC[12] = (good && seen == 0xffu) ? 1u : 0u; }
        __syncthreads(); local_ok = F.MISC[12] != 0u; __syncthreads();
    }
#ifdef NO_LOCAL_BARRIERS
    local_ok = false;
#endif
#define SEAM_L(k) do { if ((k) + 1 < hi) { if (local_ok) panel_barrier((unsigned*)F.ctl, (unsigned)panel_of((int)blockIdx.x), bar.bar); else xcd_barrier(bar); } } while (0)
#endif
#if SITES & 4096
    if (IN(1)) { for (int rep = 0; rep < NREP(4096); ++rep) { h0_phase(F, AIN(0), MOD_ + 1 * DM, MOD_ + 0 * DM, HB_, XB_); fold_phase(F, kargs(), 0, CONV_DEFER ? 2 : 7, true); } SEAM_L(1); }
#endif

    for (int L = 0; L < DEPTH; ++L) {
        const int pb = 2 + 8 * L, j = L >> 1;
#define MODL_ (MOD_ + (size_t)L * MODL)
        if ((L & 1) == 0) {
#if SITES & 8
            if (IN(pb + 0)) for (int rep = 0; rep < NREP(2); ++rep) {
                if (QKV_DATAFLOW && L >= 2 && rep == 0) wait_ready(TDONE_(L - 2) + 16 * (panel_of((int)blockIdx.x) >> 4), 256u, bar.bar);
                pg8::Gemm g{HB_, (const bf16*)WSP(WS_WQKVA + j * WS_WA_STRIDE), MTOK, NQKV_A, DM};
#if PG8_PROBE
                if (L == PROBE_LAYER && PROBE_SITE == 2) g.probe = (unsigned long long*)WSP(WS_PROBE);
#endif
                pg8::StaticOrder S; S.init(MTOK, NQKV_A, F.G, (int)blockIdx.x);
                pg8::EpiQKV<128> E{QKV_, NQKV_A, ZEROS_, (const float*)WSP(WS_TABA), (const float*)WSP(WS_IDENT), 16, SEQ - 1, L == 0 ? (const float*)WSP(WS_NEUTRAL) : (const float*)STATS_(2 * L - 1), L == 0 ? ZEROS_ : CS_(2 * L - 1), L == 0 ? ZEROS_ : CB_(2 * L - 1), L == 0 ? 0 : CSTRIDE, 12, MRT_, stage_panel(L == 0 ? (const float*)WSP(WS_NEUTRAL) : (const float*)STATS_(2 * L - 1), MRT_)};
                if (STAGGER_TICKS) phase_stagger();
            pg8::gemm_phase<pg8::EpiQKV<128>, pg8::StaticOrder, true, true>(F.lds + RING_OFF, g, S, E);
                if (rep == NREP(2) - 1) { if (QKV_DATAFLOW) signal_ready(QDONE_(L) + 16 * panel_of((int)blockIdx.x)); else SEAM(pb + 0); }
            }
#endif
#if SITES & 2
            if (IN(pb + 1)) { for (int rep = 0; rep < NREP(4); ++rep) {
#if ATTA_FULLV
#if PG8_PROBE == 7 || PG8_PROBE == 8
                const unsigned long long pa_r0 = __builtin_amdgcn_s_memrealtime(), pa_c0 = __builtin_amdgcn_s_memtime();
#endif
                attnA2_phase((char*)lds + RING_OFF, QKV_, AO_, kargs(), CONV_DEFER && L == 0 && rep == 0, (DATAFLOW && rep == NREP(4) - 1) ? READY_(L) : (unsigned*)nullptr, QKV_DATAFLOW ? QDONE_(L) : (unsigned*)nullptr, QKV_DATAFLOW ? TDONE_(L) : (unsigned*)nullptr, bar.bar);
#if PG8_PROBE == 7 || PG8_PROBE == 8
                if (L == 2 && blockIdx.x == 0 && threadIdx.x == 0) { unsigned long long* pr = (unsigned long long*)WSP(WS_PROBE); pr[3] = __builtin_amdgcn_s_memrealtime() - pa_r0; pr[4] = __builtin_amdgcn_s_memtime() - pa_c0; }
#endif
#else
                attnA_phase((char*)lds + RING_OFF, QKV_, AO_);
#endif
            } if (!DATAFLOW || (L0_ATT_GLOBAL && L == 0)) SEAM(pb + 1); }
#endif
#if SITES & 512
            if (IN(pb + 2)) {
                if (CONV_DEFER && FOLD2_AT_C0 && L == 0) { fold_phase(F, kargs(), 2, 7, false); signal_ready_fenced((unsigned*)F.ctl + CW_FOLD2); }
                if (DATAFLOW) wait_ready(READY_(L) + 16 * panel_of((int)blockIdx.x), 16u, bar.bar);
                if (DATAFLOW && XCC_ALIGN && local_ok) xcc_local_barrier((unsigned*)F.ctl, (unsigned)blockIdx.x & 7u, bar.bar);
                if (local_ok && CHAIN_STAGGER_TICKS) chain_stagger();
                const float lam_init = (L == 0) ? 0.2f : 0.47071301658633585f;
                for (int rep = 0; rep < NREP(8); ++rep) combine_phase(F, AO_, AC_, AIN(12) + j * 128, AIN(13) + j * 128, AIN(14) + j * 128, AIN(15) + j * 128, AIN(16) + j * 256, lam_init);
                SEAM_L(pb + 2);
            }
#endif
#if SITES & 16
            if (IN(pb + 3)) for (int rep = 0; rep < NREP(16); ++rep) {
                pg8::Gemm g{AC_, (const bf16*)WSP(WS_WOA + j * WS_WA_STRIDE), MTOK, DM, DM};
#if PG8_PROBE
                if (L == PROBE_LAYER && PROBE_SITE == 3) g.probe = (unsigned long long*)WSP(WS_PROBE);
#endif
                pg8::StaticOrder S; S.init(MTOK, DM, F.G, (int)blockIdx.x);
                pg8::EpiResid E{L == 0 ? (const bf16*)XB_ : (const bf16*)HB_, L == 0 ? ONES_ : IG_(2 * L - 1), L == 0 ? 0 : DM, L == 0 ? NEUTRAL_ : (const float*)STATS_(2 * L - 1), L == 0 ? ONES_ : AIN(6) + (L - 1) * DM, L == 0 ? ZEROS_ : AIN(7) + (L - 1) * DM,
                                 (float*)nullptr, STATS_(2 * L), HB_, GN_(2 * L), DM, DM, MODL_ + 2 * DM, MODB, ZEROS_, ALPHA, 12, MRT_, stage_panel(L == 0 ? NEUTRAL_ : (const float*)STATS_(2 * L - 1), MRT_)};
                if (STAGGER_TICKS) phase_stagger();
            pg8::gemm_phase<pg8::EpiResid, pg8::StaticOrder, true, true>(F.lds + RING_OFF, g, S, E);
                if (rep == NREP(16) - 1) SEAM_L(pb + 3);
            }
#endif
        } else {
#if SITES & 32
            if (IN(pb + 0)) for (int rep = 0; rep < NREP(32); ++rep) {
                if (QKV_DATAFLOW && L >= 2 && rep == 0) wait_ready(TDONE_(L - 2) + 16 * (panel_of((int)blockIdx.x) >> 4), 128u, bar.bar);
                pg8::Gemm g{HB_, (const bf16*)WSP(WS_WQKVB + j * WS_WB_STRIDE), MTOK, NQKV_B, DM}; pg8::StaticOrder S; S.init(MTOK, NQKV_B, F.G, (int)blockIdx.x);
                pg8::EpiQKV<64> E{QKVB_, NQKV_B, (const float*)WSP(WS_BPERM) + j * NQKV_B, (const float*)WSP(WS_TABB), (const float*)WSP(WS_IDENT), 9, SEQ - 1, (const float*)STATS_(2 * L - 1), CS_(2 * L - 1), CB_(2 * L - 1), CSTRIDE, 12, MRT_, stage_panel((const float*)STATS_(2 * L - 1), MRT_)};
                if (STAGGER_TICKS) phase_stagger();
            pg8::gemm_phase<pg8::EpiQKV<64>, pg8::StaticOrder, true, true>(F.lds + RING_OFF, g, S, E);
                if (rep == NREP(32) - 1) { if (QKV_DATAFLOW) signal_ready(QDONE_(L) + 16 * panel_of((int)blockIdx.x)); else SEAM(pb + 0); }
            }
#endif
#if SITES & 4
            if (IN(pb + 1) && CONV_DEFER && L == 1 && !FOLD2_AT_C0) {
                fold_phase(F, kargs(), 2, 7, false); signal_ready_fenced((unsigned*)F.ctl + CW_FOLD2); }
            if (IN(pb + 1)) { for (int rep = 0; rep < NREP(64); ++rep) attnB_phase(F, QKVB_, AIN(19) + j * 32, AC_, (DATAFLOW && rep == NREP(64) - 1) ? READY_(L) : (unsigned*)nullptr, QKV_DATAFLOW ? QDONE_(L) : (unsigned*)nullptr, QKV_DATAFLOW ? TDONE_(L) : (unsigned*)nullptr, bar.bar); if (!DATAFLOW) SEAM(pb + 1); }
#endif
#if SITES & 64
            if (IN(pb + 3)) for (int rep = 0; rep < NREP(128); ++rep) {
                if (DATAFLOW && rep == 0) wait_ready(READY_(L) + 16 * panel_of((int)blockIdx.x), 8u, bar.bar);
                if (DATAFLOW && XCC_ALIGN && local_ok && rep == 0) xcc_local_barrier((unsigned*)F.ctl, (unsigned)blockIdx.x & 7u, bar.bar);
                if (local_ok && CHAIN_STAGGER_TICKS) chain_stagger();
                pg8::Gemm g{AC_, (const bf16*)WSP(WS_WOB + j * WS_WB_STRIDE), MTOK, DM, DM}; pg8::StaticOrder S; S.init(MTOK, DM, F.G, (int)blockIdx.x);
                pg8::EpiResid E{(const bf16*)HB_, IG_(2 * L - 1), DM, (const float*)STATS_(2 * L - 1), AIN(6) + (L - 1) * DM, AIN(7) + (L - 1) * DM,
                                 (float*)nullptr, STATS_(2 * L), HB_, GN_(2 * L), DM, DM, MODL_ + 2 * DM, MODB, AIN(21) + j * DM, ALPHA, 12, MRT_, stage_panel((const float*)STATS_(2 * L - 1), MRT_)};
                if (STAGGER_TICKS) phase_stagger();
            pg8::gemm_phase<pg8::EpiResid, pg8::StaticOrder, true, true>(F.lds + RING_OFF, g, S, E);
                if (rep == NREP(128) - 1) SEAM_L(pb + 3);
            }
#endif
        }
#if SITES & 128
        if (IN(pb + 5)) for (int rep = 0; rep < NREP(512); ++rep) {
            if (CONV_DEFER && L == 1 && rep == 0) wait_ready((unsigned*)F.ctl + CW_FOLD2, gridDim.x, bar.bar);
            pg8::Gemm g{HB_, (const bf16*)WSP(WS_WUP + L * WS_WMLP_STRIDE), MTOK, DFF, DM};
#if PG8_PROBE
            if (L == PROBE_LAYER && PROBE_SITE == 0) g.probe = (unsigned long long*)WSP(WS_PROBE);
#endif
            pg8::StaticOrder S; S.init(MTOK, DFF, F.G, (int)blockIdx.x);
            pg8::EpiRelu2 E{HID_, DFF, (const float*)STATS_(2 * L), CS_(2 * L), CB_(2 * L), CSTRIDE, 12, MRT_, stage_panel((const float*)STATS_(2 * L), MRT_), QKV_};
            if (STAGGER_TICKS) phase_stagger();
            pg8::gemm_phase<pg8::EpiRelu2, pg8::StaticOrder, true, true>(F.lds + RING_OFF, g, S, E);
            if (rep == NREP(512) - 1) SEAM_L(pb + 5);
        }
#endif
#if SITES & 256
        if (IN(pb + 6)) for (int rep = 0; rep < NREP(1024); ++rep) {
            pg8::Gemm g{HID_, (const bf16*)WSP(WS_WDN + L * WS_WMLP_STRIDE), MTOK, DM, DFF};
#if PG8_PROBE
            if (L == PROBE_LAYER && PROBE_SITE == 1) g.probe = (unsigned long long*)WSP(WS_PROBE);
#endif
            pg8::StaticOrder S; S.init(MTOK, DM, F.G, (int)blockIdx.x);
            pg8::EpiResid E{(const bf16*)HB_, IG_(2 * L), DM, (const float*)STATS_(2 * L), AIN(4) + L * DM, AIN(5) + L * DM,
                             L == DEPTH - 1 ? X_ : (float*)nullptr, STATS_(2 * L + 1), L == DEPTH - 1 ? (bf16*)nullptr : HB_, GN_(2 * L + 1), DM, DM, MODL_ + 5 * DM, MODB, ZEROS_, ALPHA, 12, MRT_, stage_panel((const float*)STATS_(2 * L), MRT_)};
            if (STAGGER_TICKS) phase_stagger();
            pg8::gemm_phase<pg8::EpiResid, pg8::StaticOrder, true, true>(F.lds + RING_OFF, g, S, E);
            if (rep == NREP(1024) - 1) { if (CONV_DEFER && (!DATAFLOW || L0_DOWN_GLOBAL) && L == 0) SEAM(pb + 6); else SEAM_L(pb + 6); }
        }
#endif
    }
    if (IN(2 + 8 * DEPTH)) final_ln_phase(F, X_, STATS_(2 * DEPTH - 1), kargs()->out, AIN(6) + (DEPTH - 1) * DM, AIN(7) + (DEPTH - 1) * DM);
#if PG8_PROBE == 5
    if (threadIdx.x == 0) atomicAdd((unsigned long long*)WSP(512 * 1024), pr_bar);
#endif
#if ATTA_STAMP
    if (blockIdx.x == 0 && threadIdx.x == 0) { const unsigned long long t0 = __builtin_amdgcn_s_memrealtime(), ticks = ((const unsigned long long*)WSP(512 * 1024 + 128))[ATTA_STAMP_SEL] / 8ull;
        while (__builtin_amdgcn_s_memrealtime() - t0 < ticks) __builtin_amdgcn_s_sleep(8); }
#endif
#if CONV_PROBE
    if (blockIdx.x == PROBE_WG && threadIdx.x == 0) { const unsigned long long t0 = __builtin_amdgcn_s_memrealtime(), ticks = 5ull * *(const unsigned long long*)WSP(512 * 1024 + 64);
        while (__builtin_amdgcn_s_memrealtime() - t0 < ticks) __builtin_amdgcn_s_sleep(8); }
#endif
#if PG8_PROBE
    if (IN(2 + 8 * DEPTH)) { xcd_barrier(bar);
        if (blockIdx.x == 0 && threadIdx.x == 0) { const unsigned long long* pr = (const unsigned long long*)WSP(WS_PROBE); float v = 0.f;
            if (PG8_PROBE == 1) v = ((float)pr[4] * 100.0f / (float)pr[3] - 1000.0f) * 0.1f;
            if (PG8_PROBE == 2) v = ((float)pr[0] / (float)(pr[2] * (unsigned long long)PROBE_KT) - 2000.0f) * 0.1f;
            if (PG8_PROBE == 3) v = (float)pr[1] / (float)pr[2] * 0.01f;
            if (PG8_PROBE == 5) v = (float)(*(const unsigned long long*)WSP(512 * 1024)) / (float)gridDim.x * 0.001f;
            if (PG8_PROBE == 5 && PROBE_BARSET == 0) { unsigned sum = 0; for (int i = 0; i < N_PHASES; ++i) { const unsigned w = ((const unsigned*)WSP(520 * 1024))[i]; if (w) sum += ~w; } v = (float)sum * 0.001f; }
            if (PG8_PROBE == 7) v = ((float)pr[4] * 100.0f / (float)pr[3] - 1000.0f) * 0.1f;
            if (PG8_PROBE == 8) v = (float)pr[3] * 0.001f;
            if (PG8_PROBE == 9 || PG8_PROBE == 10) v = ((float)pr[0] / (float)(pr[2] - 1) - 4000.0f) * 0.05f;
            if (PG8_PROBE == 11) v = (float)(*(const unsigned long long*)WSP(512 * 1024 + 64)) * 0.01f;
            if (PG8_PROBE == 4) v = (float)pr[3] * 0.001f;
            { const unsigned long long t0 = __builtin_amdgcn_s_memrealtime(); const unsigned long long ticks = (unsigned long long)(fmaxf(v, 0.f) * 500.0f);
              while (__builtin_amdgcn_s_memrealtime() - t0 < ticks) __builtin_amdgcn_s_sleep(8); } } }
#endif
#undef IN
#undef SEAM
}

extern "C" void kernel_launch(void* const* d_in, const int* in_sizes, int n_in, void* d_out, int out_size, void* d_ws, size_t ws_size, hipStream_t stream) {
    static int grid = 0;
    if (grid == 0) {
        if (n_in != 22 || in_sizes[0] != MTOK * DM || out_size != MTOK * DM || ws_size < WS_END) {
            fprintf(stderr, "kernel_launch: unexpected shapes (n_in %d, in0 %d, out %d, ws %zu; need ws >= %zu); nothing launched\n", n_in, n_in > 0 ? in_sizes[0] : -1, out_size, ws_size, (size_t)WS_END); grid = -1; return; }
        int dev = 0, cus = 0, per_cu = 0;
        if (hipGetDevice(&dev) != hipSuccess || hipDeviceGetAttribute(&cus, hipDeviceAttributeMultiprocessorCount, dev) != hipSuccess) { fprintf(stderr, "kernel_launch: device query failed\n"); grid = -1; return; }
        if (hipFuncSetAttribute((const void*)fwd_kernel, hipFuncAttributeMaxDynamicSharedMemorySize, LDS_BYTES) != hipSuccess) { fprintf(stderr, "kernel_launch: hipFuncSetAttribute failed\n"); grid = -1; return; }
        if (hipOccupancyMaxActiveBlocksPerMultiprocessor(&per_cu, (const void*)fwd_kernel, NWAVES * 64, LDS_BYTES) != hipSuccess || per_cu < 1)
            fprintf(stderr, "kernel_launch: note: occupancy query reports %d workgroups per CU\n", per_cu);
        (void)hipGetLastError();
        grid = cus;
        { const int Ns[5] = {NQKV_A, NQKV_B, DM, DFF, DM}; bool ok = true;
          if (grid != 256) ok = false;
          for (int gi = 0; gi < 5 && ok; ++gi) for (int c = 0; c < grid && ok; ++c) { pg8::StaticOrder S; S.init(MTOK, Ns[gi], grid, c); pg8::Unit u;
              for (int i = 0; S.next(i, u); ++i) if (u.pm != panel_of(c)) { ok = false; break; } }
          if (!ok) { fprintf(stderr, "kernel_launch: unit order does not keep a workgroup on one row panel for a grid of %d; nothing launched\n", grid); grid = -1; return; } }
    }
    if (grid < 0) return;
    if (hipMemsetAsync((char*)d_ws + WS_CTL, 0, CTL_ZERO_BYTES, stream) != hipSuccess) { fprintf(stderr, "kernel_launch: memset failed\n"); return; }
    Args a{};
    for (int i = 0; i < 22; ++i) a.in[i] = (const float*)d_in[i];
    a.out = (float*)d_out; a.ws = (unsigned char*)d_ws;
#if MK_PER_PHASE
    for (int p = 0; p < N_PHASES; ++p) {
        if (p >= 2 && p < 2 + 8 * DEPTH) { const int sl = (p - 2) & 7, Lp = (p - 2) >> 3; if (sl == 4 || sl == 7 || (sl == 2 && (Lp & 1))) continue; }
        a.ph_lo = p; a.ph_hi = p + 1;
        hipLaunchKernelGGL(fwd_kernel, dim3(grid), dim3(NWAVES * 64), LDS_BYTES, stream, a);
    }
#else
    a.ph_lo = 0; a.ph_hi = N_PHASES;
    hipLaunchKernelGGL(fwd_kernel, dim3(grid), dim3(NWAVES * 64), LDS_BYTES, stream, a);
#endif
    const hipError_t le = hipPeekAtLastError();
    if (le != hipSuccess) fprintf(stderr, "kernel_launch: launch failed: %s\n", hipGetErrorName(le));
}
```

```cpp
#include <hip/hip_runtime.h>
#include <hip/hip_bf16.h>
#include <cstdio>
#include <cstdint>

constexpr int DM = 2048, NB = 4, SEQ = 4096, DEPTH = 4, MTOK = NB * SEQ, DFF = 8192;
constexpr int NQKV_A = 3 * DM;
constexpr int NQKV_B = 2560;
constexpr float LN_EPS = 1e-5f;
constexpr float ALPHA = 1.681792830507429f;
constexpr int NMOD = 6;
__device__ __forceinline__ int opaque_tid() { int t = (int)threadIdx.x; asm volatile("" : "+v"(t)); return t; }
#ifndef PG8_RELAX
#define PG8_RELAX 0
#endif
#ifndef CONV_PROBE
#define CONV_PROBE 0
#endif
#ifndef PROBE_WG
#define PROBE_WG 0
#endif
#ifndef DATAFLOW
#define DATAFLOW 1
#endif
#ifndef FOLD2_AT_C0
#define FOLD2_AT_C0 1
#endif
#ifndef L0_DOWN_GLOBAL
#define L0_DOWN_GLOBAL 0
#endif
#ifndef XCC_ALIGN
#define XCC_ALIGN 0
#endif
#ifndef ATT_DYN
#define ATT_DYN 1
#endif
#ifndef QKV_DATAFLOW
#define QKV_DATAFLOW 1
#endif
#ifndef HID_PERM
#define HID_PERM 0
#endif
#ifndef L0_ATT_GLOBAL
#define L0_ATT_GLOBAL 1
#endif
#ifndef CONV_DEFER
#define CONV_DEFER 1
#endif
#ifndef ATTA_FULLV
#define ATTA_FULLV 1
#endif
template <int K> __device__ __forceinline__ float lane_xor(float v) {
    if constexpr (K == 32) { const auto rr = __builtin_amdgcn_permlane32_swap(__float_as_uint(v), __float_as_uint(v), false, false);
        return __uint_as_float(((opaque_tid() & 32) ? rr[0] : rr[1])); }
    else return __uint_as_float((unsigned)__builtin_amdgcn_ds_swizzle((int)__float_as_uint(v), (K << 10) | 0x1F));
}
__device__ __forceinline__ float half_sum32(float v) { const auto rr = __builtin_amdgcn_permlane32_swap(__float_as_uint(v), __float_as_uint(v), false, false); return __uint_as_float(rr[0]) + __uint_as_float(rr[1]); }
__device__ __forceinline__ float half_max32(float v) { const auto rr = __builtin_amdgcn_permlane32_swap(__float_as_uint(v), __float_as_uint(v), false, false); return fmaxf(__uint_as_float(rr[0]), __uint_as_float(rr[1])); }
typedef unsigned wt_u32x4 __attribute__((ext_vector_type(4)));
__device__ __forceinline__ void store16_wt(void* p, wt_u32x4 v) { asm volatile("global_store_dwordx4 %0, %1, off sc1\n\ts_nop 1" :: "v"(p), "v"(v) : "memory"); }
__device__ __forceinline__ void store4_wt(void* p, unsigned v) { asm volatile("global_store_dword %0, %1, off sc1\n\ts_nop 1" :: "v"(p), "v"(v) : "memory"); }

#define GAS __attribute__((address_space(1)))
#define LAS __attribute__((address_space(3)))
typedef unsigned short bf16;
typedef unsigned v4u __attribute__((ext_vector_type(4)));
typedef float f32x4 __attribute__((ext_vector_type(4)));
typedef short bf16x8 __attribute__((ext_vector_type(8)));
typedef GAS unsigned gu32;
typedef GAS unsigned long long gu64;
#define RLX_AGENT __ATOMIC_RELAXED, __HIP_MEMORY_SCOPE_AGENT
#define LDS_WAIT() asm volatile("s_waitcnt lgkmcnt(0)" ::: "memory")
#define VM_WAIT() asm volatile("s_waitcnt vmcnt(0)" ::: "memory")
__device__ __forceinline__ unsigned long long rt() { return __builtin_amdgcn_s_memrealtime(); }
__device__ __forceinline__ unsigned f2bf(float f) { unsigned u = __builtin_bit_cast(unsigned, f); return (u + 0x7fffu + ((u >> 16) & 1u)) >> 16; }
__device__ __forceinline__ unsigned pk2(float lo, float hi) { return f2bf(lo) | (f2bf(hi) << 16); }

#define XB_TMO      128
#define XB_XCNT(j)  (256  + 64 * (j))
#define XB_XSUB(j)  (1280 + 64 * (j))
#define XB_XGEN(j)  (2304 + 64 * (j))
#define XB_TOP      3328
#define XB_TOPGEN   3392
#define XCD_BAR_WORDS 3456
#define XB_SPIN_CAP (1u << 18)

__device__ __forceinline__ unsigned xb_ld(unsigned* p)              { return __hip_atomic_load(p, __ATOMIC_RELAXED, __HIP_MEMORY_SCOPE_AGENT); }
__device__ __forceinline__ unsigned xb_add(unsigned* p, unsigned v) { return __hip_atomic_fetch_add(p, v, __ATOMIC_RELAXED, __HIP_MEMORY_SCOPE_AGENT); }
__device__ __forceinline__ unsigned xb_xcc_id() { return (unsigned)__builtin_amdgcn_s_getreg((3 << 11) | 20) & 0xFu; }
#define XB_SPIN(cond, bar) do { unsigned _sp = 0; while (cond) { __builtin_amdgcn_s_sleep(1); \
    if ((++_sp & 255u) == 0u) { if (xb_ld(&(bar)[XB_TMO])) break; if (_sp > XB_SPIN_CAP) { atomicAdd(&(bar)[XB_TMO], 1u); break; } } } } while (0)

struct XcdBarrier {
    unsigned* bar; unsigned x;
    volatile LAS unsigned* st;
};

__device__ __forceinline__ XcdBarrier xcd_barrier_post(unsigned* bar, volatile LAS unsigned* st) {
    XcdBarrier b; b.bar = bar; b.x = xb_xcc_id(); b.st = st;
    if (threadIdx.x == 0) (void)xb_add(&bar[XB_XCNT(b.x)], 1u);
    return b;
}
__device__ __forceinline__ void xcd_barrier_complete(unsigned* bar, unsigned x, unsigned& nloc, unsigned& nx) {
    const unsigned G = gridDim.x * gridDim.y * gridDim.z;
    unsigned sum, cnt, mine, sp = 0u;
    for (;;) {
        sum = 0u; cnt = 0u; mine = 0u;
#pragma unroll
        for (unsigned j = 0; j < 16; ++j) { const unsigned c = xb_ld(&bar[XB_XCNT(j)]); sum += c; cnt += (c > 0u) ? 1u : 0u; mine = (j == x) ? c : mine; }
        if (sum == G) break;
        __builtin_amdgcn_s_sleep(1);
        if ((++sp & 255u) == 0u) { if (xb_ld(&bar[XB_TMO])) break; if (sp > XB_SPIN_CAP) { atomicAdd(&bar[XB_TMO], 1u); break; } }
    }
    nloc = mine > 0u ? mine : 1u; nx = cnt > 0u ? cnt : 1u;
}

__device__ __forceinline__ void xcd_barrier(const XcdBarrier& b) {
    asm volatile("s_waitcnt vmcnt(0)" ::: "memory");
    __syncthreads();
    if (threadIdx.x == 0) {
        unsigned* bar = b.bar;
        __builtin_amdgcn_s_waitcnt(0);
        unsigned nloc = b.st[0], nx = b.st[1];
        unsigned bx = b.x; asm volatile("" : "+s"(bx));
        if (nloc == 0u) { xcd_barrier_complete(bar, bx, nloc, nx); b.st[0] = nloc; b.st[1] = nx; }
        const unsigned old = xb_add(&bar[XB_XSUB(bx)], 1u);
        const unsigned gen = old / nloc;
        if (old + 1u == (gen + 1u) * nloc) {
            __builtin_amdgcn_fence(__ATOMIC_RELEASE, "agent");
            asm volatile("s_waitcnt vmcnt(0)" ::: "memory");
            const unsigned og = xb_add(&bar[XB_TOP], 1u);
            const unsigned tg = og / nx;
            if (og + 1u == (tg + 1u) * nx) xb_add(&bar[XB_TOPGEN], 1u);
            else XB_SPIN(xb_ld(&bar[XB_TOPGEN]) == tg, bar);
            __builtin_amdgcn_fence(__ATOMIC_ACQUIRE, "agent");
            xb_add(&bar[XB_XGEN(bx)], 1u);
            asm volatile("s_waitcnt vmcnt(0)" ::: "memory");
        } else {
            XB_SPIN(xb_ld(&bar[XB_XGEN(bx)]) == gen, bar);
            __builtin_amdgcn_fence(__ATOMIC_ACQUIRE, "agent");
            asm volatile("s_waitcnt vmcnt(0)" ::: "memory");
        }
    }
    __syncthreads();
}

namespace pg8 {
#define PG8_LAS __attribute__((address_space(3)))
typedef unsigned short bf16_t;
typedef short bf16x8 __attribute__((ext_vector_type(8)));
typedef float f32x4 __attribute__((ext_vector_type(4)));
typedef unsigned u32x4 __attribute__((ext_vector_type(4)));
constexpr int BM = 256, BK = 64, HALF = 128, HTB = HALF * BK * 2  , STAGE_BYTES = 8 * HTB, NXCD = 8, WGM = 8;

__host__ __device__ __forceinline__ int lds_byte(int r, int c) { const int st = (r >> 4) * 2 + (c >> 5), rr = r & 15, cc = c & 31, ob = rr * 64 + cc * 2; return st * 1024 + (ob ^ (((ob >> 9) & 1) << 5)); }
__host__ __device__ __forceinline__ void stage_rc(int b, int& R, int& C) { const int st = b / 1024, sb = b % 1024, swz = sb ^ (((sb >> 9) & 1) << 5); R = (st >> 1) * 16 + swz / 64; C = (st & 1) * 32 + (swz % 64) / 2; }
__host__ __device__ __forceinline__ int perm32(int rho) { const int n = rho >> 4, i = rho & 15; return 8 * (i >> 2) + 4 * n + (i & 3); }

struct Unit { int pm, pn; };
struct Gemm { const bf16_t* A; const bf16_t* Bt; int M, N, K; unsigned long long* probe = nullptr; };

struct StaticOrder {
    int nM, nN, nwg, G, c;
    __host__ __device__ void init(int M, int N, int G_, int c_) { nM = M / BM; nN = N / BM; nwg = nM * nN; G = G_; c = c_; }
    __host__ __device__ bool next(int i, Unit& u) const {
        const long L = (long)i * G + c; if (L >= nwg) return false;
        int wgid = (int)L; { const int q = nwg / NXCD, r = nwg % NXCD, xcd = wgid % NXCD, off = wgid / NXCD; wgid = (xcd < r ? xcd * (q + 1) : r * (q + 1) + (xcd - r) * q) + off; }
        const int nig = WGM * nN, gid = wgid / nig, fm = gid * WGM, gsz = (nM - fm) < WGM ? (nM - fm) : WGM;
        u.pm = fm + ((wgid % nig) % gsz); u.pn = (wgid % nig) / gsz; return true;
    }
    __device__ __forceinline__ void a_ready(const Unit&) const {}
    __device__ __forceinline__ void done(const Unit&) const {}
};

__device__ __forceinline__ unsigned cvt_pk_bf16(float lo, float hi) { unsigned r; asm volatile("v_cvt_pk_bf16_f32 %0, %1, %2" : "=v"(r) : "v"(lo), "v"(hi)); return r; }
typedef float f32x2 __attribute__((ext_vector_type(2)));

typedef float f32x2v __attribute__((ext_vector_type(2)));
typedef unsigned u32x2v __attribute__((ext_vector_type(2)));
constexpr float kInvD = 1.0f / 2048.0f, kEps = 1e-5f;
__device__ __forceinline__ void row_mu_r(const float* st, int row, float& mu, float& r) {
    const f32x4* p = (const f32x4*)(st + 16 * (size_t)row); const f32x4 a = p[0], b = p[1], c = p[2], d = p[3];
    const float s = ((a[0] + a[2]) + (b[0] + b[2])) + ((c[0] + c[2]) + (d[0] + d[2])), q = ((a[1] + a[3]) + (b[1] + b[3])) + ((c[1] + c[3]) + (d[1] + d[3]));
    mu = s * kInvD; const float var = fmaxf(q * kInvD - mu * mu, 0.f); r = __builtin_amdgcn_rsqf(var + kEps);
}
__device__ __forceinline__ void stage_mu_r(PG8_LAS f32x2v* mr, const float* st, int pm, int t) {
    if (t < 256) { float mu, r; row_mu_r(st, pm * BM + t, mu, r); mr[t] = (f32x2v){mu, r}; }
    asm volatile("s_waitcnt lgkmcnt(0)" ::: "memory"); __builtin_amdgcn_s_barrier(); asm volatile("" ::: "memory");
}
__device__ __forceinline__ u32x4 pack_bf16x8(const f32x4 v0, const f32x4 v1) { u32x4 w; w.x = cvt_pk_bf16(v0[0], v0[1]); w.y = cvt_pk_bf16(v0[2], v0[3]); w.z = cvt_pk_bf16(v1[0], v1[1]); w.w = cvt_pk_bf16(v1[2], v1[3]); return w; }
template <int HD> struct EpiQKV {
    static constexpr bool PERM = true, AFTER_DRAIN = false; static constexpr int NSTORES = 16;
    bf16_t* O; int ldc; const float* bias; const float* tab; const float* ident; int rope_tiles; int seq_mask;
    const float* st; const float* cs; const float* cb; int cstride; int seq_shift; PG8_LAS float* mrt; int staged_pm;
    __device__ __forceinline__ void operator()(f32x4 (&acc)[2][2][4][2], const Unit& u, int wr, int wc, int fr, int fq) const {
        asm volatile("" : "+v"(fr), "+v"(fq));
        const int row0 = u.pm * BM + wr * 64 + fr, col0 = u.pn * BM + wc * 32 + 8 * fq, lrow0 = wr * 64 + fr;
        PG8_LAS f32x2v* mr = (PG8_LAS f32x2v*)mrt; (void)staged_pm;
        const bool rope = u.pn < rope_tiles;
        const char* tbase = rope ? (const char*)tab : (const char*)ident; const unsigned tmul = rope ? (unsigned)(HD * 4) : 0u;
        const size_t cofs = (size_t)((u.pm * BM) >> seq_shift) * cstride + col0;
#pragma unroll
        for (int bj = 0; bj < 2; ++bj) {
            f32x4 bv[2], cbv[2], csv[2];
#pragma unroll
            for (int n = 0; n < 2; ++n) { bv[n] = *(const f32x4*)(bias + col0 + bj * HALF + 4 * n); cbv[n] = *(const f32x4*)(cb + cofs + bj * HALF + 4 * n); csv[n] = *(const f32x4*)(cs + cofs + bj * HALF + 4 * n); }
            const unsigned tcol = rope ? (unsigned)(((col0 + bj * HALF) & (HD - 1)) >> 1) * 8u : 0u;
#pragma unroll
            for (int ai = 0; ai < 2; ++ai) {
                f32x4 tb[4][2];
#pragma unroll
                for (int m = 0; m < 4; ++m) { const unsigned tof = (unsigned)((row0 + ai * HALF + m * 16) & seq_mask) * tmul + tcol;
                    tb[m][0] = *(const f32x4*)(tbase + tof); tb[m][1] = *(const f32x4*)(tbase + tof + 16u); }
                asm volatile("" : "+v"(tb[0][0]), "+v"(tb[0][1]), "+v"(tb[1][0]), "+v"(tb[1][1]), "+v"(tb[2][0]), "+v"(tb[2][1]), "+v"(tb[3][0]), "+v"(tb[3][1]));
                if (ai == 0) { bv[0] += cbv[0]; bv[1] += cbv[1]; }
#pragma unroll
                for (int m = 0; m < 4; ++m) { const f32x2v q = mr[lrow0 + ai * HALF + m * 16]; const float mu = q.x, r = q.y;
                    const f32x4 v0 = (acc[ai][bj][m][0] - csv[0] * mu) * r + bv[0], v1 = (acc[ai][bj][m][1] - csv[1] * mu) * r + bv[1];
                    const f32x4 t0 = tb[m][0], t1 = tb[m][1];
                    acc[ai][bj][m][0] = (f32x4){v0[0] * t0[0] - v0[1] * t0[1], v0[1] * t0[0] + v0[0] * t0[1], v0[2] * t0[2] - v0[3] * t0[3], v0[3] * t0[2] + v0[2] * t0[3]};
                    acc[ai][bj][m][1] = (f32x4){v1[0] * t1[0] - v1[1] * t1[1], v1[1] * t1[0] + v1[0] * t1[1], v1[2] * t1[2] - v1[3] * t1[3], v1[3] * t1[2] + v1[2] * t1[3]}; }
                asm volatile("" : "+v"(acc[ai][bj][0][0]), "+v"(acc[ai][bj][0][1]), "+v"(acc[ai][bj][1][0]), "+v"(acc[ai][bj][1][1]), "+v"(acc[ai][bj][2][0]), "+v"(acc[ai][bj][2][1]), "+v"(acc[ai][bj][3][0]), "+v"(acc[ai][bj][3][1]) :: "memory");
            }
        }
#pragma unroll
        for (int ai = 0; ai < 2; ++ai)
#pragma unroll
            for (int m = 0; m < 4; ++m) { bf16_t* rowp = O + (size_t)(row0 + ai * HALF + m * 16) * ldc + col0;
#pragma unroll
                for (int bj = 0; bj < 2; ++bj) { const u32x4 w_ = pack_bf16x8(acc[ai][bj][m][0], acc[ai][bj][m][1]);
                    if (QKV_DATAFLOW) store16_wt(rowp + bj * HALF, w_); else *(u32x4*)(rowp + bj * HALF) = w_; } }
    }
};
struct EpiRelu2 {
    static constexpr bool PERM = true, AFTER_DRAIN = false; static constexpr int NSTORES = 16;
    bf16_t* O; int ldc; const float* st; const float* cs; const float* cb; int cstride; int seq_shift; PG8_LAS float* mrt; int staged_pm; bf16_t* dup;
    __device__ __forceinline__ void operator()(f32x4 (&acc)[2][2][4][2], const Unit& u, int wr, int wc, int fr, int fq) const {
        asm volatile("" : "+v"(fr), "+v"(fq));
        const int row0 = u.pm * BM + wr * 64 + fr, col0 = u.pn * BM + wc * 32 + 8 * fq, lrow0 = wr * 64 + fr;
        const size_t cofs = (size_t)((u.pm * BM) >> seq_shift) * cstride + col0;
        PG8_LAS f32x2v* mr = (PG8_LAS f32x2v*)mrt; (void)staged_pm;
        f32x4 cbv[2][2], csv[2][2];
#pragma unroll
        for (int bj = 0; bj < 2; ++bj)
#pragma unroll
            for (int n = 0; n < 2; ++n) { cbv[bj][n] = *(const f32x4*)(cb + cofs + bj * HALF + 4 * n); csv[bj][n] = *(const f32x4*)(cs + cofs + bj * HALF + 4 * n); }
        asm volatile("" ::: "memory");
#pragma unroll
        for (int ai = 0; ai < 2; ++ai)
#pragma unroll
            for (int m = 0; m < 4; ++m) { bf16_t* rowp = O + (size_t)(row0 + ai * HALF + m * 16) * ldc + col0; const f32x2v q = mr[lrow0 + ai * HALF + m * 16]; u32x4 wv[2]; (void)rowp; (void)wv;
#pragma unroll
                for (int bj = 0; bj < 2; ++bj) { f32x4 v0 = (acc[ai][bj][m][0] - csv[bj][0] * q.x) * q.y + cbv[bj][0], v1 = (acc[ai][bj][m][1] - csv[bj][1] * q.x) * q.y + cbv[bj][1];
#pragma unroll
                    for (int e = 0; e < 4; ++e) { const float a = fmaxf(v0[e], 0.f), b = fmaxf(v1[e], 0.f); v0[e] = a * a; v1[e] = b * b; }
#if HID_PERM
                    wv[bj] = pack_bf16x8(v0, v1); }
                { const bool lo = fr < 8; const u32x4 snd = lo ? wv[1] : wv[0]; u32x4 rcv;
#pragma unroll
                  for (int e = 0; e < 4; ++e) rcv[e] = (unsigned)__builtin_amdgcn_update_dpp(0, (int)snd[e], 0x128, 0xf, 0xf, false);
                  const u32x4 dA = lo ? wv[0] : rcv, dB = lo ? rcv : wv[1];
                  bf16_t* pA = O + (size_t)(u.pm * BM + wr * 64 + ai * HALF + m * 16 + (fr & 7)) * ldc + u.pn * BM + wc * 64 + (lo ? 0 : 32) + 8 * fq;
                  *(u32x4*)pA = dA; *(u32x4*)(pA + (size_t)8 * ldc) = dB; } }
#else
                    { const u32x4 w_ = pack_bf16x8(v0, v1); *(u32x4*)(rowp + bj * HALF) = w_; } } }
#endif
    }
};
struct EpiResid {
    static constexpr bool PERM = true, AFTER_DRAIN = false; static constexpr int NSTORES = 16;
    const bf16_t* rb; const float* ig; int igstride; const float* pst; const float* pg; const float* pb; float* outf; float* st; bf16_t* hb; const float* gn; int gnstride;
    int ldc; const float* gate; int gstride; const float* bias; float alpha; int seq_shift;
    PG8_LAS float* tbl; int staged_pm;
    __device__ __forceinline__ void operator()(f32x4 (&acc)[2][2][4][2], const Unit& u, int wr, int wc, int fr, int fq) const {
        asm volatile("" : "+v"(fr), "+v"(fq));
        const int lrow0 = wr * 64 + fr, col0 = u.pn * BM + wc * 32 + 8 * fq;
        const int b = (u.pm * BM) >> seq_shift, t = (wr * 4 + wc) * 64 + fq * 16 + fr;
        const float* gb = gate + (size_t)b * gstride + col0; const float* gnb = gn + (size_t)b * gnstride + col0; const float* igb = ig + (size_t)b * igstride + col0;
        PG8_LAS f32x2v* mr = (PG8_LAS f32x2v*)tbl; PG8_LAS f32x2v* ps = (PG8_LAS f32x2v*)tbl + 256;
        (void)staged_pm;
        const unsigned rowb = (unsigned)((u.pm * BM + lrow0) * ldc + col0) * 2u;
        const unsigned rstep = (unsigned)ldc * 32u;
#pragma unroll
        for (int bj = 0; bj < 2; ++bj) { const int c = bj * HALF;
            u32x4 xs[2][4];
#pragma unroll
            for (int ai = 0; ai < 2; ++ai)
#pragma unroll
                for (int m = 0; m < 4; ++m) xs[ai][m] = *(const u32x4*)((const char*)rb + (rowb + (unsigned)(ai * 8 + m) * rstep + (unsigned)c * 2u));
            f32x4 gv[2], c1[2], c2[2], c3[2];
#pragma unroll
            for (int n = 0; n < 2; ++n) { gv[n] = *(const f32x4*)(gb + c + 4 * n); c1[n] = *(const f32x4*)(igb + c + 4 * n); c2[n] = *(const f32x4*)(pg + col0 + c + 4 * n);
                c3[n] = *(const f32x4*)(pb + col0 + c + 4 * n); }
            const f32x4 bz0 = *(const f32x4*)(bias + col0 + c), bz1 = *(const f32x4*)(bias + col0 + c + 4);
            asm volatile("" : "+v"(xs[0][0]), "+v"(xs[0][1]), "+v"(xs[0][2]), "+v"(xs[0][3]), "+v"(xs[1][0]), "+v"(xs[1][1]), "+v"(xs[1][2]), "+v"(xs[1][3]));
#pragma unroll
            for (int n = 0; n < 2; ++n) { gv[n] = gv[n] + 1.0f; c1[n] = c1[n] * alpha  ; c2[n] = c2[n] * alpha; c3[n] = c3[n] * alpha + gv[n] * (n ? bz1 : bz0); }
#pragma unroll
            for (int ai = 0; ai < 2; ++ai)
#pragma unroll
                for (int m = 0; m < 4; ++m) { const f32x2v q = mr[lrow0 + ai * HALF + m * 16]; const u32x4 x = xs[ai][m];
                    const f32x4 x0 = {__uint_as_float(x.x << 16), __uint_as_float(x.x & 0xffff0000u), __uint_as_float(x.y << 16), __uint_as_float(x.y & 0xffff0000u)};
                    const f32x4 x1 = {__uint_as_float(x.z << 16), __uint_as_float(x.z & 0xffff0000u), __uint_as_float(x.w << 16), __uint_as_float(x.w & 0xffff0000u)};
                    acc[ai][bj][m][0] = (x0 * c1[0] - c2[0] * q.x) * q.y + c3[0] + gv[0] * acc[ai][bj][m][0];
                    acc[ai][bj][m][1] = (x1 * c1[1] - c2[1] * q.x) * q.y + c3[1] + gv[1] * acc[ai][bj][m][1]; }
            asm volatile("" : "+v"(acc[0][bj][0][0]), "+v"(acc[0][bj][1][0]), "+v"(acc[0][bj][2][0]), "+v"(acc[0][bj][3][0]), "+v"(acc[1][bj][0][0]), "+v"(acc[1][bj][1][0]), "+v"(acc[1][bj][2][0]), "+v"(acc[1][bj][3][0]),
                              "+v"(acc[0][bj][0][1]), "+v"(acc[0][bj][1][1]), "+v"(acc[0][bj][2][1]), "+v"(acc[0][bj][3][1]), "+v"(acc[1][bj][0][1]), "+v"(acc[1][bj][1][1]), "+v"(acc[1][bj][2][1]), "+v"(acc[1][bj][3][1]) :: "memory");
        }
        unsigned rowb2 = rowb; asm volatile("" : "+v"(rowb2));
#pragma unroll
        for (int ai = 0; ai < 2; ++ai)
#pragma unroll
            for (int m = 0; m < 4; ++m) { const int lrow = lrow0 + ai * HALF + m * 16;
                float s_ = 0.f, q_ = 0.f;
#pragma unroll
                for (int bj = 0; bj < 2; ++bj)
#pragma unroll
                    for (int n = 0; n < 2; ++n) { const f32x4 v = acc[ai][bj][m][n]; s_ += (v[0] + v[1]) + (v[2] + v[3]); q_ += (v[0] * v[0] + v[1] * v[1]) + (v[2] * v[2] + v[3] * v[3]); }
                s_ += lane_xor<16>(s_); s_ = half_sum32(s_); q_ += lane_xor<16>(q_); q_ = half_sum32(q_);
                if (fq == 0) ps[lrow * 4 + wc] = (f32x2v){s_, q_}; }
        if (hb) {
            f32x4 gnv[2][2];
#pragma unroll
            for (int bj = 0; bj < 2; ++bj)
#pragma unroll
                for (int n = 0; n < 2; ++n) gnv[bj][n] = *(const f32x4*)(gnb + bj * HALF + 4 * n);
#pragma unroll
            for (int ai = 0; ai < 2; ++ai)
#pragma unroll
                for (int m = 0; m < 4; ++m) { const unsigned ob = rowb2 + (unsigned)(ai * 8 + m) * rstep;
#pragma unroll
                    for (int bj = 0; bj < 2; ++bj) *(u32x4*)((char*)hb + (ob + (unsigned)bj * 256u)) = pack_bf16x8(acc[ai][bj][m][0] * gnv[bj][0], acc[ai][bj][m][1] * gnv[bj][1]); }
        } else {
#pragma unroll
            for (int ai = 0; ai < 2; ++ai)
#pragma unroll
                for (int m = 0; m < 4; ++m) { const unsigned ob = (rowb2 + (unsigned)(ai * 8 + m) * rstep) * 2u;
#pragma unroll
                    for (int bj = 0; bj < 2; ++bj) { *(f32x4*)((char*)outf + (ob + (unsigned)bj * 512u)) = acc[ai][bj][m][0]; *(f32x4*)((char*)outf + (ob + (unsigned)bj * 512u + 16u)) = acc[ai][bj][m][1]; } }
        }
        asm volatile("s_waitcnt lgkmcnt(0)" ::: "memory"); __builtin_amdgcn_s_barrier(); asm volatile("" ::: "memory");
        if (t < 256) { const f32x2v a = ps[t * 4 + 0], b2 = ps[t * 4 + 1], c = ps[t * 4 + 2], d = ps[t * 4 + 3];
            *(f32x2v*)(st + 16 * (size_t)(u.pm * BM + t) + 2 * u.pn) = (f32x2v){(a.x + b2.x) + (c.x + d.x), (a.y + b2.y) + (c.y + d.y)}; }
    }
};

template <class Epi, class Sched, bool ALIGN_EPI = false, bool SP2 = false>
__device__ __forceinline__ void gemm_phase(PG8_LAS unsigned char* lds, const Gemm g, const Sched& S, const Epi& E) {
    const int tid = opaque_tid(), wid = __builtin_amdgcn_readfirstlane(tid >> 6), lane = tid & 63, wr = wid >> 2, wc = wid & 3, fr = lane & 15, fq = lane >> 4;
    const int K = g.K, nt = K / BK;
    unsigned voffA[2], voffB[2];
#pragma unroll
    for (int i = 0; i < 2; ++i) { int R, C; stage_rc(tid * 16 + i * 8192, R, C); const int Rb = Epi::PERM ? ((R & ~31) + perm32(R & 31)) : R;
        voffA[i] = (unsigned)(R * K + C) * 2u; voffB[i] = (unsigned)(Rb * K + C) * 2u; }
    const size_t kstep = (size_t)(BK * 2);
    const size_t hstep = (size_t)HALF * K * 2;
    const size_t tstep = 2 * hstep;
    const unsigned ldsw = (unsigned)wid * 1024u;
    const int aoff = lds_byte(wr * 64 + fr, fq * 8), boff = lds_byte(wc * 32 + fr, fq * 8);
#define PG8_SA(b, h) (((b) * 2 + (h)) * HTB)
#define PG8_SB(b, h) ((4 + (b) * 2 + (h)) * HTB)
#define PG8_STAGE(bufoff, gbase, voff) do { _Pragma("unroll") for (int _i = 0; _i < 2; ++_i) \
        __builtin_amdgcn_global_load_lds((const unsigned*)((const char*)(gbase) + (voff)[_i]), (PG8_LAS unsigned*)(lds + (bufoff) + ldsw + _i * 8192), 16, 0, 0); } while (0)
#define PG8_LDA(dst, b, h) do { _Pragma("unroll") for (int m = 0; m < 4; ++m) _Pragma("unroll") for (int k = 0; k < 2; ++k) dst[m][k] = *(const PG8_LAS bf16x8*)(lds + PG8_SA(b, h) + aoff + m * 2048 + k * 1024); } while (0)
#define PG8_LDB(dst, b, h) do { _Pragma("unroll") for (int n = 0; n < 2; ++n) _Pragma("unroll") for (int k = 0; k < 2; ++k) dst[n][k] = *(const PG8_LAS bf16x8*)(lds + PG8_SB(b, h) + boff + n * 2048 + k * 1024); } while (0)
#define PG8_MMA(ai, bj, At, Bt) do { __builtin_amdgcn_s_setprio(1); _Pragma("unroll") for (int m = 0; m < 4; ++m) _Pragma("unroll") for (int n = 0; n < 2; ++n) _Pragma("unroll") for (int k = 0; k < 2; ++k) \
        acc[ai][bj][m][n] = __builtin_amdgcn_mfma_f32_16x16x32_bf16(Bt[n][k], At[m][k], acc[ai][bj][m][n], 0, 0, 0); __builtin_amdgcn_s_setprio(0); } while (0)
#define PG8_WAIT_V(n) asm volatile("s_waitcnt vmcnt(" #n ")" ::: "memory")
#define PG8_WAIT_L(n) asm volatile("s_waitcnt lgkmcnt(" #n ")" ::: "memory")
#if PG8_RELAX
#define PG8_WAIT_VR() do { asm volatile("s_waitcnt vmcnt(%0)" :: "n"(8 + Epi::NSTORES) : "memory"); if (!PG8_RELAX || relax_ == 0) { PG8_WAIT_V(8); } } while (0)
#else
#define PG8_WAIT_VR() PG8_WAIT_V(8)
#endif
#define PG8_BAR __builtin_amdgcn_s_barrier()
#define PG8_SCHED __builtin_amdgcn_sched_barrier(0)
    Unit cur, nxt; int ui = 0;
    if (!S.next(0, cur)) return;
#if PG8_PROBE
    unsigned long long pr_tk = 0, pr_te = 0; const unsigned long long pr_r0 = __builtin_amdgcn_s_memrealtime(), pr_c0 = __builtin_amdgcn_s_memtime();
#endif
    f32x4 acc[2][2][4][2];
#pragma unroll
    for (int a = 0; a < 2; ++a)
#pragma unroll
        for (int b = 0; b < 2; ++b)
#pragma unroll
            for (int m = 0; m < 4; ++m)
#pragma unroll
                for (int n = 0; n < 2; ++n) acc[a][b][m][n] = (f32x4){0.f, 0.f, 0.f, 0.f};
    bf16x8 At[4][2], B0[2][2], B1[2][2];
    const char* cA = (const char*)g.A + (size_t)cur.pm * tstep; const char* cB = (const char*)g.Bt + (size_t)cur.pn * tstep;
    S.a_ready(cur);
    if constexpr (SP2) {
        PG8_STAGE(PG8_SB(0, 0), cB, voffB); PG8_STAGE(PG8_SB(0, 1), cB + hstep, voffB); PG8_STAGE(PG8_SA(0, 0), cA, voffA); PG8_STAGE(PG8_SA(0, 1), cA + hstep, voffA);
        if (wr == 1) PG8_BAR;
        PG8_WAIT_V(2); PG8_BAR;
        PG8_STAGE(PG8_SB(1, 0), cB + kstep, voffB); PG8_STAGE(PG8_SA(1, 0), cA + kstep, voffA); PG8_STAGE(PG8_SB(1, 1), cB + hstep + kstep, voffB);
        PG8_WAIT_V(6); PG8_BAR;
    } else {
        PG8_STAGE(PG8_SB(0, 0), cB, voffB); PG8_STAGE(PG8_SA(0, 0), cA, voffA); PG8_STAGE(PG8_SB(0, 1), cB + hstep, voffB); PG8_STAGE(PG8_SA(0, 1), cA + hstep, voffA);
        if (wr == 1) PG8_BAR;
        PG8_WAIT_V(4); PG8_BAR;
        PG8_STAGE(PG8_SB(1, 0), cB + kstep, voffB); PG8_STAGE(PG8_SA(1, 0), cA + kstep, voffA); PG8_STAGE(PG8_SB(1, 1), cB + hstep + kstep, voffB);
        PG8_WAIT_V(6); PG8_BAR;
    }
    for (;;) {
        const bool has_next = S.next(ui + 1, nxt);
        const char* nA = has_next ? (const char*)g.A + (size_t)nxt.pm * tstep : cA; const char* nB = has_next ? (const char*)g.Bt + (size_t)nxt.pn * tstep : cB;
#if PG8_PROBE
        const unsigned long long pr_ta = __builtin_amdgcn_s_memtime();
#endif
        for (int t = 0; t < nt; t += 2) {
            const bool last = (t == nt - 2);
#if PG8_PROBE >= 9 && PG8_PROBE <= 10
            int pr_tv = (PG8_PROBE == 9 ? 0 : 8); asm volatile("" : "+v"(pr_tv)); const bool pr_sel = (ui > 0) && (t == __builtin_amdgcn_readfirstlane(pr_tv)); const unsigned pr_i0 = (unsigned)__builtin_amdgcn_s_memtime();
#endif
#if PG8_RELAX
            int relax_v = ((t == 0) && (ui > 0)) ? 1 : 0; asm volatile("" : "+v"(relax_v)); const int relax_ = __builtin_amdgcn_readfirstlane(relax_v);
#endif
            const char* a1 = cA + (size_t)(t + 1) * kstep;
            const char* a2 = last ? nA : cA + (size_t)(t + 2) * kstep; const char* b2 = last ? nB : cB + (size_t)(t + 2) * kstep;
            const char* a3 = a2 + kstep; const char* b3 = b2 + kstep;
            if (last && has_next) S.a_ready(nxt);
            if constexpr (SP2) {
            PG8_LDB(B0, 0, 0); PG8_LDB(B1, 0, 1); PG8_SCHED; PG8_LDA(At, 0, 0); PG8_STAGE(PG8_SA(1, 1), a1 + hstep, voffA);
            PG8_WAIT_VR(); PG8_WAIT_L(0); PG8_BAR; PG8_MMA(0, 0, At, B0); PG8_MMA(0, 1, At, B1); PG8_BAR; PG8_SCHED;
            PG8_LDA(At, 0, 1); PG8_STAGE(PG8_SB(0, 0), b2, voffB); PG8_STAGE(PG8_SB(0, 1), b2 + hstep, voffB); PG8_STAGE(PG8_SA(0, 0), a2, voffA);
            PG8_WAIT_VR(); PG8_WAIT_L(0); PG8_BAR; PG8_MMA(1, 0, At, B0); PG8_MMA(1, 1, At, B1); PG8_BAR; PG8_SCHED;
            PG8_LDB(B0, 1, 0); PG8_LDB(B1, 1, 1); PG8_SCHED; PG8_LDA(At, 1, 0); PG8_STAGE(PG8_SA(0, 1), a2 + hstep, voffA);
            PG8_WAIT_V(8); PG8_WAIT_L(0); PG8_BAR; PG8_MMA(0, 0, At, B0); PG8_MMA(0, 1, At, B1); PG8_BAR; PG8_SCHED;
            PG8_LDA(At, 1, 1); PG8_STAGE(PG8_SB(1, 0), b3, voffB); PG8_STAGE(PG8_SB(1, 1), b3 + hstep, voffB); PG8_STAGE(PG8_SA(1, 0), a3, voffA);
            PG8_WAIT_V(8); PG8_WAIT_L(0); PG8_BAR; PG8_MMA(1, 0, At, B0); PG8_MMA(1, 1, At, B1); PG8_BAR; PG8_SCHED;
            } else {
            PG8_LDB(B0, 0, 0); PG8_SCHED; PG8_LDA(At, 0, 0); PG8_STAGE(PG8_SA(1, 1), a1 + hstep, voffA);
            PG8_WAIT_L(8); PG8_BAR; PG8_WAIT_L(0); PG8_MMA(0, 0, At, B0); PG8_BAR; PG8_SCHED;
            PG8_LDB(B1, 0, 1); PG8_STAGE(PG8_SB(0, 0), b2, voffB);
            PG8_BAR; PG8_WAIT_L(0); PG8_MMA(0, 1, At, B1); PG8_BAR;
            PG8_LDA(At, 0, 1); PG8_STAGE(PG8_SA(0, 0), a2, voffA);
            PG8_BAR; PG8_WAIT_L(0); PG8_MMA(1, 0, At, B0); PG8_BAR; PG8_SCHED;
            PG8_STAGE(PG8_SB(0, 1), b2 + hstep, voffB);
            PG8_WAIT_V(6); PG8_BAR; PG8_MMA(1, 1, At, B1); PG8_BAR;
            PG8_LDB(B0, 1, 0); PG8_SCHED; PG8_LDA(At, 1, 0); PG8_STAGE(PG8_SA(0, 1), a2 + hstep, voffA);
            PG8_WAIT_L(8); PG8_BAR; PG8_WAIT_L(0); PG8_MMA(0, 0, At, B0); PG8_BAR; PG8_SCHED;
            PG8_LDB(B1, 1, 1); PG8_STAGE(PG8_SB(1, 0), b3, voffB);
            PG8_BAR; PG8_WAIT_L(0); PG8_MMA(0, 1, At, B1); PG8_BAR;
            PG8_LDA(At, 1, 1); PG8_STAGE(PG8_SA(1, 0), a3, voffA);
            PG8_BAR; PG8_WAIT_L(0); PG8_MMA(1, 0, At, B0); PG8_BAR; PG8_SCHED;
            PG8_STAGE(PG8_SB(1, 1), b3 + hstep, voffB);
            PG8_WAIT_V(6); PG8_BAR; PG8_MMA(1, 1, At, B1); PG8_BAR;
            }
#if PG8_PROBE >= 9 && PG8_PROBE <= 10
            if (pr_sel) pr_tk += (unsigned)((unsigned)__builtin_amdgcn_s_memtime() - pr_i0);
#endif
        }
#if PG8_PROBE
        const unsigned long long pr_tb = __builtin_amdgcn_s_memtime(); if (!(PG8_PROBE >= 9 && PG8_PROBE <= 10)) pr_tk += pr_tb - pr_ta;
#endif
        if constexpr (ALIGN_EPI) { if (wr == 0) PG8_BAR; }
        if constexpr (!Epi::AFTER_DRAIN) { E(acc, cur, wr, wc, fr, fq); S.done(cur); }
#if PG8_PROBE
        { const unsigned long long pr_tc = __builtin_amdgcn_s_memtime(); pr_te += pr_tc - pr_tb; }
#endif
        if (!has_next) break;
#pragma unroll
        for (int a = 0; a < 2; ++a)
#pragma unroll
            for (int b = 0; b < 2; ++b)
#pragma unroll
                for (int m = 0; m < 4; ++m)
#pragma unroll
                    for (int n = 0; n < 2; ++n) acc[a][b][m][n] = (f32x4){0.f, 0.f, 0.f, 0.f};
        cur = nxt; cA = nA; cB = nB; ++ui;
        if constexpr (ALIGN_EPI) { if (wr == 1) PG8_BAR; }
    }
#if PG8_PROBE
    if (g.probe && blockIdx.x == 0 && tid == 0) { g.probe[0] = pr_tk; g.probe[1] = pr_te; g.probe[2] = (unsigned long long)(ui + 1); g.probe[3] = __builtin_amdgcn_s_memrealtime() - pr_r0; g.probe[4] = __builtin_amdgcn_s_memtime() - pr_c0; }
#endif
    PG8_WAIT_V(0);
    if constexpr (!ALIGN_EPI) { if (wr == 0) PG8_BAR; }
    PG8_BAR;
    if constexpr (Epi::AFTER_DRAIN) { E.fused(acc, cur, wr, wc, fr, fq, lds, wid, lane); S.done(cur); }
#undef PG8_SA
#undef PG8_SB
#undef PG8_STAGE
#undef PG8_LDA
#undef PG8_LDB
#undef PG8_MMA
#undef PG8_WAIT_V
#undef PG8_WAIT_L
#undef PG8_WAIT_VR
#undef PG8_BAR
#undef PG8_SCHED
}
}

namespace attA {
constexpr int D = 128;
constexpr int LDQ = NQKV_A, LDKV = NQKV_A, LDO = 2 * DM;
constexpr float THR = 8.f;
constexpr bool WSKIP = false;
constexpr float SCALE = 0.08838834764831845f;
constexpr int NW = 8, QBLK = 32, KVBLK = 64, QB = NW * QBLK;
constexpr int SHM_V = KVBLK * D * 2, SHM_K = KVBLK * D * 2;
constexpr int LDS_BYTES = 2 * SHM_V + 2 * SHM_K + NW * 64 * 4;
using bf16 = __hip_bfloat16;
typedef short bf16x8 __attribute__((ext_vector_type(8)));
typedef short s16x4 __attribute__((ext_vector_type(4)));
typedef float f32x16 __attribute__((ext_vector_type(16)));
typedef float f32x4 __attribute__((ext_vector_type(4)));
typedef unsigned u32x4 __attribute__((ext_vector_type(4)));
template <class A, class Bt> struct same_t { static constexpr bool v = false; };
template <class A> struct same_t<A, A> { static constexpr bool v = true; };

#define KSWZ(row, colB) ((row) * 256 + ((colB) ^ (((row) & 7) << 4)))
#define SBAR() __builtin_amdgcn_sched_barrier(0)
__device__ __forceinline__ int v_st(int k, int c) { const int kk = (k & ~0xC) | ((k & 4) << 1) | ((k & 8) >> 1); return ((kk >> 3) * 4 + (c >> 5)) * 512 + ((kk & 7) * 32 + (c & 31)) * 2; }
__device__ __forceinline__ int v_rd_base(int lane) { return ((lane & 3) << 3) | (((lane >> 2) & 3) << 6) | (((lane >> 4) & 1) << 5) | (((lane >> 5) & 1) << 8); }
constexpr int v_rd_off(int d0, int ks, int half) { return d0 * 512 + ks * 4096 + half * 2048; }
__device__ __forceinline__ int crow(int r, int hi) { return (r & 3) + 8 * (r >> 2) + 4 * hi; }
__device__ __forceinline__ unsigned cvtpk(float lo, float hi) {
    unsigned r; asm volatile("v_cvt_pk_bf16_f32 %0, %1, %2" : "=v"(r) : "v"(lo), "v"(hi)); return r;
}
__device__ __forceinline__ bf16x8 pack8(f32x4 a, f32x4 b) {
    u32x4 w = {cvtpk(a[0], a[1]), cvtpk(a[2], a[3]), cvtpk(b[0], b[1]), cvtpk(b[2], b[3])};
    return *reinterpret_cast<bf16x8*>(&w);
}
template <class T> __device__ __forceinline__ bf16x8 load8(const T* p) {
    if constexpr (same_t<T, float>::v) { return pack8(*(const f32x4*)p, *(const f32x4*)(p + 4)); }
    else { return *reinterpret_cast<const bf16x8*>(p); }
}
__device__ __forceinline__ void mask_tile(f32x16& p0, f32x16& p1, int dq, unsigned W) {
    const float NEG = -__builtin_inff();
#pragma unroll
    for (int r = 0; r < 16; ++r) {
        const int c = (r & 3) + 8 * (r >> 2);
        if ((unsigned)(dq - c) >= W) p0[r] = NEG;
        if ((unsigned)(dq - c - 32) >= W) p1[r] = NEG;
    }
}
__device__ __forceinline__ void partialSM(f32x16& p0, f32x16& p1, float& m_reg, float& mn, float& alpha) {
    float pmax = p0[0]; for (int r = 1; r < 16; ++r) pmax = fmaxf(pmax, p0[r]); for (int r = 0; r < 16; ++r) pmax = fmaxf(pmax, p1[r]);
    { auto rr = __builtin_amdgcn_permlane32_swap(__float_as_uint(pmax), __float_as_uint(pmax), false, false);
      pmax = fmaxf(__uint_as_float(rr[0]), __uint_as_float(rr[1])); }
    constexpr float C2 = 1.4426950408889634f * SCALE;
    if (__builtin_expect(__all((pmax - m_reg) * SCALE <= THR), 1)) { mn = m_reg; alpha = 1.f; }
    else { mn = fmaxf(m_reg, pmax); alpha = __builtin_amdgcn_exp2f((m_reg - mn) * C2); m_reg = mn; }
    const float mnL = -mn * C2;
    for (int r = 0; r < 16; ++r) p0[r] = fmaf(p0[r], C2, mnL); for (int r = 0; r < 16; ++r) p1[r] = fmaf(p1[r], C2, mnL);
    for (int r = 0; r < 16; ++r) p0[r] = __builtin_amdgcn_exp2f(p0[r]);
}
__device__ __forceinline__ void finishSM(f32x16& p0, f32x16& p1, float alpha, float& l_reg, bf16x8& pa0, bf16x8& pa1, bf16x8& pa2, bf16x8& pa3) {
    for (int r = 0; r < 16; ++r) p1[r] = __builtin_amdgcn_exp2f(p1[r]);
    float ps = 0; for (int r = 0; r < 16; ++r) ps += p0[r]; for (int r = 0; r < 16; ++r) ps += p1[r];
    { auto rr = __builtin_amdgcn_permlane32_swap(__float_as_uint(ps), __float_as_uint(ps), false, false);
      ps = __uint_as_float(rr[0]) + __uint_as_float(rr[1]); }
    l_reg = l_reg * alpha + ps;
#define PK4(P, B_, OUT) do { unsigned a0 = cvtpk(P[B_+0], P[B_+1]), a1 = cvtpk(P[B_+2], P[B_+3]);                          \
        unsigned b0 = cvtpk(P[B_+4], P[B_+5]), b1 = cvtpk(P[B_+6], P[B_+7]);                                             \
        auto r0 = __builtin_amdgcn_permlane32_swap(a0, b0, false, false); auto r1 = __builtin_amdgcn_permlane32_swap(a1, b1, false, false); \
        u32x4 w = {r0[0], r1[0], r0[1], r1[1]}; OUT = *reinterpret_cast<bf16x8*>(&w); } while (0)
    PK4(p0, 0, pa0); PK4(p0, 8, pa1); PK4(p1, 0, pa2); PK4(p1, 8, pa3);
#undef PK4
}
template <int KB, bool SK>
__device__ __forceinline__ void qkt(f32x16& p0, f32x16& p1, const char* K_lds, int r32, int hi, const bf16x8* qr, bool act) {
    if (SK && !act) { const float NEG = -__builtin_inff();
#pragma unroll
        for (int r = 0; r < 16; ++r) { p0[r] = NEG; p1[r] = NEG; } return; }
    p0 = f32x16{}; p1 = f32x16{};
    const char* kb[4];
#pragma unroll
    for (int dd = 0; dd < 4; ++dd) kb[dd] = K_lds + KB * SHM_K + KSWZ(r32, (dd * 16 + hi * 8) * 2);
#pragma unroll
    for (int d0 = 0; d0 < 8; ++d0) { const char* a = kb[d0 & 3] + (d0 >> 2) * 128;
        bf16x8 b0 = *reinterpret_cast<const bf16x8*>(a);
        bf16x8 b1 = *reinterpret_cast<const bf16x8*>(a + 32 * 256);
        p0 = __builtin_amdgcn_mfma_f32_32x32x16_bf16(b0, qr[d0], p0, 0, 0, 0);
        p1 = __builtin_amdgcn_mfma_f32_32x32x16_bf16(b1, qr[d0], p1, 0, 0, 0); }
}
template <int VB, bool SK>
__device__ __forceinline__ void pv_tile(f32x16* o, int vb0, bf16x8 pa0, bf16x8 pa1, bf16x8 pa2, bf16x8 pa3, bool act) {
    if (SK && !act) return;
#define TRRD(dst, off) asm volatile("ds_read_b64_tr_b16 %0, %1 offset:%2" : "=&v"(dst) : "v"(vb0), "i"(off) : "memory")
#define PV_D0(d0) do { s16x4 l0, l1, l2, l3, h0, h1, h2, h3; constexpr int b_ = VB * SHM_V + v_rd_off(d0, 0, 0);     \
        TRRD(l0, b_); TRRD(h0, b_ + 2048); TRRD(l1, b_ + 4096); TRRD(h1, b_ + 6144); TRRD(l2, b_ + 8192); TRRD(h2, b_ + 10240); TRRD(l3, b_ + 12288); TRRD(h3, b_ + 14336); \
        asm volatile("s_waitcnt lgkmcnt(0)" ::: "memory"); SBAR();                 \
        o[d0] = __builtin_amdgcn_mfma_f32_32x32x16_bf16(pa0, (bf16x8){l0[0], l0[1], l0[2], l0[3], h0[0], h0[1], h0[2], h0[3]}, o[d0], 0, 0, 0);   \
        o[d0] = __builtin_amdgcn_mfma_f32_32x32x16_bf16(pa1, (bf16x8){l1[0], l1[1], l1[2], l1[3], h1[0], h1[1], h1[2], h1[3]}, o[d0], 0, 0, 0);   \
        o[d0] = __builtin_amdgcn_mfma_f32_32x32x16_bf16(pa2, (bf16x8){l2[0], l2[1], l2[2], l2[3], h2[0], h2[1], h2[2], h2[3]}, o[d0], 0, 0, 0);   \
        o[d0] = __builtin_amdgcn_mfma_f32_32x32x16_bf16(pa3, (bf16x8){l3[0], l3[1], l3[2], l3[3], h3[0], h3[1], h3[2], h3[3]}, o[d0], 0, 0, 0); } while (0)
    PV_D0(0); PV_D0(1); PV_D0(2); PV_D0(3);
#undef PV_D0
#undef TRRD
}

template <class TIn, class TOut> struct BlockRef { const TIn* Q; const TIn* K; const TIn* V; TOut* O; int P0; };
template <class TIn> struct Seam {
    bf16x8 qr[8];
    bf16x8 st_v0, st_v1, st_k0, st_k1; f32x4 sf0, sf1, sf2, sf3;
    f32x4 tq[16];
};
__device__ __forceinline__ int swa_jlo(int P0, int W) { const int lowk = P0 - W + 1; return lowk > 0 ? lowk / KVBLK : 0; }
#define ROW(p, k0, rr) ((p) + (size_t)((k0) + (rr)) * LDKV + sc)
#define VMW() asm volatile("s_waitcnt vmcnt(0)" ::: "memory")
#define VMWN(n) asm volatile("s_waitcnt vmcnt(%0)" :: "i"(n) : "memory")
#define SLOAD_H(Kp, Vp, k0) do { S.st_v0 = load8<TIn>(ROW(Vp, k0, sr)); S.st_v1 = load8<TIn>(ROW(Vp, k0, 32 + sr));              \
                         S.st_k0 = load8<TIn>(ROW(Kp, k0, sr)); S.st_k1 = load8<TIn>(ROW(Kp, k0, 32 + sr)); } while (0)
#define SWRITE_HK(bf) do { *(bf16x8*)(K_lds + (bf) * SHM_K + kws) = S.st_k0; *(bf16x8*)(K_lds + (bf) * SHM_K + kws + 32 * 256) = S.st_k1; } while (0)
#define SWRITE_HV(bf) do { *(bf16x8*)(V_lds + (bf) * SHM_V + vst0) = S.st_v0; *(bf16x8*)(V_lds + (bf) * SHM_V + vst1) = S.st_v1; } while (0)
#define SWRITE_H(bf) do { SWRITE_HV(bf); SWRITE_HK(bf); } while (0)
#define SLOAD_F(p, k0) do { S.sf0 = *(const f32x4*)ROW(p, k0, sr); S.sf1 = *(const f32x4*)(ROW(p, k0, sr) + 4);                \
                            S.sf2 = *(const f32x4*)ROW(p, k0, 32 + sr); S.sf3 = *(const f32x4*)(ROW(p, k0, 32 + sr) + 4); } while (0)
#define SWRITE_KF(bf) do { *(bf16x8*)(K_lds + (bf) * SHM_K + kws) = pack8(S.sf0, S.sf1); *(bf16x8*)(K_lds + (bf) * SHM_K + kws + 32 * 256) = pack8(S.sf2, S.sf3); } while (0)
#define SWRITE_VF(bf) do { *(bf16x8*)(V_lds + (bf) * SHM_V + vst0) = pack8(S.sf0, S.sf1); *(bf16x8*)(V_lds + (bf) * SHM_V + vst1) = pack8(S.sf2, S.sf3); } while (0)
template <class TIn, class TOut>
__device__ __forceinline__ void causal_swa_prime(const BlockRef<TIn, TOut>& cur, int W, char* lds, Seam<TIn>& S) {
    constexpr bool F32 = same_t<TIn, float>::v;
    const int tid = opaque_tid(), wid = __builtin_amdgcn_readfirstlane(tid >> 6), lane = tid & 63, r32 = lane & 31, hi = lane >> 5;
    const int sr = tid >> 4, sc = (tid & 15) * 8, kws = KSWZ(sr, sc * 2); char* K_lds = lds + 2 * SHM_V;
    const int kb0 = swa_jlo(cur.P0, W) * KVBLK;
    for (int d0 = 0; d0 < 8; ++d0) S.qr[d0] = load8<TIn>(cur.Q + (size_t)(wid * QBLK + r32) * LDQ + d0 * 16 + hi * 8);
    if constexpr (F32) { SLOAD_F((const float*)cur.K, kb0); VMW(); SWRITE_KF(0); SBAR(); SLOAD_F((const float*)cur.V, kb0); }
    else { SLOAD_H(cur.K, cur.V, kb0); VMW(); SWRITE_HK(0); }
    __syncthreads();
}
template <class TIn, class TOut>
__device__ __forceinline__ void causal_swa_block(const BlockRef<TIn, TOut>& cur, const BlockRef<TIn, TOut>& nxt, int skv, int W, char* lds, Seam<TIn>& S) {
    constexpr bool F32 = same_t<TIn, float>::v;
    const int tid = opaque_tid(), wid = __builtin_amdgcn_readfirstlane(tid >> 6), lane = tid & 63, r32 = lane & 31, hi = lane >> 5;
    const int j_lo = swa_jlo(cur.P0, W);
    int j_hi = (cur.P0 + QB - 1) / KVBLK + 1; if (j_hi > skv / KVBLK) j_hi = skv / KVBLK;
    const int NT = j_hi - j_lo;
    const int kbn = swa_jlo(nxt.P0, W) * KVBLK;
    const int qlo = cur.P0 + wid * QBLK, qm = qlo + r32 - 4 * hi;
    char* V_lds = lds; char* K_lds = lds + 2 * SHM_V;
    float* ws = (float*)(lds + 2 * SHM_V + 2 * SHM_K) + wid * 64; float* li_l = ws, * al_l = ws + 32;
    float m_reg = -1e30f, l_reg = 0; f32x16 o[4] = {};
    const int sr = tid >> 4, sc = (tid & 15) * 8, vst0 = v_st(sr, sc), vst1 = v_st(32 + sr, sc), kws = KSWZ(sr, sc * 2);
    const int vb0 = (int)(uintptr_t)V_lds + v_rd_base(lane);
    const TIn* Kh = cur.K; const TIn* Vh = cur.V;
#define RESC(a) do { if (__any((a) < 1.f)) { if (hi == 0) al_l[r32] = (a); asm volatile("s_waitcnt lgkmcnt(0)" ::: "memory");              \
                     for (int d_ = 0; d_ < 4; ++d_) for (int r = 0; r < 16; ++r) o[d_][r] *= al_l[crow(r, hi)]; } } while (0)
#define KBASE(t) ((j_lo + (t)) * KVBLK)
#define ACT(t) (KBASE(t) <= qlo + QBLK - 1 && KBASE(t) + KVBLK - 1 >= qlo - W + 1)
#define MASKT(P0_, P1_, t) do { const int kb_ = KBASE(t); if ((!SK || ACT(t)) && (kb_ + KVBLK - 1 > qlo || kb_ <= qlo + QBLK - 1 - W)) mask_tile(P0_, P1_, qm - kb_, (unsigned)W); } while (0)
    constexpr int NQL = F32 ? 16 : 8;
    constexpr bool SK = WSKIP && !F32;
#define SEAM_K0() do { VMWN(NQL); if constexpr (F32) { SWRITE_KF(0); SBAR(); SLOAD_F((const float*)nxt.V, kbn); } else { SWRITE_HK(0); } SBAR(); } while (0)
    f32x16 pA0, pA1, pB0, pB1; float mnA, mnB, alA, alB; bf16x8 pa0, pa1, pa2, pa3;
    if constexpr (F32) { VMW(); SWRITE_VF(0); SBAR(); } else { SWRITE_HV(0); SBAR(); }
    if (NT > 1) { if constexpr (F32) SLOAD_F((const float*)Kh, KBASE(1)); else SLOAD_H(Kh, Vh, KBASE(1)); }
    SBAR(); qkt<0, SK>(pA0, pA1, K_lds, r32, hi, S.qr, ACT(0));
    if constexpr (F32) { if (NT > 1) { VMW(); SWRITE_KF(1); SBAR(); SLOAD_F((const float*)Vh, KBASE(1)); } }
    MASKT(pA0, pA1, 0); partialSM(pA0, pA1, m_reg, mnA, alA);
    if (NT > 1) { VMW(); if constexpr (F32) { SWRITE_VF(1); SBAR(); if (NT > 2) SLOAD_F((const float*)Kh, KBASE(2)); } else SWRITE_H(1); }
    __syncthreads();
#define HALF_STEP(PX0, PX1, mnX, alX, PY0, PY1, alY, t, KB, VB, SB) do {                                                      \
        SBAR(); qkt<KB, SK>(PX0, PX1, K_lds, r32, hi, S.qr, ACT(t));                                             \
        finishSM(PY0, PY1, alY, l_reg, pa0, pa1, pa2, pa3); SBAR();                                                           \
        if ((t) + 1 < NT) { if constexpr (F32) { VMW(); SWRITE_KF(SB); SBAR(); SLOAD_F((const float*)Vh, KBASE((t) + 1)); }  \
                            else { SLOAD_H(Kh, Vh, KBASE((t) + 1)); } SBAR(); }                                               \
        pv_tile<VB, SK>(o, vb0, pa0, pa1, pa2, pa3, ACT((t) - 1)); MASKT(PX0, PX1, (t)); partialSM(PX0, PX1, m_reg, mnX, alX);                                        \
        __syncthreads();                                                                                                      \
        if ((t) + 1 < NT) { VMW(); if constexpr (F32) { SWRITE_VF(SB); SBAR(); if ((t) + 2 < NT) SLOAD_F((const float*)Kh, KBASE((t) + 2)); } \
                            else { SWRITE_H(SB); } }                                                                          \
        RESC(alX); __syncthreads(); } while (0)
    for (int t = 1; t + 1 < NT; t += 2) {
        HALF_STEP(pB0, pB1, mnB, alB, pA0, pA1, alA, t, 1, 0, 0);
        HALF_STEP(pA0, pA1, mnA, alA, pB0, pB1, alB, t + 1, 0, 1, 1);
    }
    const bool even = (NT & 1) == 0;
    if (even) { SBAR(); qkt<1, SK>(pB0, pB1, K_lds, r32, hi, S.qr, ACT(NT - 1)); SBAR(); }
#define QROW(e) (nxt.Q + (size_t)(wid * QBLK + r32) * LDQ + ((e) >> 1) * 16 + hi * 8 + ((e) & 1) * 4)
    if constexpr (F32) { SLOAD_F((const float*)nxt.K, kbn); SBAR();
#pragma unroll
        for (int e = 0; e < 8; ++e) S.tq[e] = *(const f32x4*)QROW(e); }
    else { SLOAD_H(nxt.K, nxt.V, kbn); SBAR();
#pragma unroll
        for (int d0 = 0; d0 < 8; ++d0) S.qr[d0] = load8<TIn>(nxt.Q + (size_t)(wid * QBLK + r32) * LDQ + d0 * 16 + hi * 8); }
    SBAR();
    finishSM(pA0, pA1, alA, l_reg, pa0, pa1, pa2, pa3); SBAR();
    if constexpr (F32) {
#pragma unroll
        for (int e = 8; e < 16; ++e) S.tq[e] = *(const f32x4*)QROW(e); SBAR(); }
#undef QROW
    pv_tile<0, SK>(o, vb0, pa0, pa1, pa2, pa3, ACT(even ? NT - 2 : NT - 1));
    if (even) { MASKT(pB0, pB1, NT - 1); partialSM(pB0, pB1, m_reg, mnB, alB); __syncthreads(); RESC(alB);
        finishSM(pB0, pB1, alB, l_reg, pa0, pa1, pa2, pa3); SBAR(); pv_tile<1, SK>(o, vb0, pa0, pa1, pa2, pa3, ACT(NT - 1)); }
    SBAR(); SEAM_K0();
    if (hi == 0) li_l[r32] = l_reg; asm volatile("s_waitcnt lgkmcnt(0)" ::: "memory");
    float rli[16];
#pragma unroll
    for (int r = 0; r < 16; ++r) rli[r] = __builtin_amdgcn_rcpf(li_l[crow(r, hi)]);
    TOut* Ow = cur.O + (size_t)(wid * QBLK) * LDO;
#pragma unroll
    for (int r = 0; r < 16; ++r) { const int orow = crow(r, hi);
#pragma unroll
        for (int d0 = 0; d0 < 4; ++d0) { const float v = o[d0][r] * rli[r];
            if constexpr (same_t<TOut, float>::v) { Ow[(size_t)orow * LDO + d0 * 32 + r32] = v; }
            else { const float vn = __shfl_xor(v, 1);
                   if ((r32 & 1) == 0) *(unsigned*)(Ow + (size_t)orow * LDO + d0 * 32 + r32) = cvtpk(v, vn); } } }
    if constexpr (F32) {
#pragma unroll
        for (int d0 = 0; d0 < 8; ++d0) S.qr[d0] = pack8(S.tq[2 * d0], S.tq[2 * d0 + 1]); }
    __syncthreads();
#undef RESC
#undef KBASE
#undef ACT
#undef MASKT
#undef SEAM_K0
#undef HALF_STEP
}
#undef ROW
#undef VMW
#undef VMWN
#undef SLOAD_H
#undef SWRITE_HK
#undef SWRITE_HV
#undef SWRITE_H
#undef SLOAD_F
#undef SWRITE_KF
#undef SWRITE_VF

#ifndef ATTA_LATE_FROM
#define ATTA_LATE_FROM 4
#endif
#ifndef ATTA_LATE_ODD
#define ATTA_LATE_ODD 0
#endif
#ifndef ATTA_STAMP_WAVE
#define ATTA_STAMP_WAVE 7
#endif
#ifndef ATTA_STAMP_SEL
#define ATTA_STAMP_SEL 0
#endif
#ifndef ATTA_STAMP
#define ATTA_STAMP 0
#endif
#ifndef ATTA_PRIO
#define ATTA_PRIO 1
#endif
#ifndef ATTA_T64
#define ATTA_T64 0
#endif
#ifndef ATTA_VPF
#define ATTA_VPF 1
#endif
#ifndef ATTA_PINGPONG
#define ATTA_PINGPONG 0
#endif
constexpr int SHM_V2 = KVBLK * 256 * 2;
constexpr int NVB = 3;
constexpr int LDS2_BYTES = NVB * SHM_V2 + 2 * SHM_K;
struct Blk2 { const bf16* Q; const bf16* K; const bf16* V; bf16* O; int P0; unsigned long long* stamp; };

template <int HF>
__device__ __forceinline__ void pv_half(f32x16 (&o)[8], const bf16x8& pa0, const bf16x8& pa1, int vb) {
#define TRRD(dst, off) asm volatile("ds_read_b64_tr_b16 %0, %1 offset:%2" : "=&v"(dst) : "v"(vb), "i"(off) : "memory")
#define RD4(l0, h0, l1, h1, d0) do { constexpr int b_ = ((d0) >> 2) * 16384 + ((d0) & 3) * 512 + HF * 8192;     \
        TRRD(l0, b_); TRRD(h0, b_ + 2048); TRRD(l1, b_ + 4096); TRRD(h1, b_ + 6144); } while (0)
#define MM2(l0, h0, l1, h1, d0) do { if (ATTA_PRIO == 2) __builtin_amdgcn_s_setprio(1); \
        o[d0] = __builtin_amdgcn_mfma_f32_32x32x16_bf16(pa0, (bf16x8){l0[0], l0[1], l0[2], l0[3], h0[0], h0[1], h0[2], h0[3]}, o[d0], 0, 0, 0); \
        o[d0] = __builtin_amdgcn_mfma_f32_32x32x16_bf16(pa1, (bf16x8){l1[0], l1[1], l1[2], l1[3], h1[0], h1[1], h1[2], h1[3]}, o[d0], 0, 0, 0); if (ATTA_PRIO == 2) __builtin_amdgcn_s_setprio(0); } while (0)
#define LWAIT() do { asm volatile("s_waitcnt lgkmcnt(0)" ::: "memory"); SBAR(); } while (0)
#if ATTA_VPF == 2
#define LWAIT4() do { asm volatile("s_waitcnt lgkmcnt(4)" ::: "memory"); SBAR(); } while (0)
    s16x4 a0, a1, a2, a3, b0, b1, b2, b3, c0, c1, c2, c3;
    RD4(a0, a1, a2, a3, 0); RD4(b0, b1, b2, b3, 1);
    LWAIT4(); RD4(c0, c1, c2, c3, 2); SBAR(); MM2(a0, a1, a2, a3, 0); SBAR();
    LWAIT4(); RD4(a0, a1, a2, a3, 3); SBAR(); MM2(b0, b1, b2, b3, 1); SBAR();
    LWAIT4(); RD4(b0, b1, b2, b3, 4); SBAR(); MM2(c0, c1, c2, c3, 2); SBAR();
    LWAIT4(); RD4(c0, c1, c2, c3, 5); SBAR(); MM2(a0, a1, a2, a3, 3); SBAR();
    LWAIT4(); RD4(a0, a1, a2, a3, 6); SBAR(); MM2(b0, b1, b2, b3, 4); SBAR();
    LWAIT4(); RD4(b0, b1, b2, b3, 7); SBAR(); MM2(c0, c1, c2, c3, 5); SBAR();
    LWAIT4(); MM2(a0, a1, a2, a3, 6); SBAR();
    LWAIT(); MM2(b0, b1, b2, b3, 7);
#undef LWAIT4
#else
    s16x4 a0, a1, a2, a3, b0, b1, b2, b3;
    RD4(a0, a1, a2, a3, 0);
    LWAIT(); RD4(b0, b1, b2, b3, 1); SBAR(); MM2(a0, a1, a2, a3, 0); SBAR();
    LWAIT(); RD4(a0, a1, a2, a3, 2); SBAR(); MM2(b0, b1, b2, b3, 1); SBAR();
    LWAIT(); RD4(b0, b1, b2, b3, 3); SBAR(); MM2(a0, a1, a2, a3, 2); SBAR();
    LWAIT(); RD4(a0, a1, a2, a3, 4); SBAR(); MM2(b0, b1, b2, b3, 3); SBAR();
    LWAIT(); RD4(b0, b1, b2, b3, 5); SBAR(); MM2(a0, a1, a2, a3, 4); SBAR();
    LWAIT(); RD4(a0, a1, a2, a3, 6); SBAR(); MM2(b0, b1, b2, b3, 5); SBAR();
    LWAIT(); RD4(b0, b1, b2, b3, 7); SBAR(); MM2(a0, a1, a2, a3, 6); SBAR();
    LWAIT(); MM2(b0, b1, b2, b3, 7);
#endif
#undef LWAIT
#undef MM2
#undef RD4
#undef TRRD
}

template <int BF, bool LATE>
__device__ __forceinline__ void fullv_tile(f32x16 (&o)[8], float& m_reg, float& l_reg, const bf16x8 (&qr)[8], const char* K_lds, int vcur, int vprev, float* al_l, int t, int qlo, int qm, int r32, int hi,
                                           char* pp_l, unsigned long long (&st)[6]) {
    constexpr float C2 = 1.4426950408889634f * SCALE;
    const char* kb[4];
#pragma unroll
    for (int dd = 0; dd < 4; ++dd) kb[dd] = K_lds + BF * SHM_K + KSWZ(r32, (dd * 16 + hi * 8) * 2);
#pragma unroll
    for (int hf = 0; hf < 2; ++hf) {
        if constexpr (LATE) { const bf16x8 q0 = *(const bf16x8*)pp_l, q1 = *(const bf16x8*)(pp_l + 1024);
            if (hf == 0) pv_half<1>(o, q0, q1, vprev); else pv_half<0>(o, q0, q1, vcur); }
        const int kbase = t * KVBLK + hf * 32;
        if (kbase > qlo + QBLK - 1) { if constexpr (LATE) { *(bf16x8*)pp_l = bf16x8{}; *(bf16x8*)(pp_l + 1024) = bf16x8{}; } continue; }
#if ATTA_STAMP
        const unsigned long long ts0 = __builtin_amdgcn_s_memtime();
#endif
        f32x16 p = f32x16{};
#pragma unroll
        for (int d0 = 0; d0 < 8; ++d0) { const bf16x8 kf = *reinterpret_cast<const bf16x8*>(kb[d0 & 3] + (d0 >> 2) * 128 + hf * (32 * 256));
            p = __builtin_amdgcn_mfma_f32_32x32x16_bf16(kf, qr[d0], p, 0, 0, 0); }
        if (kbase + 31 > qlo) {
            const float NEG = -__builtin_inff(); const int dq = qm - kbase;
#pragma unroll
            for (int r = 0; r < 16; ++r) { const int c = (r & 3) + 8 * (r >> 2); if (dq - c < 0) p[r] = NEG; } }
#if ATTA_STAMP
        asm volatile("" :: "v"(p[0]), "v"(p[15]) : "memory"); const unsigned long long ts1 = __builtin_amdgcn_s_memtime();
#endif
        float pmax = p[0];
#pragma unroll
        for (int r = 1; r < 16; ++r) pmax = fmaxf(pmax, p[r]);
        { auto rr = __builtin_amdgcn_permlane32_swap(__float_as_uint(pmax), __float_as_uint(pmax), false, false); pmax = fmaxf(__uint_as_float(rr[0]), __uint_as_float(rr[1])); }
        float mn = m_reg, alpha = 1.f;
        if (!__builtin_expect(__all((pmax - m_reg) * SCALE <= THR), 1)) { mn = fmaxf(m_reg, pmax); alpha = __builtin_amdgcn_exp2f((m_reg - mn) * C2); m_reg = mn; }
        if (__any(alpha < 1.f)) { if (hi == 0) al_l[r32] = alpha; asm volatile("s_waitcnt lgkmcnt(0)" ::: "memory");
#pragma unroll
            for (int d_ = 0; d_ < 8; ++d_)
#pragma unroll
                for (int r = 0; r < 16; ++r) { const float a_ = al_l[crow(r, hi)]; asm volatile("v_mul_f32 %0, %0, %1" : "+v"(o[d_][r]) : "v"(a_)); } }
        const float mnL = -mn * C2; float ps = 0.f;
#pragma unroll
        for (int r = 0; r < 16; ++r) { p[r] = __builtin_amdgcn_exp2f(fmaf(p[r], C2, mnL)); ps += p[r]; }
        { auto rr = __builtin_amdgcn_permlane32_swap(__float_as_uint(ps), __float_as_uint(ps), false, false); ps = __uint_as_float(rr[0]) + __uint_as_float(rr[1]); }
        l_reg = l_reg * alpha + ps;
        bf16x8 pa0, pa1;
#define PK4(P, B_, OUT) do { unsigned a0 = cvtpk(P[B_+0], P[B_+1]), a1 = cvtpk(P[B_+2], P[B_+3]); unsigned b0 = cvtpk(P[B_+4], P[B_+5]), b1 = cvtpk(P[B_+6], P[B_+7]); \
        auto r0 = __builtin_amdgcn_permlane32_swap(a0, b0, false, false); auto r1 = __builtin_amdgcn_permlane32_swap(a1, b1, false, false); \
        u32x4 w = {r0[0], r1[0], r0[1], r1[1]}; OUT = *reinterpret_cast<bf16x8*>(&w); } while (0)
        PK4(p, 0, pa0); PK4(p, 8, pa1);
#undef PK4
#if ATTA_STAMP
        asm volatile("" :: "v"(pa0), "v"(pa1) : "memory"); const unsigned long long ts2 = __builtin_amdgcn_s_memtime();
#endif
        if constexpr (LATE) { *(bf16x8*)pp_l = pa0; *(bf16x8*)(pp_l + 1024) = pa1; }
        else { if (hf == 0) pv_half<0>(o, pa0, pa1, vcur); else pv_half<1>(o, pa0, pa1, vcur); }
#if ATTA_STAMP
        { const unsigned long long ts3 = __builtin_amdgcn_s_memtime(); st[0] += ts1 - ts0; st[1] += ts2 - ts1; st[2] += ts3 - ts2; }
#endif
    }
}

template <int BF>
__device__ __forceinline__ void fullv_tile64(f32x16 (&o)[8], float& m_reg, float& l_reg, const bf16x8 (&qr)[8], const char* K_lds, int vcur, float* al_l, int t, int qlo, int qm, int r32, int hi) {
    constexpr float C2 = 1.4426950408889634f * SCALE;
    const int kbase = t * KVBLK;
    if (kbase > qlo + QBLK - 1) return;
    const char* kb[4];
#pragma unroll
    for (int dd = 0; dd < 4; ++dd) kb[dd] = K_lds + BF * SHM_K + KSWZ(r32, (dd * 16 + hi * 8) * 2);
    f32x16 p0 = f32x16{}, p1 = f32x16{};
#pragma unroll
    for (int d0 = 0; d0 < 8; ++d0) { const bf16x8 kf0 = *reinterpret_cast<const bf16x8*>(kb[d0 & 3] + (d0 >> 2) * 128), kf1 = *reinterpret_cast<const bf16x8*>(kb[d0 & 3] + (d0 >> 2) * 128 + 32 * 256);
        p0 = __builtin_amdgcn_mfma_f32_32x32x16_bf16(kf0, qr[d0], p0, 0, 0, 0); p1 = __builtin_amdgcn_mfma_f32_32x32x16_bf16(kf1, qr[d0], p1, 0, 0, 0); }
    if (kbase + 63 > qlo) {
        const float NEG = -__builtin_inff(); const int dq = qm - kbase;
#pragma unroll
        for (int r = 0; r < 16; ++r) { const int c = (r & 3) + 8 * (r >> 2); if (dq - c < 0) p0[r] = NEG; if (dq - 32 - c < 0) p1[r] = NEG; } }
    float pmax = fmaxf(p0[0], p1[0]);
#pragma unroll
    for (int r = 1; r < 16; ++r) pmax = fmaxf(pmax, fmaxf(p0[r], p1[r]));
    { auto rr = __builtin_amdgcn_permlane32_swap(__float_as_uint(pmax), __float_as_uint(pmax), false, false); pmax = fmaxf(__uint_as_float(rr[0]), __uint_as_float(rr[1])); }
    float mn = m_reg, alpha = 1.f;
    if (!__builtin_expect(__all((pmax - m_reg) * SCALE <= THR), 1)) { mn = fmaxf(m_reg, pmax); alpha = __builtin_amdgcn_exp2f((m_reg - mn) * C2); m_reg = mn; }
    if (__any(alpha < 1.f)) { if (hi == 0) al_l[r32] = alpha; asm volatile("s_waitcnt lgkmcnt(0)" ::: "memory");
#pragma unroll
        for (int d_ = 0; d_ < 8; ++d_)
#pragma unroll
            for (int r = 0; r < 16; ++r) { const float a_ = al_l[crow(r, hi)]; asm volatile("v_mul_f32 %0, %0, %1" : "+v"(o[d_][r]) : "v"(a_)); } }
    const float mnL = -mn * C2; float ps0 = 0.f, ps1 = 0.f;
#pragma unroll
    for (int r = 0; r < 16; ++r) { p0[r] = __builtin_amdgcn_exp2f(fmaf(p0[r], C2, mnL)); ps0 += p0[r]; p1[r] = __builtin_amdgcn_exp2f(fmaf(p1[r], C2, mnL)); ps1 += p1[r]; }
    float ps = ps0 + ps1;
    { auto rr = __builtin_amdgcn_permlane32_swap(__float_as_uint(ps), __float_as_uint(ps), false, false); ps = __uint_as_float(rr[0]) + __uint_as_float(rr[1]); }
    l_reg = l_reg * alpha + ps;
    bf16x8 pa0, pa1, pa2, pa3;
#define PK4(P, B_, OUT) do { unsigned a0 = cvtpk(P[B_+0], P[B_+1]), a1 = cvtpk(P[B_+2], P[B_+3]); unsigned b0 = cvtpk(P[B_+4], P[B_+5]), b1 = cvtpk(P[B_+6], P[B_+7]); \
        auto r0 = __builtin_amdgcn_permlane32_swap(a0, b0, false, false); auto r1 = __builtin_amdgcn_permlane32_swap(a1, b1, false, false); \
        u32x4 w = {r0[0], r1[0], r0[1], r1[1]}; OUT = *reinterpret_cast<bf16x8*>(&w); } while (0)
    PK4(p0, 0, pa0); PK4(p0, 8, pa1); PK4(p1, 0, pa2); PK4(p1, 8, pa3);
#undef PK4
    pv_half<0>(o, pa0, pa1, vcur); pv_half<1>(o, pa2, pa3, vcur);
}

template <bool LATE_>
__device__ __forceinline__ void causal_fullv_block_impl(const Blk2& cur, char* lds) {
    const int tid = opaque_tid(), wid = __builtin_amdgcn_readfirstlane(tid >> 6), lane = tid & 63, r32 = lane & 31, hi = lane >> 5;
    char* V_lds = lds; char* K_lds = lds + NVB * SHM_V2;
    float* ws = (float*)(lds + 132096) + wid * 64; float* li_l = ws; float* al_l = ws + 32;
    const int NT = (cur.P0 + QB) / KVBLK;
    const int qlo = cur.P0 + wid * QBLK, qm = qlo + r32 - 4 * hi;
    const int vb0 = (int)(uintptr_t)V_lds + v_rd_base(lane);
    unsigned koff[2];
#pragma unroll
    for (int e = 0; e < 2; ++e) { const int rl = 4 * e + (lane >> 4), c = (lane & 15) ^ (rl & 7); koff[e] = (unsigned)((8 * wid + rl) * LDKV + c * 8) * 2u; }
    const int kkl = (lane & 31) >> 2, klane = ((kkl >> 2) << 3) | (kkl & 3);
    const unsigned voff = (unsigned)((klane + 16 * (wid >> 1) + 4 * (wid & 1)) * LDKV + 32 * (lane >> 5) + 8 * (lane & 3)) * 2u;
    typedef __attribute__((address_space(3))) unsigned las_u32;
    las_u32* const lds3 = (las_u32*)lds;
#define GLDS(gp, lo) __builtin_amdgcn_global_load_lds((const unsigned*)(gp), (las_u32*)((__attribute__((address_space(3))) char*)lds3 + (lo)), 16, 0, 0)
#define DMA_TILE(k0, bf, vo) do { const char* kp_ = (const char*)(cur.K + (size_t)(k0) * LDKV); const char* vp_ = (const char*)(cur.V + (size_t)(k0) * LDKV) + voff; \
        GLDS(kp_ + koff[0], NVB * SHM_V2 + (bf) * SHM_K + 2048 * wid); GLDS(kp_ + koff[1], NVB * SHM_V2 + (bf) * SHM_K + 2048 * wid + 1024); \
        GLDS(vp_, (vo) + 2048 * wid); GLDS(vp_ + 128, (vo) + 2048 * wid + 1024); GLDS(vp_ + 256, (vo) + 16384 + 2048 * wid); GLDS(vp_ + 384, (vo) + 16384 + 2048 * wid + 1024); } while (0)
#define DMA_WAIT() asm volatile("s_waitcnt vmcnt(0)" ::: "memory")
    bf16x8 qr[8];
#pragma unroll
    for (int d0 = 0; d0 < 8; ++d0) qr[d0] = load8<bf16>(cur.Q + (size_t)(wid * QBLK + r32) * LDQ + d0 * 16 + hi * 8);
    DMA_TILE(0, 0, 0); DMA_WAIT();
    __syncthreads();
    float m_reg = -1e30f, l_reg = 0.f; f32x16 o[8];
#pragma unroll
    for (int d_ = 0; d_ < 8; ++d_) o[d_] = f32x16{};
    constexpr bool late = LATE_;
    char* pp_l = lds + 134144 + (ATTA_LATE_ODD ? (wid >> 1) : (wid & 3)) * 2048 + lane * 16;
    if (late) { *(bf16x8*)pp_l = bf16x8{}; *(bf16x8*)(pp_l + 1024) = bf16x8{}; }
    unsigned long long st[6] = {0, 0, 0, 0, 0, 0};
#if ATTA_STAMP
    const unsigned long long tb0 = __builtin_amdgcn_s_memtime();
#endif
    int vo_p = 0, vo_c = 0;
    if (!ATTA_PINGPONG && ATTA_PRIO == 1 && wid >= 4) __builtin_amdgcn_s_setprio(1);
#define NEXT_VO(v) ((v) == (NVB - 1) * SHM_V2 ? 0 : (v) + SHM_V2)
    for (int t = 0; t < NT; t += 2) {
        const int vo_n = NEXT_VO(vo_c), vo_nn = NEXT_VO(vo_n);
        DMA_TILE((t + 1) * KVBLK, 1, vo_n);
#if ATTA_T64
        fullv_tile64<0>(o, m_reg, l_reg, qr, K_lds, vb0 + vo_c, al_l, t, qlo, qm, r32, hi);
#else
        fullv_tile<0, LATE_>(o, m_reg, l_reg, qr, K_lds, vb0 + vo_c, vb0 + vo_p, al_l, t, qlo, qm, r32, hi, pp_l, st);
#endif
#if ATTA_STAMP
        { const unsigned long long tw0 = __builtin_amdgcn_s_memtime(); DMA_WAIT(); const unsigned long long tw1 = __builtin_amdgcn_s_memtime(); __syncthreads(); const unsigned long long tw2 = __builtin_amdgcn_s_memtime(); st[3] += tw1 - tw0; st[5] += tw2 - tw1; }
#else
        DMA_WAIT();
        __syncthreads();
#endif
        if (t + 2 < NT) DMA_TILE((t + 2) * KVBLK, 0, vo_nn);
#if ATTA_T64
        fullv_tile64<1>(o, m_reg, l_reg, qr, K_lds, vb0 + vo_n, al_l, t + 1, qlo, qm, r32, hi);
#else
        fullv_tile<1, LATE_>(o, m_reg, l_reg, qr, K_lds, vb0 + vo_n, vb0 + vo_c, al_l, t + 1, qlo, qm, r32, hi, pp_l, st);
#endif
#if ATTA_STAMP
        { const unsigned long long tw0 = __builtin_amdgcn_s_memtime(); DMA_WAIT(); const unsigned long long tw1 = __builtin_amdgcn_s_memtime(); __syncthreads(); const unsigned long long tw2 = __builtin_amdgcn_s_memtime(); st[3] += tw1 - tw0; st[5] += tw2 - tw1; }
#else
        DMA_WAIT();
        __syncthreads();
#endif
        vo_p = vo_n; vo_c = vo_nn;
    }
    if (late) { const bf16x8 q0 = *(const bf16x8*)pp_l, q1 = *(const bf16x8*)(pp_l + 1024); pv_half<1>(o, q0, q1, vb0 + vo_p); }
#undef NEXT_VO
#undef DMA_TILE
#undef DMA_WAIT
#undef GLDS
#undef NEXT_VO
    __builtin_amdgcn_s_setprio(0);
#if ATTA_STAMP
    if (blockIdx.x == 0 && wid == ATTA_STAMP_WAVE && lane == 0) { atomicAdd(cur.stamp + 0, st[0]); atomicAdd(cur.stamp + 1, st[1]); atomicAdd(cur.stamp + 2, st[2]); atomicAdd(cur.stamp + 3, st[3]); atomicAdd(cur.stamp + 5, st[5]); atomicAdd(cur.stamp + 4, __builtin_amdgcn_s_memtime() - tb0); }
#endif
    if (ATTA_PINGPONG) __syncthreads();
    if (hi == 0) li_l[r32] = l_reg; asm volatile("s_waitcnt lgkmcnt(0)" ::: "memory");
    char* stg = lds + wid * 16384;
#pragma unroll
    for (int r = 0; r < 16; ++r) { const float rl = __builtin_amdgcn_rcpf(li_l[crow(r, hi)]); const int orow = crow(r, hi);
#pragma unroll
        for (int d0 = 0; d0 < 8; ++d0) { const float v = o[d0][r] * rl; *(unsigned short*)(stg + orow * 512 + (d0 * 32 + r32) * 2) = (unsigned short)cvtpk(v, v); } }
    asm volatile("s_waitcnt lgkmcnt(0)" ::: "memory");
    bf16* Ow = cur.O + (size_t)(wid * QBLK) * LDO;
#pragma unroll
    for (int i = 0; i < 16; ++i) { const int row = 2 * i + (lane >> 5), ch = lane & 31;
        const u32x4 v = *(const u32x4*)(stg + row * 512 + ch * 16); store16_wt(Ow + (size_t)row * LDO + ch * 8, v); }
    __syncthreads();
}
__device__ __forceinline__ void causal_fullv_block(const Blk2& cur, char* lds) {
    const int wid_ = __builtin_amdgcn_readfirstlane(opaque_tid() >> 6);
    if (ATTA_PINGPONG && (ATTA_LATE_ODD ? (wid_ & 1) != 0 : wid_ >= ATTA_LATE_FROM)) causal_fullv_block_impl<true>(cur, lds); else causal_fullv_block_impl<false>(cur, lds);
}
#undef KSWZ
#undef SBAR
}

namespace attB {
typedef short bf16x8 __attribute__((ext_vector_type(8)));
typedef short s16x4 __attribute__((ext_vector_type(4)));
typedef float f32x16 __attribute__((ext_vector_type(16)));
typedef unsigned u32x4 __attribute__((ext_vector_type(4)));
typedef unsigned short bf16_t;
constexpr int HD = 64, LD = NQKV_B, KOFF = 2048, VOFF = 2304, LDO = DM;
constexpr int LDS_K = 0, LDS_V = 32768, LDS_S = 65536, LDS_O = 69632, LDS_BYTES = LDS_O + 8 * 4096;
constexpr float C2 = 0.125f * 1.4426950408889634f;
__device__ __forceinline__ int crow(int r, int hi) { return (r & 3) + 8 * (r >> 2) + 4 * hi; }
__device__ __forceinline__ unsigned cvtpk(float lo, float hi) { unsigned r; asm volatile("v_cvt_pk_bf16_f32 %0, %1, %2" : "=v"(r) : "v"(lo), "v"(hi)); return r; }
typedef short v4i16_t __attribute__((ext_vector_type(4)));
__device__ __forceinline__ s16x4 vtr(LAS const unsigned char* p) { return __builtin_bit_cast(s16x4, __builtin_amdgcn_ds_read_tr16_b64_v4i16((LAS v4i16_t*)p)); }

__device__ __forceinline__ void swa_unit(int b, int kvh, int n, const bf16_t* __restrict__ QKV, const float* __restrict__ sinks, bf16_t* __restrict__ O, LAS unsigned char* lds) {
    const int tid = opaque_tid(), lane = tid & 63, r32 = lane & 31, hi = lane >> 5, wid = __builtin_amdgcn_readfirstlane(tid >> 6);
    __syncthreads();
    const size_t tok0 = (size_t)b * SEQ;
#pragma unroll
    for (int i = 0; i < 4; ++i) {
        const int c = tid + 512 * i, row = c >> 3, ch = c & 7, t = n * 128 - 128 + row;
        u32x4 kv = {0u, 0u, 0u, 0u}, vv = {0u, 0u, 0u, 0u};
        if (t >= 0) { const bf16_t* p = QKV + (tok0 + (size_t)t) * LD + kvh * HD + ch * 8; kv = *(const u32x4*)(p + KOFF); vv = *(const u32x4*)(p + VOFF); }
        *(LAS u32x4*)(lds + LDS_K + row * 128 + ((ch ^ ((row >> 1) & 7)) << 4)) = kv;
        *(LAS u32x4*)(lds + LDS_V + row * 128 + (ch << 4)) = vv;
    }
    __syncthreads();
    const int hq = kvh * 8 + wid;
    const float sink2 = sinks[hq] * 1.4426950408889634f;
    LAS float* scr = (LAS float*)(lds + LDS_S) + wid * 32;
    const int vq = (lane & 15) >> 2, vp = lane & 3, vg1 = (lane >> 4) & 1;
    LAS const unsigned char* vbase = lds + LDS_V + (4 * hi + vq) * 128 + (16 * vg1 + 4 * vp) * 2;
    const float NEG = -__builtin_inff();
    for (int qs = 0; qs < 4; ++qs) {
        const size_t tq = tok0 + (size_t)(n * 128 + 32 * qs + r32);
        bf16x8 qr[4];
#pragma unroll
        for (int d0 = 0; d0 < 4; ++d0) qr[d0] = *(const bf16x8*)(QKV + tq * LD + hq * HD + d0 * 16 + hi * 8);
        f32x16 p[5];
#pragma unroll
        for (int tt = 0; tt < 5; ++tt) {
            const int kt = qs + tt; const bool dead = (n == 0) && (kt < 4);
            p[tt] = f32x16{};
            if (!dead) { const int krow = kt * 32 + r32;
#pragma unroll
                for (int d0 = 0; d0 < 4; ++d0) { const bf16x8 kf = *(LAS const bf16x8*)(lds + LDS_K + krow * 128 + (((d0 * 2 + hi) ^ ((krow >> 1) & 7)) << 4));
                    p[tt] = __builtin_amdgcn_mfma_f32_32x32x16_bf16(kf, qr[d0], p[tt], 0, 0, 0); } }
#pragma unroll
            for (int r = 0; r < 16; ++r) { const int c = crow(r, hi); bool valid = !dead;
                if (tt == 0) valid = valid && (c > r32);
                if (tt == 4) valid = valid && (c <= r32);
                p[tt][r] = valid ? p[tt][r] * C2 : NEG; }
        }
        float mx = sink2;
#pragma unroll
        for (int tt = 0; tt < 5; ++tt)
#pragma unroll
            for (int r = 0; r < 16; ++r) mx = fmaxf(mx, p[tt][r]);
        mx = half_max32(mx);
        float sum = 0.f;
#pragma unroll
        for (int tt = 0; tt < 5; ++tt)
#pragma unroll
            for (int r = 0; r < 16; ++r) { const float e = __builtin_amdgcn_exp2f(p[tt][r] - mx); p[tt][r] = e; sum += e; }
        sum = half_sum32(sum);
        sum += __builtin_amdgcn_exp2f(sink2 - mx);
        if (hi == 0) scr[r32] = 1.0f / sum;
        f32x16 o[2]; o[0] = f32x16{}; o[1] = f32x16{};
#pragma unroll
        for (int tt = 0; tt < 5; ++tt) {
            const int kt = qs + tt; const bool dead = (n == 0) && (kt < 4);
            if (!dead) {
#pragma unroll
                for (int s = 0; s < 2; ++s) {
                    u32x4 w; w.x = cvtpk(p[tt][8 * s + 0], p[tt][8 * s + 1]); w.y = cvtpk(p[tt][8 * s + 2], p[tt][8 * s + 3]); w.z = cvtpk(p[tt][8 * s + 4], p[tt][8 * s + 5]); w.w = cvtpk(p[tt][8 * s + 6], p[tt][8 * s + 7]);
                    const bf16x8 pa = __builtin_bit_cast(bf16x8, w);
#pragma unroll
                    for (int d0 = 0; d0 < 2; ++d0) { LAS const unsigned char* vp_ = vbase + (kt * 32 + 16 * s) * 128 + d0 * 64;
                        const s16x4 lo = vtr(vp_), hh = vtr(vp_ + 8 * 128);
                        const bf16x8 vf = {lo[0], lo[1], lo[2], lo[3], hh[0], hh[1], hh[2], hh[3]};
                        o[d0] = __builtin_amdgcn_mfma_f32_32x32x16_bf16(pa, vf, o[d0], 0, 0, 0); }
                }
            }
        }
        bf16_t* Ow = O + (tok0 + (size_t)(n * 128 + 32 * qs)) * LDO + hq * HD;
        LAS unsigned char* stg = lds + LDS_O + wid * 4096;
#pragma unroll
        for (int r = 0; r < 16; ++r) { const int orow = crow(r, hi); const float ri = scr[orow];
#pragma unroll
            for (int d0 = 0; d0 < 2; ++d0) { const float v = o[d0][r] * ri; *(LAS unsigned short*)(stg + orow * 128 + (d0 * 32 + r32) * 2) = (unsigned short)cvtpk(v, v); } }
        asm volatile("s_waitcnt lgkmcnt(0)" ::: "memory");
#pragma unroll
        for (int i = 0; i < 4; ++i) { const int row = 8 * i + (lane >> 3), ch = lane & 7;
            const u32x4 v = *(LAS const u32x4*)(stg + row * 128 + ch * 16); store16_wt(Ow + (size_t)row * LDO + ch * 8, v); }
    }
}
}

constexpr int NWAVES = 8;
#ifndef MK_PER_PHASE
#define MK_PER_PHASE 0
#endif
constexpr int N_PHASES = 3 + 8 * DEPTH;

constexpr size_t MiB = 1u << 20;
constexpr size_t WS_CTL = 0, CTL_ZERO_BYTES = 1 * MiB;
constexpr size_t WS_STATS = 1198 * MiB;
constexpr size_t WS_MOD = 2 * MiB;
constexpr size_t WS_TABA = 3 * MiB;
constexpr size_t WS_TABB = 5 * MiB;
constexpr size_t WS_BPERM = 6 * MiB;
constexpr size_t WS_WUP = 8 * MiB, WS_WDN = 40 * MiB, WS_WMLP_STRIDE = 64 * MiB;
constexpr size_t WS_WQKVA = 264 * MiB, WS_WOA = 288 * MiB, WS_WA_STRIDE = 32 * MiB;
constexpr size_t WS_WQKVB = 328 * MiB, WS_WOB = 338 * MiB, WS_WB_STRIDE = 18 * MiB;
constexpr size_t WS_X = 364 * MiB;
constexpr size_t WS_HB = 492 * MiB;
constexpr size_t WS_QKV = 556 * MiB;
constexpr size_t WS_AO = 748 * MiB;
constexpr size_t WS_AC = 876 * MiB;
constexpr size_t WS_HID = 940 * MiB;
constexpr size_t WS_CS = 1196 * MiB, WS_CB = 1197 * MiB;
constexpr size_t WS_GN = 6 * MiB + 64 * 1024;
constexpr int CSTRIDE = 8192;
constexpr size_t WS_ZEROS = 768 * 1024;
constexpr size_t WS_ONES = 6 * MiB + 32 * 1024;
constexpr size_t WS_IDENT = 6 * MiB + 48 * 1024;
constexpr size_t WS_IG = 6 * MiB + 640 * 1024;
constexpr size_t WS_NEUTRAL = 1 * MiB;
constexpr size_t WS_PROBE = 7 * MiB;
constexpr size_t WS_QKVB = 1206 * MiB;
constexpr size_t WS_END = 1286 * MiB;
constexpr int CW_TMO = 0, CW_CODE = 1, CW_BAR = 4096;
constexpr int CW_PSUB = 16384, CW_PGEN = 20480;
constexpr int CW_XMASK = 8192, CW_LSUB = 8192 + 1024, CW_LGEN = 8192 + 2048;

constexpr int RING_OFF = 0, RING_BYTES = 131072;
constexpr int LDSCTL_OFF = RING_BYTES, MISC_OFF = LDSCTL_OFF + 320, STATTBL_OFF = LDSCTL_OFF + 1024;
constexpr int LDS_BYTES = 147456;
static_assert(attA::LDS_BYTES <= RING_BYTES && attA::LDS2_BYTES <= RING_BYTES && attB::LDS_BYTES <= RING_BYTES, "attention scratch fits the ring region");

struct Frame {
    LAS unsigned char* lds;
    volatile LAS unsigned* MISC;
    gu32* ctl;
    int vcu, G;
};
#define FR_IDS() const int f_tid = opaque_tid(), f_lane = f_tid & 63, f_wave = __builtin_amdgcn_readfirstlane(f_tid >> 6); (void)f_tid; (void)f_lane; (void)f_wave

__device__ __forceinline__ float wave_sum(float v) {
    v += lane_xor<1>(v); v += lane_xor<2>(v); v += lane_xor<4>(v); v += lane_xor<8>(v); v += lane_xor<16>(v);
    return half_sum32(v);
}
__device__ __forceinline__ float bf2f(unsigned short u) { return __uint_as_float((unsigned)u << 16); }

__device__ __forceinline__ int dest_row(int n, int mode) {
    if (mode == 1 && n < 4096) { const int j = n & 127; return (n & ~127) + (((j & 63) << 1) | (j >> 6)); }
    if (mode == 2 && n < 2304) { const int j = n & 63; return (n & ~63) + (((j & 31) << 1) | (j >> 5)); }
    return n;
}
struct ConvDesc { bf16* dst; int K, mode, n0, k0; };
__device__ __forceinline__ int kpos(int k, int mode) { return mode == 3 ? ((k & ~255) | (((((k >> 5) & 3) << 1) | ((k >> 7) & 1)) << 5) | (k & 31)) : k; }
#ifndef CONV_SHAPE
#define CONV_SHAPE 0
#endif
#if CONV_SHAPE == 0
__device__ __forceinline__ void conv_issue(const float* W, int K, int N, bf16* WT, int mode, int item, int lane, ConvDesc& D, float (&wv)[32]) {
    const int nblk = N / 32, kb = item / nblk, nb = item % nblk, k0 = 64 * kb, n0 = 32 * nb;
    const float* p = W + (size_t)(k0 + (lane >> 5)) * N + n0 + (lane & 31);
#pragma unroll
    for (int i = 0; i < 32; ++i) wv[i] = p[(size_t)(2 * i) * N];
    D.dst = WT; D.K = K; D.mode = mode; D.n0 = n0; D.k0 = k0;
}
__device__ __forceinline__ void conv_finish(const ConvDesc& D, const float (&wv)[32], LAS float* scr, int lane) {
#pragma unroll
    for (int i = 0; i < 32; ++i) { const int kk = 2 * i + (lane >> 5); scr[kk * 33 + (lane & 31)] = wv[i]; }
    LDS_WAIT(); asm volatile("" ::: "memory");
    const int c = lane & 7;
#pragma unroll
    for (int j = 0; j < 4; ++j) { const int n = (lane >> 3) + 8 * j; const LAS float* s = scr + (8 * c) * 33 + n;
        v4u o; o.x = pk2(s[0 * 33], s[1 * 33]); o.y = pk2(s[2 * 33], s[3 * 33]); o.z = pk2(s[4 * 33], s[5 * 33]); o.w = pk2(s[6 * 33], s[7 * 33]);
        *(GAS v4u*)(D.dst + (size_t)dest_row(D.n0 + n, D.mode) * D.K + kpos(D.k0 + 8 * c, D.mode)) = o; }
    LDS_WAIT(); asm volatile("" ::: "memory");
}
#else
__device__ __forceinline__ void conv_issue(const float* W, int K, int N, bf16* WT, int mode, int item, int lane, ConvDesc& D, float (&wv)[32]) {
    const int nblk = N / 64, kb = item / nblk, nb = item % nblk, k0 = 32 * kb, n0 = 64 * nb;
    const float* p = W + (size_t)k0 * N + n0 + lane;
#pragma unroll
    for (int i = 0; i < 32; ++i) wv[i] = p[(size_t)i * N];
    D.dst = WT; D.K = K; D.mode = mode; D.n0 = n0; D.k0 = k0;
}
__device__ __forceinline__ void conv_finish(const ConvDesc& D, const float (&wv)[32], LAS float* scr, int lane) {
#pragma unroll
    for (int i = 0; i < 32; ++i) scr[i * 65 + lane] = wv[i];
    LDS_WAIT(); asm volatile("" ::: "memory");
    const int c = lane & 3;
#pragma unroll
    for (int j = 0; j < 4; ++j) { const int n = (lane >> 2) + 16 * j; const LAS float* s = scr + (8 * c) * 65 + n;
        v4u o; o.x = pk2(s[0 * 65], s[1 * 65]); o.y = pk2(s[2 * 65], s[3 * 65]); o.z = pk2(s[4 * 65], s[5 * 65]); o.w = pk2(s[6 * 65], s[7 * 65]);
        *(GAS v4u*)(D.dst + (size_t)dest_row(D.n0 + n, D.mode) * D.K + kpos(D.k0 + 8 * c, D.mode)) = o; }
    LDS_WAIT(); asm volatile("" ::: "memory");
}
#endif
__device__ __forceinline__ void sincos_d(double x, double& sn, double& cs) {
    const double k = __builtin_rint(x * 0.63661977236758134308);
    double r = __builtin_fma(-k, 1.57079632673412561417e+00, x); r = __builtin_fma(-k, 6.07710050650619224932e-11, r);
    const double r2 = r * r;
    double ps = -1.0 / 1307674368000.0; ps = ps * r2 + 1.0 / 6227020800.0; ps = ps * r2 - 1.0 / 39916800.0; ps = ps * r2 + 1.0 / 362880.0; ps = ps * r2 - 1.0 / 5040.0; ps = ps * r2 + 1.0 / 120.0; ps = ps * r2 - 1.0 / 6.0; ps = ps * r2 * r + r;
    double pc = 1.0 / 20922789888000.0; pc = pc * r2 - 1.0 / 87178291200.0; pc = pc * r2 + 1.0 / 479001600.0; pc = pc * r2 - 1.0 / 3628800.0; pc = pc * r2 + 1.0 / 40320.0; pc = pc * r2 - 1.0 / 720.0; pc = pc * r2 + 1.0 / 24.0; pc = pc * r2 - 0.5; pc = pc * r2 + 1.0;
    const int q = (int)k & 3;
    sn = (q == 0) ? ps : (q == 1) ? pc : (q == 2) ? -ps : -pc;
    cs = (q == 0) ? pc : (q == 1) ? -ps : (q == 2) ? -pc : ps;
}
__device__ __forceinline__ void rope_entry(float* tab, int idx, int half, double base_ratio) {
    const int s = idx / half, j = idx % half;
    double inv = 1.0, rr = base_ratio;
    for (int t = j; t; t >>= 1) { if (t & 1) inv *= rr; rr *= rr; }
    const float invf = (float)inv, angf = (float)s * invf;
    double sn, cs; sincos_d((double)angf, sn, cs);
    tab[2 * (size_t)idx] = (float)cs; tab[2 * (size_t)idx + 1] = (float)sn;
}

struct Args { const float* in[22]; float* out; unsigned char* ws; int ph_lo, ph_hi; };
typedef __attribute__((address_space(4))) const Args CArgs;

constexpr int CONV_ITEMS = 4 * 16384 + 2 * 8192 + 2 * 4608;
constexpr int CONV_NOW = 16384 + 8192 + 4608;
constexpr int CONV_LATER = CONV_ITEMS - CONV_NOW;
__device__ __forceinline__ int now_item(int d) { return d < 16384 ? d : d < 24576 ? 65536 + (d - 16384) : 81920 + (d - 24576); }
__device__ __forceinline__ void convert_issue(CArgs* ap, int it, int lane, ConvDesc& D, float (&wv)[32]) {
    unsigned char* ws = ap->ws;
    int r = it; const float* W; bf16* WT; int K, N, mode = 0, item;
    if (r < 65536) { const int L = r >> 14, rr = r & 16383;
        if (rr < 8192) { W = ap->in[8] + (size_t)L * DM * DFF; K = DM; N = DFF; WT = (bf16*)(ws + WS_WUP + L * WS_WMLP_STRIDE); item = rr; }
        else { W = ap->in[9] + (size_t)L * DFF * DM; K = DFF; N = DM; WT = (bf16*)(ws + WS_WDN + L * WS_WMLP_STRIDE); item = rr - 8192; mode = HID_PERM ? 3 : 0; } }
    else { r -= 65536;
        if (r < 16384) { const int j = r >> 13, rr = r & 8191;
            if (rr < 6144) { W = ap->in[10] + (size_t)j * DM * NQKV_A; K = DM; N = NQKV_A; WT = (bf16*)(ws + WS_WQKVA + j * WS_WA_STRIDE); mode = 1; item = rr; }
            else { W = ap->in[11] + (size_t)j * DM * DM; K = DM; N = DM; WT = (bf16*)(ws + WS_WOA + j * WS_WA_STRIDE); item = rr - 6144; } }
        else { r -= 16384; const int j = r / 4608, rr = r % 4608;
            if (rr < 2560) { W = ap->in[17] + (size_t)j * DM * NQKV_B; K = DM; N = NQKV_B; WT = (bf16*)(ws + WS_WQKVB + j * WS_WB_STRIDE); mode = 2; item = rr; }
            else { W = ap->in[20] + (size_t)j * DM * DM; K = DM; N = DM; WT = (bf16*)(ws + WS_WOB + j * WS_WB_STRIDE); item = rr - 2560; } } }
    conv_issue(W, K, N, WT, mode, item, lane, D, wv);
}
__device__ __forceinline__ void convert_item(CArgs* ap, int it, LAS float* scr, int lane) {
    ConvDesc D; float wv[32]; convert_issue(ap, it, lane, D, wv); conv_finish(D, wv, scr, lane);
}
#ifndef CONV_NCH
#define CONV_NCH 4
#endif
constexpr int CONV_CHUNKS = CONV_NCH;
__device__ __forceinline__ int deferred_item(int d) { return d < 49152 ? 16384 + d : d < 57344 ? 73728 + (d - 49152) : 86528 + (d - 57344); }
__device__ __forceinline__ void convert_chunk(CArgs* ap, char* ring, int q) {
    FR_IDS();
#if CONV_PROBE
    if (f_tid == 0) *(unsigned long long*)(ring + 140000) = __builtin_amdgcn_s_memrealtime();
#endif
    LAS float* scr = (LAS float*)(ring + f_wave * 16384);
    const int gw = (int)blockIdx.x * NWAVES + f_wave, NGW = (int)gridDim.x * NWAVES;
    constexpr int PER = (CONV_LATER + 2048 * CONV_CHUNKS - 1) / (2048 * CONV_CHUNKS);
    const int per = (NGW == 2048) ? PER : (CONV_LATER + NGW * CONV_CHUNKS - 1) / (NGW * CONV_CHUNKS);
    const int d0 = gw + NGW * (q * per);
    ConvDesc da, db; float va[32], vb[32];
    bool ha = d0 < CONV_LATER, hb = false;
    if (ha) convert_issue(ap, deferred_item(d0), f_lane, da, va);
    for (int jj = 0; jj < per; jj += 2) {
        const int d1 = d0 + NGW * (jj + 1), d2 = d0 + NGW * (jj + 2);
        hb = (jj + 1 < per) && d1 < CONV_LATER;
        if (hb) convert_issue(ap, deferred_item(d1), f_lane, db, vb);
        if (ha) conv_finish(da, va, scr, f_lane);
        ha = (jj + 2 < per) && d2 < CONV_LATER;
        if (ha) convert_issue(ap, deferred_item(d2), f_lane, da, va);
        if (hb) conv_finish(db, vb, scr, f_lane);
    }
    __syncthreads();
#if CONV_PROBE
    if (blockIdx.x == PROBE_WG && f_tid == 0) atomicAdd((unsigned long long*)(ap->ws + 512 * 1024 + 64), __builtin_amdgcn_s_memrealtime() - *(unsigned long long*)(ring + 140000));
#endif
}
__device__ __forceinline__ void p0_prologue(Frame& F, CArgs* ap) {
    FR_IDS();
    unsigned char* ws = ap->ws;
    {
        LAS float* cact = (LAS float*)F.lds;
        LAS float* part = (LAS float*)(F.lds + 32768);
        const float* cin = ap->in[1];
        for (int i = f_tid; i < NB * DM; i += NWAVES * 64) { const float c = cin[i]; cact[i] = c / (1.0f + expf(-c)); }
        __syncthreads();
        float* mod = (float*)(ws + WS_MOD);
        for (int it = F.vcu; it < 256; it += F.G) {
            const int L = it >> 6, cb = it & 63;
            if (f_lane < 48) {
                const float* Wp = ap->in[2] + ((size_t)L * DM + 256 * f_wave) * (NMOD * DM) + 192 * cb + 4 * f_lane;
                f32x4 a0 = {0.f, 0.f, 0.f, 0.f}, a1 = a0, a2 = a0, a3 = a0;
#pragma unroll 8
                for (int kk = 0; kk < 256; ++kk) { const f32x4 w = *(const f32x4*)(Wp + (size_t)kk * (NMOD * DM)); const int k = 256 * f_wave + kk;
                    a0 += w * cact[k]; a1 += w * cact[DM + k]; a2 += w * cact[2 * DM + k]; a3 += w * cact[3 * DM + k]; }
                LAS f32x4* pp = (LAS f32x4*)(part + (f_wave * NB) * 192) + f_lane;
                pp[0] = a0; pp[48] = a1; pp[96] = a2; pp[144] = a3;
            }
            __syncthreads();
            for (int o = f_tid; o < NB * 192; o += NWAVES * 64) { const int b = o / 192, cc = o % 192; float s = 0.f;
#pragma unroll
                for (int w = 0; w < 8; ++w) s += part[(w * NB + b) * 192 + cc];
                mod[((size_t)L * NB + b) * (NMOD * DM) + 192 * cb + cc] = s + ap->in[3][(size_t)L * (NMOD * DM) + 192 * cb + cc]; }
            __syncthreads();
        }
    }
    {
        LAS float* scr = (LAS float*)(F.lds + RING_OFF + f_wave * 16384);
        const int gw = F.vcu * NWAVES + f_wave, NGW = F.G * NWAVES;
#if CONV_DEFER
        for (int d = gw; d < CONV_NOW; d += NGW) convert_item(ap, now_item(d), scr, f_lane);
#else
        for (int d = gw; d < CONV_ITEMS; d += NGW) convert_item(ap, d, scr, f_lane);
#endif
    }
    {
        const int gt = F.vcu * (NWAVES * 64) + f_tid, NGT = F.G * NWAVES * 64;
        float* tabA = (float*)(ws + WS_TABA); float* tabB = (float*)(ws + WS_TABB);
        for (int idx = gt; idx < SEQ * 64; idx += NGT) rope_entry(tabA, idx, 64, 0.86596432336006535);
        for (int idx = gt; idx < SEQ * 32; idx += NGT) rope_entry(tabB, idx, 32, 0.74989420933245582);
        for (int idx = gt; idx < DM; idx += NGT) ((float*)(ws + WS_ONES))[idx] = 1.0f;
        if (gt < 8) ((float*)(ws + WS_IDENT))[gt] = (gt & 1) ? 0.f : 1.f;
        for (int idx = gt; idx < MTOK * 16; idx += NGT) ((float*)(ws + WS_NEUTRAL))[idx] = ((idx & 15) == 1) ? 2048.0f * (1.0f - LN_EPS) : 0.f;
        float* bp = (float*)(ws + WS_BPERM);
        for (int idx = gt; idx < 2 * NQKV_B; idx += NGT) { const int j = idx / NQKV_B, n = idx % NQKV_B;
            int src = n; if (n < 2304) { const int p = n & 63; src = (n & ~63) + (p >> 1) + 32 * (p & 1); }
            bp[idx] = ap->in[18][(size_t)j * NQKV_B + src]; }
    }
}
__device__ __forceinline__ void h0_phase(Frame& F, const float* x, const float* sc, const float* sh, bf16* hb, bf16* xb) {
    FR_IDS();
    const int m0 = 256 * (8 * ((int)blockIdx.x & 7) + (((int)blockIdx.x >> 3) & 7)) + ((int)blockIdx.x >> 6) * 64 + f_wave * 8;
    for (int m = m0; m < m0 + 8; ++m) {
        const int b = m / SEQ;
        const GAS f32x4* xr = (const GAS f32x4*)(x + (size_t)m * DM) + f_lane;
        const f32x4* scp = (const f32x4*)(sc + (size_t)b * (NMOD * DM)) + f_lane; const f32x4* shp = (const f32x4*)(sh + (size_t)b * (NMOD * DM)) + f_lane;
        GAS unsigned long long* o8 = (GAS unsigned long long*)(hb + (size_t)m * DM) + f_lane; GAS unsigned long long* x8 = (GAS unsigned long long*)(xb + (size_t)m * DM) + f_lane;
#pragma unroll
        for (int j = 0; j < 8; ++j) { const f32x4 xv = xr[64 * j]; const f32x4 v = xv * (scp[64 * j] + 1.0f) + shp[64 * j];
            o8[64 * j] = (unsigned long long)pk2(v.x, v.y) | ((unsigned long long)pk2(v.z, v.w) << 32);
            x8[64 * j] = (unsigned long long)pk2(xv.x, xv.y) | ((unsigned long long)pk2(xv.z, xv.w) << 32); }
    }
}
__device__ __forceinline__ void final_ln_phase(Frame& F, const float* vin, const float* st, float* xout, const float* g, const float* bln) {
    FR_IDS();
    const int m0 = 256 * (8 * ((int)blockIdx.x & 7) + (((int)blockIdx.x >> 3) & 7)) + ((int)blockIdx.x >> 6) * 64 + f_wave * 8;
    for (int m = m0; m < m0 + 8; ++m) {
        float mu, r; pg8::row_mu_r(st, m, mu, r);
        const GAS f32x4* xr = (const GAS f32x4*)(vin + (size_t)m * DM) + f_lane;
        const f32x4* gp = (const f32x4*)g + f_lane; const f32x4* bp = (const f32x4*)bln + f_lane;
        GAS f32x4* xo = (GAS f32x4*)(xout + (size_t)m * DM) + f_lane;
#pragma unroll
        for (int j = 0; j < 8; ++j) xo[64 * j] = (xr[64 * j] - mu) * r * gp[64 * j] + bp[64 * j];
    }
}
__device__ __forceinline__ void fold_phase(Frame& F, CArgs* ap, int s_lo, int s_hi, bool gn) {
    FR_IDS();
    unsigned char* ws = ap->ws;
    LAS float* GL = (LAS float*)F.lds;
    const float* mod = (const float*)(ws + WS_MOD);
    for (int s = 0; s < 7; ++s) {
        const bool do_c = s >= s_lo && s < s_hi, do_g = gn && F.vcu == s;
        if (!do_c && !do_g) continue;
        const int L = s >> 1, odd = s & 1, Lc = L + odd;
        const float* g = (odd ? ap->in[6] : ap->in[4]) + (size_t)L * DM; const float* bl = (odd ? ap->in[7] : ap->in[5]) + (size_t)L * DM;
        const float* mc = mod + (size_t)Lc * NB * NMOD * DM + (odd ? 0 : 3 * DM);
        __syncthreads();
        {
            const int k = 4 * f_tid;
            const f32x4 gv = *(const f32x4*)(g + k), blv = *(const f32x4*)(bl + k);
            f32x4 scv[NB], shv[NB];
#pragma unroll
            for (int b = 0; b < NB; ++b) { scv[b] = *(const f32x4*)(mc + (size_t)b * NMOD * DM + DM + k) + 1.0f; shv[b] = *(const f32x4*)(mc + (size_t)b * NMOD * DM + k); }
#pragma unroll
            for (int b = 0; b < NB; ++b) { const f32x4 G = gv * scv[b];
                *(LAS f32x4*)(GL + b * DM + k) = G; *(LAS f32x4*)(GL + (4 + b) * DM + k) = blv * scv[b] + shv[b];
                if (do_g) { *(f32x4*)((float*)(ws + WS_GN) + ((size_t)s * NB + b) * DM + k) = G;
                    *(f32x4*)((float*)(ws + WS_IG) + ((size_t)s * NB + b) * DM + k) = (f32x4){1.0f / scv[b][0], 1.0f / scv[b][1], 1.0f / scv[b][2], 1.0f / scv[b][3]}; } }
        }
        __syncthreads();
        if (!do_c) continue;
        const bf16* Wt; int N;
        if (!odd) { Wt = (const bf16*)(ws + WS_WUP + Lc * WS_WMLP_STRIDE); N = DFF; }
        else if (Lc & 1) { Wt = (const bf16*)(ws + WS_WQKVB + (Lc >> 1) * WS_WB_STRIDE); N = NQKV_B; }
        else { Wt = (const bf16*)(ws + WS_WQKVA + (Lc >> 1) * WS_WA_STRIDE); N = NQKV_A; }
        float* cs = (float*)(ws + WS_CS) + (size_t)s * NB * CSTRIDE; float* cb = (float*)(ws + WS_CB) + (size_t)s * NB * CSTRIDE;
        const int n0 = F.vcu * NWAVES + f_wave, NGW = F.G * NWAVES;
        for (int nb = n0; nb < N; nb += 4 * NGW) {
            v4u wv[4][4];
#pragma unroll
            for (int j = 0; j < 4; ++j) { const int n = nb + j * NGW < N ? nb + j * NGW : nb;
#pragma unroll
                for (int i = 0; i < 4; ++i) wv[j][i] = *(const GAS v4u*)(Wt + (size_t)n * DM + 8 * (f_lane + 64 * i)); }
#pragma unroll
            for (int j = 0; j < 4; ++j) { const int n = nb + j * NGW; if (n >= N) break;
                asm volatile("" ::: "memory");
                float a[8] = {0.f, 0.f, 0.f, 0.f, 0.f, 0.f, 0.f, 0.f};
#pragma unroll
                for (int i = 0; i < 4; ++i) { const int k0 = 8 * (f_lane + 64 * i); const v4u w4 = wv[j][i];
                    float w[8]; w[0] = __uint_as_float(w4.x << 16); w[1] = __uint_as_float(w4.x & 0xffff0000u); w[2] = __uint_as_float(w4.y << 16); w[3] = __uint_as_float(w4.y & 0xffff0000u);
                    w[4] = __uint_as_float(w4.z << 16); w[5] = __uint_as_float(w4.z & 0xffff0000u); w[6] = __uint_as_float(w4.w << 16); w[7] = __uint_as_float(w4.w & 0xffff0000u);
#pragma unroll
                    for (int v = 0; v < 8; ++v) { const f32x4 g0 = *(const LAS f32x4*)(GL + v * DM + k0), g1 = *(const LAS f32x4*)(GL + v * DM + k0 + 4);
                        a[v] += (w[0] * g0[0] + w[1] * g0[1]) + (w[2] * g0[2] + w[3] * g0[3]) + (w[4] * g1[0] + w[5] * g1[1]) + (w[6] * g1[2] + w[7] * g1[3]); } }
#pragma unroll
                for (int v = 0; v < 8; ++v) a[v] = wave_sum(a[v]);
                if (f_lane == 0) {
#pragma unroll
                    for (int b = 0; b < 4; ++b) { cs[(size_t)b * CSTRIDE + n] = a[b]; cb[(size_t)b * CSTRIDE + n] = a[4 + b]; } }
            }
        }
    }
    __syncthreads();
}
__device__ __forceinline__ void combine_phase(Frame& F, const bf16* AO, bf16* AC, const float* lq1, const float* lk1, const float* lq2, const float* lk2, const float* gsub, float lam_init) {
    FR_IDS();
    const float d1 = wave_sum(lq1[f_lane] * lk1[f_lane] + lq1[f_lane + 64] * lk1[f_lane + 64]);
    const float d2 = wave_sum(lq2[f_lane] * lk2[f_lane] + lq2[f_lane + 64] * lk2[f_lane + 64]);
    const float lam = expf(d1) - expf(d2) + lam_init;
    const f32x4 gs = *((const f32x4*)gsub + f_lane) * (1.0f - lam_init);
    const int m0 = 256 * (8 * ((int)blockIdx.x & 7) + (((int)blockIdx.x >> 3) & 7)) + ((int)blockIdx.x >> 6) * 64 + f_wave * 8;
    for (int m = m0; m < m0 + 8; ++m) {
        const GAS unsigned long long* ip = (const GAS unsigned long long*)(AO + (size_t)m * (2 * DM)) + f_lane;
        GAS unsigned long long* op = (GAS unsigned long long*)(AC + (size_t)m * DM) + f_lane;
        unsigned long long r1[8], r2[8];
#pragma unroll
        for (int h = 0; h < 8; ++h) { r1[h] = ip[(2 * h) * 64]; r2[h] = ip[(2 * h + 1) * 64]; }
#pragma unroll
        for (int h = 0; h < 8; ++h) {
            f32x4 d;
            d.x = bf2f((unsigned short)(r1[h])) - lam * bf2f((unsigned short)(r2[h]));
            d.y = bf2f((unsigned short)(r1[h] >> 16)) - lam * bf2f((unsigned short)(r2[h] >> 16));
            d.z = bf2f((unsigned short)(r1[h] >> 32)) - lam * bf2f((unsigned short)(r2[h] >> 32));
            d.w = bf2f((unsigned short)(r1[h] >> 48)) - lam * bf2f((unsigned short)(r2[h] >> 48));
            const float ss = wave_sum((d.x * d.x + d.y * d.y) + (d.z * d.z + d.w * d.w));
            const float r = 1.f / sqrtf(ss * (1.f / 256.f) + LN_EPS);
            const f32x4 o = d * r * gs;
            op[h * 64] = (unsigned long long)pk2(o.x, o.y) | ((unsigned long long)pk2(o.z, o.w) << 32);
        }
    }
}
typedef attA::bf16 abf;
typedef attA::BlockRef<abf, abf> ARef;
__device__ __forceinline__ ARef attA_ref(const bf16* QKV, bf16* AO, int L, int pass) {
    const int k = L >> 3, xcd = L & 7, gi = k >> 5, r = k & 31;
    const int grp = gi * 8 + xcd, b = grp >> 3, hp = grp & 7;
    const int hq = 2 * hp + (r & 1), vh = (r >> 1) & 1, x = r >> 2;
    const int qb = pass ? 15 - x : x;
    const abf* base = (const abf*)QKV + (size_t)b * SEQ * NQKV_A;
    ARef R; R.Q = base + (size_t)qb * 256 * NQKV_A + hq * 128; R.K = base + DM + hq * 128; R.V = base + 2 * DM + hp * 256 + vh * 128;
    R.O = (abf*)AO + ((size_t)b * SEQ + (size_t)qb * 256) * (2 * DM) + hq * 256 + vh * 128; R.P0 = qb * 256;
    return R;
}
__device__ __forceinline__ void attnA_phase(char* lds, const bf16* QKV, bf16* AO) {
    const int total = 1024, stride = (int)gridDim.x;
    int L = blockIdx.x; if (L >= total) return;
    int pass = 0;
    ARef cur = attA_ref(QKV, AO, L, 0);
    attA::Seam<abf> S;
    attA::causal_swa_prime<abf, abf>(cur, SEQ, lds, S);
    for (;;) {
        const bool more_pass = pass == 0, more_item = L + stride < total, last = !more_pass && !more_item;
        int passn = pass + 1, Ln = L;
        if (!more_pass) { passn = 0; Ln = more_item ? L + stride : L; }
        const ARef nxt = last ? cur : attA_ref(QKV, AO, Ln, passn);
        attA::causal_swa_block<abf, abf>(cur, nxt, SEQ, SEQ, lds, S);
        if (last) break;
        cur = nxt; pass = passn; L = Ln;
    }
}
constexpr int CW_READY = 24576;
constexpr int CW_FOLD2 = CW_READY + 16 * 64 * DEPTH;
constexpr int CW_QDONE = CW_FOLD2 + 16;
constexpr int CW_TDONE = CW_QDONE + 16 * 64 * DEPTH;
constexpr int CW_AQ = CW_TDONE + 16 * NB * DEPTH;
constexpr int CW_BRDY = CW_AQ + 16 * 8 * DEPTH;
__device__ __forceinline__ void wait_panels(unsigned* base, int npan, unsigned expected, unsigned* bar) {
    const int t = opaque_tid();
    if (t < 64) {
        unsigned sp = 0;
        for (;;) { const unsigned c = t < npan ? xb_ld(base + 16 * t) : expected;
            if (__builtin_amdgcn_ballot_w64(c < expected) == 0ull) break;
            __builtin_amdgcn_s_sleep(1);
            if ((++sp & 255u) == 0u) { if (xb_ld(&bar[XB_TMO])) break; if (sp > XB_SPIN_CAP) { if (t == 0) atomicAdd(&bar[XB_TMO], 1u); break; } } }
        if (t == 0) { __builtin_amdgcn_fence(__ATOMIC_ACQUIRE, "agent"); asm volatile("s_waitcnt vmcnt(0)" ::: "memory"); }
    }
    __syncthreads();
}
__device__ __forceinline__ void signal_ready2(unsigned* cnt, unsigned* cnt2) {
    asm volatile("s_waitcnt vmcnt(0)" ::: "memory");
    __syncthreads();
    if (threadIdx.x == 0) { (void)xb_add(cnt, 1u); if (cnt2) (void)xb_add(cnt2, 1u); }
}
__device__ __forceinline__ void signal_ready(unsigned* cnt) {
    asm volatile("s_waitcnt vmcnt(0)" ::: "memory");
    __syncthreads();
    if (threadIdx.x == 0) (void)xb_add(cnt, 1u);
}
__device__ __forceinline__ void signal_ready_fenced(unsigned* cnt) {
    asm volatile("s_waitcnt vmcnt(0)" ::: "memory");
    __syncthreads();
    if (threadIdx.x == 0) { __builtin_amdgcn_fence(__ATOMIC_RELEASE, "agent"); asm volatile("s_waitcnt vmcnt(0)" ::: "memory"); (void)xb_add(cnt, 1u); }
}
__device__ __forceinline__ void wait_ready(unsigned* cnt, unsigned expected, unsigned* bar) {
    if (threadIdx.x == 0) { XB_SPIN(xb_ld(cnt) < expected, bar); __builtin_amdgcn_fence(__ATOMIC_ACQUIRE, "agent"); asm volatile("s_waitcnt vmcnt(0)" ::: "memory"); }
    __syncthreads();
}
#if ATT_DYN && QKV_DATAFLOW
__device__ __forceinline__ void attnA2_dyn_phase(char* lds, const bf16* QKV, bf16* AO, CArgs* ap, bool defer, unsigned* ctl, int Lyr) {
    int cq = 0;
#define ready (ctl + CW_READY + 16 * 64 * Lyr)
#define qdone (ctl + CW_QDONE + 16 * 64 * Lyr)
#define tdone (ctl + CW_TDONE + 16 * NB * Lyr)
#define aq (ctl + CW_AQ + 16 * 8 * Lyr)
#define brdy (ctl + CW_BRDY + 16 * NB * Lyr)
#define bar (ctl + CW_BAR)
    const int total = 512, stride = 256;
    { (void)total; (void)stride;
        volatile unsigned* slot = (volatile unsigned*)(lds + 142400);
        for (;;) {
            __syncthreads();
            if (threadIdx.x == 0) { const int own = (int)blockIdx.x & 7;
                unsigned got = 0xffffffffu;
#pragma unroll 1
                for (int c = 0; c < 16; ++c) { const int q = (own + c) & 7;
                    if (c < 8 && xb_ld(brdy + 16 * (q >> 1)) < 64u) continue;
                    if (xb_ld(aq + 16 * q) >= 64u) continue;
                    const unsigned idx = xb_add(aq + 16 * q, 1u);
                    if (idx < 64u) { got = ((unsigned)q << 8) | idx; break; } }
                *slot = got;
            }
            __syncthreads();
            const unsigned got = (unsigned)__builtin_amdgcn_readfirstlane((int)*slot);
            if (got == 0xffffffffu) break;
            const int q = (int)(got >> 8), idx = (int)(got & 255u), b = q >> 1, hp = 4 * (q & 1) + (idx >> 4), r = idx & 15, hq = 2 * hp + (r & 1), x = r >> 1;
            const abf* base = (const abf*)QKV + (size_t)b * SEQ * NQKV_A;
#pragma unroll 1
            for (int pass = 0; pass < 2; ++pass) { const int qb = pass ? 15 - x : x;
                attA::Blk2 B; B.Q = base + (size_t)qb * 256 * NQKV_A + hq * 128; B.K = base + DM + hq * 128; B.V = base + 2 * DM + hp * 256;
                B.O = (abf*)AO + ((size_t)b * SEQ + (size_t)qb * 256) * (2 * DM) + hq * 256; B.P0 = qb * 256; B.stamp = (unsigned long long*)(ap->ws + 512 * 1024 + 128);
                wait_panels(qdone + 16 * 16 * b, qb + 1, 4u, bar);
                attA::causal_fullv_block(B, lds);
                signal_ready2(ready + 16 * (b * 16 + qb), tdone + 16 * b);
                if (defer && cq < CONV_CHUNKS) { convert_chunk(ap, lds, cq); ++cq; }
            }
        }
        if (defer) for (; cq < CONV_CHUNKS; ++cq) convert_chunk(ap, lds, cq);
    }
#undef ready
#undef qdone
#undef tdone
#undef aq
#undef brdy
#undef bar
}
#endif
__device__ __forceinline__ void attnA2_phase(char* lds, const bf16* QKV, bf16* AO, CArgs* ap, bool defer, unsigned* ready, unsigned* qdone, unsigned* tdone, unsigned* bar) {
    const int total = 512, stride = (int)gridDim.x;
    int cq = 0;
    for (int L = blockIdx.x; L < total; L += stride) {
        const int k = L >> 3, xcd = L & 7, r = k & 15, grp = (k >> 4) * 8 + xcd, b = grp >> 3, hp = grp & 7, hq = 2 * hp + (r & 1), x = r >> 1;
        const abf* base = (const abf*)QKV + (size_t)b * SEQ * NQKV_A;
#pragma unroll 1
        for (int pass = 0; pass < 2; ++pass) { const int qb = pass ? 15 - x : x;
            attA::Blk2 B; B.Q = base + (size_t)qb * 256 * NQKV_A + hq * 128; B.K = base + DM + hq * 128; B.V = base + 2 * DM + hp * 256;
            B.O = (abf*)AO + ((size_t)b * SEQ + (size_t)qb * 256) * (2 * DM) + hq * 256; B.P0 = qb * 256; B.stamp = (unsigned long long*)(ap->ws + 512 * 1024 + 128);
            if (qdone) wait_panels(qdone + 16 * 16 * b, qb + 1, 4u, bar);
            attA::causal_fullv_block(B, lds);
            if (ready) signal_ready2(ready + 16 * (b * 16 + qb), tdone ? tdone + 16 * b : (unsigned*)nullptr);
            if (defer && (CONV_CHUNKS == 4 || pass == 0) && cq < CONV_CHUNKS) { convert_chunk(ap, lds, cq); ++cq; }
        }
    }
    if (defer) for (; cq < CONV_CHUNKS; ++cq) convert_chunk(ap, lds, cq);
}
__device__ __forceinline__ void attnB_phase(Frame& F, const bf16* QKV, const float* sinks, bf16* AC, unsigned* ready, unsigned* qdone, unsigned* tdone, unsigned* bar) {
    for (int u = F.vcu; u < NB * 4 * 32; u += F.G) { int n = u & 31, kvh = (u >> 5) & 3, b = u >> 7;
#if ATT_DYN
        if (qdone && F.G == 256) { const int x = (int)blockIdx.x & 7, j = (x & 1) * 32 + ((int)blockIdx.x >> 3) + (u >= 256 ? 64 : 0);
            b = x >> 1; kvh = j >> 5; n = j & 31; }
#endif
        if (qdone) { const int p1 = n >> 1, p0 = n > 0 ? (n - 1) >> 1 : p1; wait_panels(qdone + 16 * (16 * b + p0), p1 - p0 + 1, 4u, bar); }
        attB::swa_unit(b, kvh, n, QKV, sinks, AC, F.lds);
        if (ready) signal_ready2(ready + 16 * (b * 16 + (n >> 1)), tdone ? tdone + 16 * b : (unsigned*)nullptr); }
    __syncthreads();
}

#ifndef SITES
#define SITES 0xffff
#endif
#ifndef PG8_PROBE
#define PG8_PROBE 0
#endif
#ifndef PROBE_LAYER
#define PROBE_LAYER 1
#endif
#ifndef PROBE_SITE
#define PROBE_SITE 0
#endif
#define PROBE_KT (PROBE_SITE == 1 ? 128 : 32)
#ifndef PROBE_DUP
#define PROBE_DUP 0
#endif
#ifndef PROBE_NREP
#define PROBE_NREP 2
#endif
#define NREP(bit) ((PROBE_DUP & (bit)) ? PROBE_NREP : 1)
#define DUMMY_F32 ((float*)WSP(WS_AO))
__device__ __forceinline__ CArgs* kargs() { CArgs* p = (CArgs*)__builtin_amdgcn_kernarg_segment_ptr(); asm volatile("" : "+s"(p)); return p; }
#define AIN(i) (kargs()->in[i])
#define WSP(off) (kargs()->ws + (off))
__host__ __device__ __forceinline__ int panel_of(int c) { return 8 * (c & 7) + ((c >> 3) & 7); }
__device__ __forceinline__ int stage_panel(const float* st, LAS float* mrt) {
    const int pm = panel_of((int)blockIdx.x);
    pg8::stage_mu_r((LAS pg8::f32x2v*)mrt, st, pm, opaque_tid()); return pm;
}
#ifndef STAGGER_TICKS
#define STAGGER_TICKS 0
#endif
__device__ __forceinline__ void phase_stagger() {
    const unsigned long long want = (unsigned long long)(blockIdx.x >> 5) * STAGGER_TICKS, t0 = __builtin_amdgcn_s_memrealtime();
    while (__builtin_amdgcn_s_memrealtime() - t0 < want) __builtin_amdgcn_s_sleep(4);
}
__device__ __forceinline__ void xcc_local_barrier(unsigned* ctl, unsigned x, unsigned* bar) {
    asm volatile("s_waitcnt vmcnt(0)" ::: "memory");
    __syncthreads();
    if (threadIdx.x == 0) {
        __builtin_amdgcn_s_waitcnt(0);
        const unsigned old = xb_add(&ctl[CW_LSUB + 64 * x], 1u), gen = old >> 5;
        if ((old & 31u) == 31u) xb_add(&ctl[CW_LGEN + 64 * x], 1u);
        else XB_SPIN(xb_ld(&ctl[CW_LGEN + 64 * x]) == gen, bar);
        __builtin_amdgcn_fence(__ATOMIC_ACQUIRE, "agent");
        asm volatile("s_waitcnt vmcnt(0)" ::: "memory");
    }
    __syncthreads();
}
__device__ __forceinline__ void panel_barrier(unsigned* ctl, unsigned pm, unsigned* bar) {
    asm volatile("s_waitcnt vmcnt(0)" ::: "memory");
    __syncthreads();
    if (threadIdx.x == 0) {
        __builtin_amdgcn_s_waitcnt(0);
        const unsigned old = xb_add(&ctl[CW_PSUB + 64 * pm], 1u), gen = old >> 2;
        if ((old & 3u) == 3u) xb_add(&ctl[CW_PGEN + 64 * pm], 1u);
        else XB_SPIN(xb_ld(&ctl[CW_PGEN + 64 * pm]) == gen, bar);
        __builtin_amdgcn_fence(__ATOMIC_ACQUIRE, "agent");
        asm volatile("s_waitcnt vmcnt(0)" ::: "memory");
    }
    __syncthreads();
}
#ifndef CHAIN_STAGGER_TICKS
#define CHAIN_STAGGER_TICKS 0
#endif
__device__ __forceinline__ void chain_stagger() {
    const unsigned long long want = (unsigned long long)((blockIdx.x >> 3) & 7) * CHAIN_STAGGER_TICKS, t0 = __builtin_amdgcn_s_memrealtime();
    while (__builtin_amdgcn_s_memrealtime() - t0 < want) __builtin_amdgcn_s_sleep(2);
}
__global__ void __launch_bounds__(NWAVES * 64, 2) fwd_kernel(Args args_unused) {
    extern __shared__ __attribute__((aligned(16))) unsigned char lds[];
    Frame F;
    F.lds = (LAS unsigned char*)lds;
    F.MISC = (volatile LAS unsigned*)(F.lds + MISC_OFF);
    F.G = gridDim.x; { const int bx = blockIdx.x; F.vcu = (F.G % 8 == 0) ? (bx % 8) * (F.G / 8) + bx / 8 : bx; }
    F.ctl = (gu32*)WSP(WS_CTL);
    for (int u = threadIdx.x; u < (LDS_BYTES - LDSCTL_OFF) / 4; u += NWAVES * 64) ((LAS unsigned*)(F.lds + LDSCTL_OFF))[u] = 0u;
    __syncthreads();
    const int lo = kargs()->ph_lo, hi = kargs()->ph_hi;
    XcdBarrier bar; bar.bar = (unsigned*)(F.ctl + CW_BAR); bar.x = 0; bar.st = nullptr;
    if (hi - lo > 1) bar = xcd_barrier_post((unsigned*)(F.ctl + CW_BAR), F.MISC + 8);
    if (hi - lo > 1 && threadIdx.x == 0) (void)__hip_atomic_fetch_or((unsigned*)F.ctl + CW_XMASK + 64 * bar.x, 1u << (blockIdx.x & 7), __ATOMIC_RELAXED, __HIP_MEMORY_SCOPE_AGENT);
    bool local_ok = false;
#define IN(k) (lo <= (k) && (k) < hi)
#if PG8_PROBE == 5
    unsigned long long pr_bar = 0;
#ifndef PROBE_BARSET
#define PROBE_BARSET 0xff
#endif
#define SEAM(k) do { if ((k) + 1 < hi) { const unsigned long long t0_ = __builtin_amdgcn_s_memrealtime(); xcd_barrier(bar); const int k_ = (k); const int cls_ = k_ < 2 ? k_ : (((k_ - 2) & 7) == 0 ? 2 : ((k_ - 2) & 7) == 1 ? 3 : ((k_ - 2) & 7) == 2 ? 4 : ((k_ - 2) & 7) == 3 ? 5 : ((k_ - 2) & 7) == 5 ? 6 : 7); const unsigned long long dt_ = __builtin_amdgcn_s_memrealtime() - t0_; if ((PROBE_BARSET >> cls_) & 1) pr_bar += dt_; if (threadIdx.x == 0) atomicMax((unsigned*)WSP(520 * 1024) + k_, ~(unsigned)dt_); } } while (0)
#else
#define SEAM(k) do { if ((k) + 1 < hi) xcd_barrier(bar); } while (0)
#endif

#define MOD_ ((float*)WSP(WS_MOD))
#define X_ ((float*)WSP(WS_X))
#define HB_ ((bf16*)WSP(WS_HB))
#define QKV_ ((bf16*)WSP(WS_QKV))
#define QKVB_ ((bf16*)WSP(WS_QKVB))
#define READY_(L) ((unsigned*)F.ctl + CW_READY + 16 * 64 * (L))
#define QDONE_(L) ((unsigned*)F.ctl + CW_QDONE + 16 * 64 * (L))
#define TDONE_(L) ((unsigned*)F.ctl + CW_TDONE + 16 * NB * (L))
#define AQ_(L) ((unsigned*)F.ctl + CW_AQ + 16 * 8 * (L))
#define BRDY_(L) ((unsigned*)F.ctl + CW_BRDY + 16 * NB * (L))
#define AO_ ((bf16*)WSP(WS_AO))
#define AC_ ((bf16*)WSP(WS_AC))
#define HID_ ((bf16*)WSP(WS_HID))
#define STATS_(s) ((float*)WSP(WS_STATS) + (size_t)(s) * MTOK * 16)
#define MRT_ ((LAS float*)(F.lds + STATTBL_OFF))
#define CS_(s) ((const float*)WSP(WS_CS) + (size_t)(s) * NB * CSTRIDE)
#define CB_(s) ((const float*)WSP(WS_CB) + (size_t)(s) * NB * CSTRIDE)
#define GN_(s) ((const float*)WSP(WS_GN) + (size_t)(s) * NB * DM)
#define ZEROS_ ((const float*)WSP(WS_ZEROS))
#define ONES_ ((const float*)WSP(WS_ONES))
#define IG_(s) ((const float*)WSP(WS_IG) + (size_t)(s) * NB * DM)
#define NEUTRAL_ ((const float*)WSP(WS_NEUTRAL))
#define XB_ ((bf16*)WSP(WS_X))
    constexpr size_t MODL = (size_t)NB * NMOD * DM;
    constexpr int MODB = NMOD * DM;

#if SITES & 1
    if (IN(0)) { for (int rep = 0; rep < NREP(1); ++rep) { p0_prologue(F, kargs()); if (NREP(1) > 1) __syncthreads(); } SEAM(0); }
    if (lo == 0 && hi > 1 && F.G == 256) {
        if (threadIdx.x == 0) { unsigned seen = 0u, good = 1u;
            for (unsigned j = 0; j < 16; ++j) { const unsigned c = xb_ld(&bar.bar[XB_XCNT(j)]), m = xb_ld((unsigned*)F.ctl + CW_XMASK + 64 * j);
                if (c == 0u && m == 0u) continue; if (c != 32u || (m & (m - 1u)) != 0u || (seen & m) != 0u) good = 0u; seen |= m; }
            F.MISC[12] = (good && seen == 0xffu) ? 1u : 0u; }
        __syncthreads(); local_ok = F.MISC[12] != 0u; __syncthreads();
    }
#ifdef NO_LOCAL_BARRIERS
    local_ok = false;
#endif
#define SEAM_L(k) do { if ((k) + 1 < hi) { if (local_ok) panel_barrier((unsigned*)F.ctl, (unsigned)panel_of((int)blockIdx.x), bar.bar); else xcd_barrier(bar); } } while (0)
#endif
#if SITES & 4096
    if (IN(1)) { for (int rep = 0; rep < NREP(4096); ++rep) { h0_phase(F, AIN(0), MOD_ + 1 * DM, MOD_ + 0 * DM, HB_, XB_); fold_phase(F, kargs(), 0, CONV_DEFER ? 2 : 7, true); } SEAM_L(1); }
#endif

    for (int L = 0; L < DEPTH; ++L) {
        const int pb = 2 + 8 * L, j = L >> 1;
#define MODL_ (MOD_ + (size_t)L * MODL)
        if ((L & 1) == 0) {
#if SITES & 8
            if (IN(pb + 0)) for (int rep = 0; rep < NREP(2); ++rep) {
                if (QKV_DATAFLOW && L >= 2 && rep == 0) wait_ready(TDONE_(L - 2) + 16 * (panel_of((int)blockIdx.x) >> 4), 256u, bar.bar);
                pg8::Gemm g{HB_, (const bf16*)WSP(WS_WQKVA + j * WS_WA_STRIDE), MTOK, NQKV_A, DM};
#if PG8_PROBE
                if (L == PROBE_LAYER && PROBE_SITE == 2) g.probe = (unsigned long long*)WSP(WS_PROBE);
#endif
                pg8::StaticOrder S; S.init(MTOK, NQKV_A, F.G, (int)blockIdx.x);
                pg8::EpiQKV<128> E{QKV_, NQKV_A, ZEROS_, (const float*)WSP(WS_TABA), (const float*)WSP(WS_IDENT), 16, SEQ - 1, L == 0 ? (const float*)WSP(WS_NEUTRAL) : (const float*)STATS_(2 * L - 1), L == 0 ? ZEROS_ : CS_(2 * L - 1), L == 0 ? ZEROS_ : CB_(2 * L - 1), L == 0 ? 0 : CSTRIDE, 12, MRT_, stage_panel(L == 0 ? (const float*)WSP(WS_NEUTRAL) : (const float*)STATS_(2 * L - 1), MRT_)};
                if (STAGGER_TICKS) phase_stagger();
            pg8::gemm_phase<pg8::EpiQKV<128>, pg8::StaticOrder, true, true>(F.lds + RING_OFF, g, S, E);
                if (rep == NREP(2) - 1) { if (QKV_DATAFLOW) signal_ready2(QDONE_(L) + 16 * panel_of((int)blockIdx.x), BRDY_(L) + 16 * (panel_of((int)blockIdx.x) >> 4)); else SEAM(pb + 0); }
            }
#endif
#if SITES & 2
            if (IN(pb + 1)) { for (int rep = 0; rep < NREP(4); ++rep) {
#if ATTA_FULLV
#if PG8_PROBE == 7 || PG8_PROBE == 8
                const unsigned long long pa_r0 = __builtin_amdgcn_s_memrealtime(), pa_c0 = __builtin_amdgcn_s_memtime();
#endif
#if ATT_DYN && QKV_DATAFLOW
                attnA2_dyn_phase((char*)lds + RING_OFF, QKV_, AO_, kargs(), CONV_DEFER && L == 0 && rep == 0, (unsigned*)F.ctl, L);
#else
                attnA2_phase((char*)lds + RING_OFF, QKV_, AO_, kargs(), CONV_DEFER && L == 0 && rep == 0, (DATAFLOW && rep == NREP(4) - 1) ? READY_(L) : (unsigned*)nullptr, QKV_DATAFLOW ? QDONE_(L) : (unsigned*)nullptr, QKV_DATAFLOW ? TDONE_(L) : (unsigned*)nullptr, bar.bar);
#endif
#if PG8_PROBE == 7 || PG8_PROBE == 8
                if (L == 2 && blockIdx.x == 0 && threadIdx.x == 0) { unsigned long long* pr = (unsigned long long*)WSP(WS_PROBE); pr[3] = __builtin_amdgcn_s_memrealtime() - pa_r0; pr[4] = __builtin_amdgcn_s_memtime() - pa_c0; }
#endif
#else
                attnA_phase((char*)lds + RING_OFF, QKV_, AO_);
#endif
            } if (!DATAFLOW || (L0_ATT_GLOBAL && L == 0)) SEAM(pb + 1); }
#endif
#if SITES & 512
            if (IN(pb + 2)) {
                if (CONV_DEFER && FOLD2_AT_C0 && L == 0) { fold_phase(F, kargs(), 2, 7, false); signal_ready_fenced((unsigned*)F.ctl + CW_FOLD2); }
                if (DATAFLOW) wait_ready(READY_(L) + 16 * panel_of((int)blockIdx.x), 16u, bar.bar);
                if (DATAFLOW && XCC_ALIGN && local_ok) xcc_local_barrier((unsigned*)F.ctl, (unsigned)blockIdx.x & 7u, bar.bar);
                if (local_ok && CHAIN_STAGGER_TICKS) chain_stagger();
                const float lam_init = (L == 0) ? 0.2f : 0.47071301658633585f;
                for (int rep = 0; rep < NREP(8); ++rep) combine_phase(F, AO_, AC_, AIN(12) + j * 128, AIN(13) + j * 128, AIN(14) + j * 128, AIN(15) + j * 128, AIN(16) + j * 256, lam_init);
                SEAM_L(pb + 2);
            }
#endif
#if SITES & 16
            if (IN(pb + 3)) for (int rep = 0; rep < NREP(16); ++rep) {
                pg8::Gemm g{AC_, (const bf16*)WSP(WS_WOA + j * WS_WA_STRIDE), MTOK, DM, DM};
#if PG8_PROBE
                if (L == PROBE_LAYER && PROBE_SITE == 3) g.probe = (unsigned long long*)WSP(WS_PROBE);
#endif
                pg8::StaticOrder S; S.init(MTOK, DM, F.G, (int)blockIdx.x);
                pg8::EpiResid E{L == 0 ? (const bf16*)XB_ : (const bf16*)HB_, L == 0 ? ONES_ : IG_(2 * L - 1), L == 0 ? 0 : DM, L == 0 ? NEUTRAL_ : (const float*)STATS_(2 * L - 1), L == 0 ? ONES_ : AIN(6) + (L - 1) * DM, L == 0 ? ZEROS_ : AIN(7) + (L - 1) * DM,
                                 (float*)nullptr, STATS_(2 * L), HB_, GN_(2 * L), DM, DM, MODL_ + 2 * DM, MODB, ZEROS_, ALPHA, 12, MRT_, stage_panel(L == 0 ? NEUTRAL_ : (const float*)STATS_(2 * L - 1), MRT_)};
                if (STAGGER_TICKS) phase_stagger();
            pg8::gemm_phase<pg8::EpiResid, pg8::StaticOrder, true, true>(F.lds + RING_OFF, g, S, E);
                if (rep == NREP(16) - 1) SEAM_L(pb + 3);
            }
#endif
        } else {
#if SITES & 32
            if (IN(pb + 0)) for (int rep = 0; rep < NREP(32); ++rep) {
                if (QKV_DATAFLOW && L >= 2 && rep == 0) wait_ready(TDONE_(L - 2) + 16 * (panel_of((int)blockIdx.x) >> 4), 128u, bar.bar);
                pg8::Gemm g{HB_, (const bf16*)WSP(WS_WQKVB + j * WS_WB_STRIDE), MTOK, NQKV_B, DM}; pg8::StaticOrder S; S.init(MTOK, NQKV_B, F.G, (int)blockIdx.x);
                pg8::EpiQKV<64> E{QKVB_, NQKV_B, (const float*)WSP(WS_BPERM) + j * NQKV_B, (const float*)WSP(WS_TABB), (const float*)WSP(WS_IDENT), 9, SEQ - 1, (const float*)STATS_(2 * L - 1), CS_(2 * L - 1), CB_(2 * L - 1), CSTRIDE, 12, MRT_, stage_panel((const float*)STATS_(2 * L - 1), MRT_)};
                if (STAGGER_TICKS) phase_stagger();
            pg8::gemm_phase<pg8::EpiQKV<64>, pg8::StaticOrder, true, true>(F.lds + RING_OFF, g, S, E);
                if (rep == NREP(32) - 1) { if (QKV_DATAFLOW) signal_ready2(QDONE_(L) + 16 * panel_of((int)blockIdx.x), BRDY_(L) + 16 * (panel_of((int)blockIdx.x) >> 4)); else SEAM(pb + 0); }
            }
#endif
#if SITES & 4
            if (IN(pb + 1) && CONV_DEFER && L == 1 && !FOLD2_AT_C0) {
                fold_phase(F, kargs(), 2, 7, false); signal_ready_fenced((unsigned*)F.ctl + CW_FOLD2); }
            if (IN(pb + 1)) { for (int rep = 0; rep < NREP(64); ++rep) attnB_phase(F, QKVB_, AIN(19) + j * 32, AC_, (DATAFLOW && rep == NREP(64) - 1) ? READY_(L) : (unsigned*)nullptr, QKV_DATAFLOW ? QDONE_(L) : (unsigned*)nullptr, QKV_DATAFLOW ? TDONE_(L) : (unsigned*)nullptr, bar.bar); if (!DATAFLOW) SEAM(pb + 1); }
#endif
#if SITES & 64
            if (IN(pb + 3)) for (int rep = 0; rep < NREP(128); ++rep) {
                if (DATAFLOW && rep == 0) wait_ready(READY_(L) + 16 * panel_of((int)blockIdx.x), 8u, bar.bar);
                if (DATAFLOW && XCC_ALIGN && local_ok && rep == 0) xcc_local_barrier((unsigned*)F.ctl, (unsigned)blockIdx.x & 7u, bar.bar);
                if (local_ok && CHAIN_STAGGER_TICKS) chain_stagger();
                pg8::Gemm g{AC_, (const bf16*)WSP(WS_WOB + j * WS_WB_STRIDE), MTOK, DM, DM}; pg8::StaticOrder S; S.init(MTOK, DM, F.G, (int)blockIdx.x);
                pg8::EpiResid E{(const bf16*)HB_, IG_(2 * L - 1), DM, (const float*)STATS_(2 * L - 1), AIN(6) + (L - 1) * DM, AIN(7) + (L - 1) * DM,
                                 (float*)nullptr, STATS_(2 * L), HB_, GN_(2 * L), DM, DM, MODL_ + 2 * DM, MODB, AIN(21) + j * DM, ALPHA, 12, MRT_, stage_panel((const float*)STATS_(2 * L - 1), MRT_)};
                if (STAGGER_TICKS) phase_stagger();
            pg8::gemm_phase<pg8::EpiResid, pg8::StaticOrder, true, true>(F.lds + RING_OFF, g, S, E);
                if (rep == NREP(128) - 1) SEAM_L(pb + 3);
            }
#endif
        }
#if SITES & 128
        if (IN(pb + 5)) for (int rep = 0; rep < NREP(512); ++rep) {
            if (CONV_DEFER && L == 1 && rep == 0) wait_ready((unsigned*)F.ctl + CW_FOLD2, gridDim.x, bar.bar);
            pg8::Gemm g{HB_, (const bf16*)WSP(WS_WUP + L * WS_WMLP_STRIDE), MTOK, DFF, DM};
#if PG8_PROBE
            if (L == PROBE_LAYER && PROBE_SITE == 0) g.probe = (unsigned long long*)WSP(WS_PROBE);
#endif
            pg8::StaticOrder S; S.init(MTOK, DFF, F.G, (int)blockIdx.x);
            pg8::EpiRelu2 E{HID_, DFF, (const float*)STATS_(2 * L), CS_(2 * L), CB_(2 * L), CSTRIDE, 12, MRT_, stage_panel((const float*)STATS_(2 * L), MRT_), QKV_};
            if (STAGGER_TICKS) phase_stagger();
            pg8::gemm_phase<pg8::EpiRelu2, pg8::StaticOrder, true, true>(F.lds + RING_OFF, g, S, E);
            if (rep == NREP(512) - 1) SEAM_L(pb + 5);
        }
#endif
#if SITES & 256
        if (IN(pb + 6)) for (int rep = 0; rep < NREP(1024); ++rep) {
            pg8::Gemm g{HID_, (const bf16*)WSP(WS_WDN + L * WS_WMLP_STRIDE), MTOK, DM, DFF};
#if PG8_PROBE
            if (L == PROBE_LAYER && PROBE_SITE == 1) g.probe = (unsigned long long*)WSP(WS_PROBE);
#endif
            pg8::StaticOrder S; S.init(MTOK, DM, F.G, (int)blockIdx.x);
            pg8::EpiResid E{(const bf16*)HB_, IG_(2 * L), DM, (const float*)STATS_(2 * L), AIN(4) + L * DM, AIN(5) + L * DM,
                             L == DEPTH - 1 ? X_ : (float*)nullptr, STATS_(2 * L + 1), L == DEPTH - 1 ? (bf16*)nullptr : HB_, GN_(2 * L + 1), DM, DM, MODL_ + 5 * DM, MODB, ZEROS_, ALPHA, 12, MRT_, stage_panel((const float*)STATS_(2 * L), MRT_)};
            if (STAGGER_TICKS) phase_stagger();
            pg8::gemm_phase<pg8::EpiResid, pg8::StaticOrder, true, true>(F.lds + RING_OFF, g, S, E);
            if (rep == NREP(1024) - 1) { if (CONV_DEFER && (!DATAFLOW || L0_DOWN_GLOBAL) && L == 0) SEAM(pb + 6); else SEAM_L(pb + 6); }
        }
#endif
    }
    if (IN(2 + 8 * DEPTH)) final_ln_phase(F, X_, STATS_(2 * DEPTH - 1), kargs()->out, AIN(6) + (DEPTH - 1) * DM, AIN(7) + (DEPTH - 1) * DM);
#if PG8_PROBE == 5
    if (threadIdx.x == 0) atomicAdd((unsigned long long*)WSP(512 * 1024), pr_bar);
#endif
#if ATTA_STAMP
    if (blockIdx.x == 0 && threadIdx.x == 0) { const unsigned long long t0 = __builtin_amdgcn_s_memrealtime(), ticks = ((const unsigned long long*)WSP(512 * 1024 + 128))[ATTA_STAMP_SEL] / 8ull;
        while (__builtin_amdgcn_s_memrealtime() - t0 < ticks) __builtin_amdgcn_s_sleep(8); }
#endif
#if CONV_PROBE
    if (blockIdx.x == PROBE_WG && threadIdx.x == 0) { const unsigned long long t0 = __builtin_amdgcn_s_memrealtime(), ticks = 5ull * *(const unsigned long long*)WSP(512 * 1024 + 64);
        while (__builtin_amdgcn_s_memrealtime() - t0 < ticks) __builtin_amdgcn_s_sleep(8); }
#endif
#if PG8_PROBE
    if (IN(2 + 8 * DEPTH)) { xcd_barrier(bar);
        if (blockIdx.x == 0 && threadIdx.x == 0) { const unsigned long long* pr = (const unsigned long long*)WSP(WS_PROBE); float v = 0.f;
            if (PG8_PROBE == 1) v = ((float)pr[4] * 100.0f / (float)pr[3] - 1000.0f) * 0.1f;
            if (PG8_PROBE == 2) v = ((float)pr[0] / (float)(pr[2] * (unsigned long long)PROBE_KT) - 2000.0f) * 0.1f;
            if (PG8_PROBE == 3) v = (float)pr[1] / (float)pr[2] * 0.01f;
            if (PG8_PROBE == 5) v = (float)(*(const unsigned long long*)WSP(512 * 1024)) / (float)gridDim.x * 0.001f;
            if (PG8_PROBE == 5 && PROBE_BARSET == 0) { unsigned sum = 0; for (int i = 0; i < N_PHASES; ++i) { const unsigned w = ((const unsigned*)WSP(520 * 1024))[i]; if (w) sum += ~w; } v = (float)sum * 0.001f; }
            if (PG8_PROBE == 7) v = ((float)pr[4] * 100.0f / (float)pr[3] - 1000.0f) * 0.1f;
            if (PG8_PROBE == 8) v = (float)pr[3] * 0.001f;
            if (PG8_PROBE == 9 || PG8_PROBE == 10) v = ((float)pr[0] / (float)(pr[2] - 1) - 4000.0f) * 0.05f;
            if (PG8_PROBE == 11) v = (float)(*(const unsigned long long*)WSP(512 * 1024 + 64)) * 0.01f;
            if (PG8_PROBE == 4) v = (float)pr[3] * 0.001f;
            { const unsigned long long t0 = __builtin_amdgcn_s_memrealtime(); const unsigned long long ticks = (unsigned long long)(fmaxf(v, 0.f) * 500.0f);
              while (__builtin_amdgcn_s_memrealtime() - t0 < ticks) __builtin_amdgcn_s_sleep(8); } } }
#endif
#undef IN
#undef SEAM
}

extern "C" void kernel_launch(void* const* d_in, const int* in_sizes, int n_in, void* d_out, int out_size, void* d_ws, size_t ws_size, hipStream_t stream) {
    static int grid = 0;
    if (grid == 0) {
        if (n_in != 22 || in_sizes[0] != MTOK * DM || out_size != MTOK * DM || ws_size < WS_END) {
            fprintf(stderr, "kernel_launch: unexpected shapes (n_in %d, in0 %d, out %d, ws %zu; need ws >= %zu); nothing launched\n", n_in, n_in > 0 ? in_sizes[0] : -1, out_size, ws_size, (size_t)WS_END); grid = -1; return; }
        int dev = 0, cus = 0, per_cu = 0;
        if (hipGetDevice(&dev) != hipSuccess || hipDeviceGetAttribute(&cus, hipDeviceAttributeMultiprocessorCount, dev) != hipSuccess) { fprintf(stderr, "kernel_launch: device query failed\n"); grid = -1; return; }
        if (hipFuncSetAttribute((const void*)fwd_kernel, hipFuncAttributeMaxDynamicSharedMemorySize, LDS_BYTES) != hipSuccess) { fprintf(stderr, "kernel_launch: hipFuncSetAttribute failed\n"); grid = -1; return; }
        if (hipOccupancyMaxActiveBlocksPerMultiprocessor(&per_cu, (const void*)fwd_kernel, NWAVES * 64, LDS_BYTES) != hipSuccess || per_cu < 1)
            fprintf(stderr, "kernel_launch: note: occupancy query reports %d workgroups per CU\n", per_cu);
        (void)hipGetLastError();
        grid = cus;
        { const int Ns[5] = {NQKV_A, NQKV_B, DM, DFF, DM}; bool ok = true;
          if (grid != 256) ok = false;
          for (int gi = 0; gi < 5 && ok; ++gi) for (int c = 0; c < grid && ok; ++c) { pg8::StaticOrder S; S.init(MTOK, Ns[gi], grid, c); pg8::Unit u;
              for (int i = 0; S.next(i, u); ++i) if (u.pm != panel_of(c)) { ok = false; break; } }
          if (!ok) { fprintf(stderr, "kernel_launch: unit order does not keep a workgroup on one row panel for a grid of %d; nothing launched\n", grid); grid = -1; return; } }
    }
    if (grid < 0) return;
    if (hipMemsetAsync((char*)d_ws + WS_CTL, 0, CTL_ZERO_BYTES, stream) != hipSuccess) { fprintf(stderr, "kernel_launch: memset failed\n"); return; }
    Args a{};
    for (int i = 0; i < 22; ++i) a.in[i] = (const float*)d_in[i];
    a.out = (float*)d_out; a.ws = (unsigned char*)d_ws;
#if MK_PER_PHASE
    for (int p = 0; p < N_PHASES; ++p) {
        if (p >= 2 && p < 2 + 8 * DEPTH) { const int sl = (p - 2) & 7, Lp = (p - 2) >> 3; if (sl == 4 || sl == 7 || (sl == 2 && (Lp & 1))) continue; }
        a.ph_lo = p; a.ph_hi = p + 1;
        hipLaunchKernelGGL(fwd_kernel, dim3(grid), dim3(NWAVES * 64), LDS_BYTES, stream, a);
    }
#else
    a.ph_lo = 0; a.ph_hi = N_PHASES;
    hipLaunchKernelGGL(fwd_kernel, dim3(grid), dim3(NWAVES * 64), LDS_BYTES, stream, a);
#endif
    const hipError_t le = hipPeekAtLastError();
    if (le != hipSuccess) fprintf(stderr, "kernel_launch: launch failed: %s\n", hipGetErrorName(le));
}
```

```cpp
#include <hip/hip_runtime.h>
#include <hip/hip_bf16.h>
#include <cstdio>
#include <cstdint>

constexpr int DM = 2048, NB = 4, SEQ = 4096, DEPTH = 4, MTOK = NB * SEQ, DFF = 8192;
constexpr int NQKV_A = 3 * DM;
constexpr int NQKV_B = 2560;
constexpr float LN_EPS = 1e-5f;
constexpr float ALPHA = 1.681792830507429f;
constexpr int NMOD = 6;
__device__ __forceinline__ int opaque_tid() { int t = (int)threadIdx.x; asm volatile("" : "+v"(t)); return t; }
#ifndef PG8_RELAX
#define PG8_RELAX 0
#endif
#ifndef CONV_PROBE
#define CONV_PROBE 0
#endif
#ifndef PROBE_WG
#define PROBE_WG 0
#endif
#ifndef DATAFLOW
#define DATAFLOW 1
#endif
#ifndef FOLD2_AT_C0
#define FOLD2_AT_C0 1
#endif
#ifndef L0_DOWN_GLOBAL
#define L0_DOWN_GLOBAL 0
#endif
#ifndef XCC_ALIGN
#define XCC_ALIGN 0
#endif
#ifndef QKV_DATAFLOW
#define QKV_DATAFLOW 0
#endif
#ifndef HID_PERM
#define HID_PERM 0
#endif
#ifndef L0_ATT_GLOBAL
#define L0_ATT_GLOBAL 1
#endif
#ifndef CONV_DEFER
#define CONV_DEFER 1
#endif
#ifndef ATTA_FULLV
#define ATTA_FULLV 1
#endif
template <int K> __device__ __forceinline__ float lane_xor(float v) {
    if constexpr (K == 32) { const auto rr = __builtin_amdgcn_permlane32_swap(__float_as_uint(v), __float_as_uint(v), false, false);
        return __uint_as_float(((opaque_tid() & 32) ? rr[0] : rr[1])); }
    else return __uint_as_float((unsigned)__builtin_amdgcn_ds_swizzle((int)__float_as_uint(v), (K << 10) | 0x1F));
}
__device__ __forceinline__ float half_sum32(float v) { const auto rr = __builtin_amdgcn_permlane32_swap(__float_as_uint(v), __float_as_uint(v), false, false); return __uint_as_float(rr[0]) + __uint_as_float(rr[1]); }
__device__ __forceinline__ float half_max32(float v) { const auto rr = __builtin_amdgcn_permlane32_swap(__float_as_uint(v), __float_as_uint(v), false, false); return fmaxf(__uint_as_float(rr[0]), __uint_as_float(rr[1])); }
typedef unsigned wt_u32x4 __attribute__((ext_vector_type(4)));
__device__ __forceinline__ void store16_wt(void* p, wt_u32x4 v) { asm volatile("global_store_dwordx4 %0, %1, off sc1\n\ts_nop 1" :: "v"(p), "v"(v) : "memory"); }
__device__ __forceinline__ void store4_wt(void* p, unsigned v) { asm volatile("global_store_dword %0, %1, off sc1\n\ts_nop 1" :: "v"(p), "v"(v) : "memory"); }

#define GAS __attribute__((address_space(1)))
#define LAS __attribute__((address_space(3)))
typedef unsigned short bf16;
typedef unsigned v4u __attribute__((ext_vector_type(4)));
typedef float f32x4 __attribute__((ext_vector_type(4)));
typedef short bf16x8 __attribute__((ext_vector_type(8)));
typedef GAS unsigned gu32;
typedef GAS unsigned long long gu64;
#define RLX_AGENT __ATOMIC_RELAXED, __HIP_MEMORY_SCOPE_AGENT
#define LDS_WAIT() asm volatile("s_waitcnt lgkmcnt(0)" ::: "memory")
#define VM_WAIT() asm volatile("s_waitcnt vmcnt(0)" ::: "memory")
__device__ __forceinline__ unsigned long long rt() { return __builtin_amdgcn_s_memrealtime(); }
__device__ __forceinline__ unsigned f2bf(float f) { unsigned u = __builtin_bit_cast(unsigned, f); return (u + 0x7fffu + ((u >> 16) & 1u)) >> 16; }
__device__ __forceinline__ unsigned pk2(float lo, float hi) { return f2bf(lo) | (f2bf(hi) << 16); }

#define XB_TMO      128
#define XB_XCNT(j)  (256  + 64 * (j))
#define XB_XSUB(j)  (1280 + 64 * (j))
#define XB_XGEN(j)  (2304 + 64 * (j))
#define XB_TOP      3328
#define XB_TOPGEN   3392
#define XCD_BAR_WORDS 3456
#define XB_SPIN_CAP (1u << 18)

__device__ __forceinline__ unsigned xb_ld(unsigned* p)              { return __hip_atomic_load(p, __ATOMIC_RELAXED, __HIP_MEMORY_SCOPE_AGENT); }
__device__ __forceinline__ unsigned xb_add(unsigned* p, unsigned v) { return __hip_atomic_fetch_add(p, v, __ATOMIC_RELAXED, __HIP_MEMORY_SCOPE_AGENT); }
__device__ __forceinline__ unsigned xb_xcc_id() { return (unsigned)__builtin_amdgcn_s_getreg((3 << 11) | 20) & 0xFu; }
#define XB_SPIN(cond, bar) do { unsigned _sp = 0; while (cond) { __builtin_amdgcn_s_sleep(1); \
    if ((++_sp & 255u) == 0u) { if (xb_ld(&(bar)[XB_TMO])) break; if (_sp > XB_SPIN_CAP) { atomicAdd(&(bar)[XB_TMO], 1u); break; } } } } while (0)

struct XcdBarrier {
    unsigned* bar; unsigned x;
    volatile LAS unsigned* st;
};

__device__ __forceinline__ XcdBarrier xcd_barrier_post(unsigned* bar, volatile LAS unsigned* st) {
    XcdBarrier b; b.bar = bar; b.x = xb_xcc_id(); b.st = st;
    if (threadIdx.x == 0) (void)xb_add(&bar[XB_XCNT(b.x)], 1u);
    return b;
}
__device__ __forceinline__ void xcd_barrier_complete(unsigned* bar, unsigned x, unsigned& nloc, unsigned& nx) {
    const unsigned G = gridDim.x * gridDim.y * gridDim.z;
    unsigned sum, cnt, mine, sp = 0u;
    for (;;) {
        sum = 0u; cnt = 0u; mine = 0u;
#pragma unroll
        for (unsigned j = 0; j < 16; ++j) { const unsigned c = xb_ld(&bar[XB_XCNT(j)]); sum += c; cnt += (c > 0u) ? 1u : 0u; mine = (j == x) ? c : mine; }
        if (sum == G) break;
        __builtin_amdgcn_s_sleep(1);
        if ((++sp & 255u) == 0u) { if (xb_ld(&bar[XB_TMO])) break; if (sp > XB_SPIN_CAP) { atomicAdd(&bar[XB_TMO], 1u); break; } }
    }
    nloc = mine > 0u ? mine : 1u; nx = cnt > 0u ? cnt : 1u;
}

__device__ __forceinline__ void xcd_barrier(const XcdBarrier& b) {
    asm volatile("s_waitcnt vmcnt(0)" ::: "memory");
    __syncthreads();
    if (threadIdx.x == 0) {
        unsigned* bar = b.bar;
        __builtin_amdgcn_s_waitcnt(0);
        unsigned nloc = b.st[0], nx = b.st[1];
        unsigned bx = b.x; asm volatile("" : "+s"(bx));
        if (nloc == 0u) { xcd_barrier_complete(bar, bx, nloc, nx); b.st[0] = nloc; b.st[1] = nx; }
        const unsigned old = xb_add(&bar[XB_XSUB(bx)], 1u);
        const unsigned gen = old / nloc;
        if (old + 1u == (gen + 1u) * nloc) {
            __builtin_amdgcn_fence(__ATOMIC_RELEASE, "agent");
            asm volatile("s_waitcnt vmcnt(0)" ::: "memory");
            const unsigned og = xb_add(&bar[XB_TOP], 1u);
            const unsigned tg = og / nx;
            if (og + 1u == (tg + 1u) * nx) xb_add(&bar[XB_TOPGEN], 1u);
            else XB_SPIN(xb_ld(&bar[XB_TOPGEN]) == tg, bar);
            __builtin_amdgcn_fence(__ATOMIC_ACQUIRE, "agent");
            xb_add(&bar[XB_XGEN(bx)], 1u);
            asm volatile("s_waitcnt vmcnt(0)" ::: "memory");
        } else {
            XB_SPIN(xb_ld(&bar[XB_XGEN(bx)]) == gen, bar);
            __builtin_amdgcn_fence(__ATOMIC_ACQUIRE, "agent");
            asm volatile("s_waitcnt vmcnt(0)" ::: "memory");
        }
    }
    __syncthreads();
}

namespace pg8 {
#define PG8_LAS __attribute__((address_space(3)))
typedef unsigned short bf16_t;
typedef short bf16x8 __attribute__((ext_vector_type(8)));
typedef float f32x4 __attribute__((ext_vector_type(4)));
typedef unsigned u32x4 __attribute__((ext_vector_type(4)));
constexpr int BM = 256, BK = 64, HALF = 128, HTB = HALF * BK * 2  , STAGE_BYTES = 8 * HTB, NXCD = 8, WGM = 8;

__host__ __device__ __forceinline__ int lds_byte(int r, int c) { const int st = (r >> 4) * 2 + (c >> 5), rr = r & 15, cc = c & 31, ob = rr * 64 + cc * 2; return st * 1024 + (ob ^ (((ob >> 9) & 1) << 5)); }
__host__ __device__ __forceinline__ void stage_rc(int b, int& R, int& C) { const int st = b / 1024, sb = b % 1024, swz = sb ^ (((sb >> 9) & 1) << 5); R = (st >> 1) * 16 + swz / 64; C = (st & 1) * 32 + (swz % 64) / 2; }
__host__ __device__ __forceinline__ int perm32(int rho) { const int n = rho >> 4, i = rho & 15; return 8 * (i >> 2) + 4 * n + (i & 3); }

struct Unit { int pm, pn; };
struct Gemm { const bf16_t* A; const bf16_t* Bt; int M, N, K; unsigned long long* probe = nullptr; };

struct StaticOrder {
    int nM, nN, nwg, G, c;
    __host__ __device__ void init(int M, int N, int G_, int c_) { nM = M / BM; nN = N / BM; nwg = nM * nN; G = G_; c = c_; }
    __host__ __device__ bool next(int i, Unit& u) const {
        const long L = (long)i * G + c; if (L >= nwg) return false;
        int wgid = (int)L; { const int q = nwg / NXCD, r = nwg % NXCD, xcd = wgid % NXCD, off = wgid / NXCD; wgid = (xcd < r ? xcd * (q + 1) : r * (q + 1) + (xcd - r) * q) + off; }
        const int nig = WGM * nN, gid = wgid / nig, fm = gid * WGM, gsz = (nM - fm) < WGM ? (nM - fm) : WGM;
        u.pm = fm + ((wgid % nig) % gsz); u.pn = (wgid % nig) / gsz; return true;
    }
    __device__ __forceinline__ void a_ready(const Unit&) const {}
    __device__ __forceinline__ void done(const Unit&) const {}
};

__device__ __forceinline__ unsigned cvt_pk_bf16(float lo, float hi) { unsigned r; asm volatile("v_cvt_pk_bf16_f32 %0, %1, %2" : "=v"(r) : "v"(lo), "v"(hi)); return r; }
typedef float f32x2 __attribute__((ext_vector_type(2)));

typedef float f32x2v __attribute__((ext_vector_type(2)));
typedef unsigned u32x2v __attribute__((ext_vector_type(2)));
constexpr float kInvD = 1.0f / 2048.0f, kEps = 1e-5f;
__device__ __forceinline__ void row_mu_r(const float* st, int row, float& mu, float& r) {
    const f32x4* p = (const f32x4*)(st + 16 * (size_t)row); const f32x4 a = p[0], b = p[1], c = p[2], d = p[3];
    const float s = ((a[0] + a[2]) + (b[0] + b[2])) + ((c[0] + c[2]) + (d[0] + d[2])), q = ((a[1] + a[3]) + (b[1] + b[3])) + ((c[1] + c[3]) + (d[1] + d[3]));
    mu = s * kInvD; const float var = fmaxf(q * kInvD - mu * mu, 0.f); r = __builtin_amdgcn_rsqf(var + kEps);
}
__device__ __forceinline__ void stage_mu_r(PG8_LAS f32x2v* mr, const float* st, int pm, int t) {
    if (t < 256) { float mu, r; row_mu_r(st, pm * BM + t, mu, r); mr[t] = (f32x2v){mu, r}; }
    asm volatile("s_waitcnt lgkmcnt(0)" ::: "memory"); __builtin_amdgcn_s_barrier(); asm volatile("" ::: "memory");
}
__device__ __forceinline__ u32x4 pack_bf16x8(const f32x4 v0, const f32x4 v1) { u32x4 w; w.x = cvt_pk_bf16(v0[0], v0[1]); w.y = cvt_pk_bf16(v0[2], v0[3]); w.z = cvt_pk_bf16(v1[0], v1[1]); w.w = cvt_pk_bf16(v1[2], v1[3]); return w; }
template <int HD> struct EpiQKV {
    static constexpr bool PERM = true, AFTER_DRAIN = false; static constexpr int NSTORES = 16;
    bf16_t* O; int ldc; const float* bias; const float* tab; const float* ident; int rope_tiles; int seq_mask;
    const float* st; const float* cs; const float* cb; int cstride; int seq_shift; PG8_LAS float* mrt; int staged_pm;
    __device__ __forceinline__ void operator()(f32x4 (&acc)[2][2][4][2], const Unit& u, int wr, int wc, int fr, int fq) const {
        asm volatile("" : "+v"(fr), "+v"(fq));
        const int row0 = u.pm * BM + wr * 64 + fr, col0 = u.pn * BM + wc * 32 + 8 * fq, lrow0 = wr * 64 + fr;
        PG8_LAS f32x2v* mr = (PG8_LAS f32x2v*)mrt; (void)staged_pm;
        const bool rope = u.pn < rope_tiles;
        const char* tbase = rope ? (const char*)tab : (const char*)ident; const unsigned tmul = rope ? (unsigned)(HD * 4) : 0u;
        const size_t cofs = (size_t)((u.pm * BM) >> seq_shift) * cstride + col0;
#pragma unroll
        for (int bj = 0; bj < 2; ++bj) {
            f32x4 bv[2], cbv[2], csv[2];
#pragma unroll
            for (int n = 0; n < 2; ++n) { bv[n] = *(const f32x4*)(bias + col0 + bj * HALF + 4 * n); cbv[n] = *(const f32x4*)(cb + cofs + bj * HALF + 4 * n); csv[n] = *(const f32x4*)(cs + cofs + bj * HALF + 4 * n); }
            const unsigned tcol = rope ? (unsigned)(((col0 + bj * HALF) & (HD - 1)) >> 1) * 8u : 0u;
#pragma unroll
            for (int ai = 0; ai < 2; ++ai) {
                f32x4 tb[4][2];
#pragma unroll
                for (int m = 0; m < 4; ++m) { const unsigned tof = (unsigned)((row0 + ai * HALF + m * 16) & seq_mask) * tmul + tcol;
                    tb[m][0] = *(const f32x4*)(tbase + tof); tb[m][1] = *(const f32x4*)(tbase + tof + 16u); }
                asm volatile("" : "+v"(tb[0][0]), "+v"(tb[0][1]), "+v"(tb[1][0]), "+v"(tb[1][1]), "+v"(tb[2][0]), "+v"(tb[2][1]), "+v"(tb[3][0]), "+v"(tb[3][1]));
                if (ai == 0) { bv[0] += cbv[0]; bv[1] += cbv[1]; }
#pragma unroll
                for (int m = 0; m < 4; ++m) { const f32x2v q = mr[lrow0 + ai * HALF + m * 16]; const float mu = q.x, r = q.y;
                    const f32x4 v0 = (acc[ai][bj][m][0] - csv[0] * mu) * r + bv[0], v1 = (acc[ai][bj][m][1] - csv[1] * mu) * r + bv[1];
                    const f32x4 t0 = tb[m][0], t1 = tb[m][1];
                    acc[ai][bj][m][0] = (f32x4){v0[0] * t0[0] - v0[1] * t0[1], v0[1] * t0[0] + v0[0] * t0[1], v0[2] * t0[2] - v0[3] * t0[3], v0[3] * t0[2] + v0[2] * t0[3]};
                    acc[ai][bj][m][1] = (f32x4){v1[0] * t1[0] - v1[1] * t1[1], v1[1] * t1[0] + v1[0] * t1[1], v1[2] * t1[2] - v1[3] * t1[3], v1[3] * t1[2] + v1[2] * t1[3]}; }
                asm volatile("" : "+v"(acc[ai][bj][0][0]), "+v"(acc[ai][bj][0][1]), "+v"(acc[ai][bj][1][0]), "+v"(acc[ai][bj][1][1]), "+v"(acc[ai][bj][2][0]), "+v"(acc[ai][bj][2][1]), "+v"(acc[ai][bj][3][0]), "+v"(acc[ai][bj][3][1]) :: "memory");
            }
        }
#pragma unroll
        for (int ai = 0; ai < 2; ++ai)
#pragma unroll
            for (int m = 0; m < 4; ++m) { bf16_t* rowp = O + (size_t)(row0 + ai * HALF + m * 16) * ldc + col0;
#pragma unroll
                for (int bj = 0; bj < 2; ++bj) { const u32x4 w_ = pack_bf16x8(acc[ai][bj][m][0], acc[ai][bj][m][1]);
                    if (QKV_DATAFLOW) store16_wt(rowp + bj * HALF, w_); else *(u32x4*)(rowp + bj * HALF) = w_; } }
    }
};
struct EpiRelu2 {
    static constexpr bool PERM = true, AFTER_DRAIN = false; static constexpr int NSTORES = 16;
    bf16_t* O; int ldc; const float* st; const float* cs; const float* cb; int cstride; int seq_shift; PG8_LAS float* mrt; int staged_pm; bf16_t* dup;
    __device__ __forceinline__ void operator()(f32x4 (&acc)[2][2][4][2], const Unit& u, int wr, int wc, int fr, int fq) const {
        asm volatile("" : "+v"(fr), "+v"(fq));
        const int row0 = u.pm * BM + wr * 64 + fr, col0 = u.pn * BM + wc * 32 + 8 * fq, lrow0 = wr * 64 + fr;
        const size_t cofs = (size_t)((u.pm * BM) >> seq_shift) * cstride + col0;
        PG8_LAS f32x2v* mr = (PG8_LAS f32x2v*)mrt; (void)staged_pm;
        f32x4 cbv[2][2], csv[2][2];
#pragma unroll
        for (int bj = 0; bj < 2; ++bj)
#pragma unroll
            for (int n = 0; n < 2; ++n) { cbv[bj][n] = *(const f32x4*)(cb + cofs + bj * HALF + 4 * n); csv[bj][n] = *(const f32x4*)(cs + cofs + bj * HALF + 4 * n); }
        asm volatile("" ::: "memory");
#pragma unroll
        for (int ai = 0; ai < 2; ++ai)
#pragma unroll
            for (int m = 0; m < 4; ++m) { bf16_t* rowp = O + (size_t)(row0 + ai * HALF + m * 16) * ldc + col0; const f32x2v q = mr[lrow0 + ai * HALF + m * 16]; u32x4 wv[2]; (void)rowp; (void)wv;
#pragma unroll
                for (int bj = 0; bj < 2; ++bj) { f32x4 v0 = (acc[ai][bj][m][0] - csv[bj][0] * q.x) * q.y + cbv[bj][0], v1 = (acc[ai][bj][m][1] - csv[bj][1] * q.x) * q.y + cbv[bj][1];
#pragma unroll
                    for (int e = 0; e < 4; ++e) { const float a = fmaxf(v0[e], 0.f), b = fmaxf(v1[e], 0.f); v0[e] = a * a; v1[e] = b * b; }
#if HID_PERM
                    wv[bj] = pack_bf16x8(v0, v1); }
                { const bool lo = fr < 8; const u32x4 snd = lo ? wv[1] : wv[0]; u32x4 rcv;
#pragma unroll
                  for (int e = 0; e < 4; ++e) rcv[e] = (unsigned)__builtin_amdgcn_update_dpp(0, (int)snd[e], 0x128, 0xf, 0xf, false);
                  const u32x4 dA = lo ? wv[0] : rcv, dB = lo ? rcv : wv[1];
                  bf16_t* pA = O + (size_t)(u.pm * BM + wr * 64 + ai * HALF + m * 16 + (fr & 7)) * ldc + u.pn * BM + wc * 64 + (lo ? 0 : 32) + 8 * fq;
                  *(u32x4*)pA = dA; *(u32x4*)(pA + (size_t)8 * ldc) = dB; } }
#else
                    { const u32x4 w_ = pack_bf16x8(v0, v1); *(u32x4*)(rowp + bj * HALF) = w_; } } }
#endif
    }
};
struct EpiResid {
    static constexpr bool PERM = true, AFTER_DRAIN = false; static constexpr int NSTORES = 16;
    const bf16_t* rb; const float* ig; int igstride; const float* pst; const float* pg; const float* pb; float* outf; float* st; bf16_t* hb; const float* gn; int gnstride;
    int ldc; const float* gate; int gstride; const float* bias; float alpha; int seq_shift;
    PG8_LAS float* tbl; int staged_pm;
    __device__ __forceinline__ void operator()(f32x4 (&acc)[2][2][4][2], const Unit& u, int wr, int wc, int fr, int fq) const {
        asm volatile("" : "+v"(fr), "+v"(fq));
        const int lrow0 = wr * 64 + fr, col0 = u.pn * BM + wc * 32 + 8 * fq;
        const int b = (u.pm * BM) >> seq_shift, t = (wr * 4 + wc) * 64 + fq * 16 + fr;
        const float* gb = gate + (size_t)b * gstride + col0; const float* gnb = gn + (size_t)b * gnstride + col0; const float* igb = ig + (size_t)b * igstride + col0;
        PG8_LAS f32x2v* mr = (PG8_LAS f32x2v*)tbl; PG8_LAS f32x2v* ps = (PG8_LAS f32x2v*)tbl + 256;
        (void)staged_pm;
        const unsigned rowb = (unsigned)((u.pm * BM + lrow0) * ldc + col0) * 2u;
        const unsigned rstep = (unsigned)ldc * 32u;
#pragma unroll
        for (int bj = 0; bj < 2; ++bj) { const int c = bj * HALF;
            u32x4 xs[2][4];
#pragma unroll
            for (int ai = 0; ai < 2; ++ai)
#pragma unroll
                for (int m = 0; m < 4; ++m) xs[ai][m] = *(const u32x4*)((const char*)rb + (rowb + (unsigned)(ai * 8 + m) * rstep + (unsigned)c * 2u));
            f32x4 gv[2], c1[2], c2[2], c3[2];
#pragma unroll
            for (int n = 0; n < 2; ++n) { gv[n] = *(const f32x4*)(gb + c + 4 * n); c1[n] = *(const f32x4*)(igb + c + 4 * n); c2[n] = *(const f32x4*)(pg + col0 + c + 4 * n);
                c3[n] = *(const f32x4*)(pb + col0 + c + 4 * n); }
            const f32x4 bz0 = *(const f32x4*)(bias + col0 + c), bz1 = *(const f32x4*)(bias + col0 + c + 4);
            asm volatile("" : "+v"(xs[0][0]), "+v"(xs[0][1]), "+v"(xs[0][2]), "+v"(xs[0][3]), "+v"(xs[1][0]), "+v"(xs[1][1]), "+v"(xs[1][2]), "+v"(xs[1][3]));
#pragma unroll
            for (int n = 0; n < 2; ++n) { gv[n] = gv[n] + 1.0f; c1[n] = c1[n] * alpha  ; c2[n] = c2[n] * alpha; c3[n] = c3[n] * alpha + gv[n] * (n ? bz1 : bz0); }
#pragma unroll
            for (int ai = 0; ai < 2; ++ai)
#pragma unroll
                for (int m = 0; m < 4; ++m) { const f32x2v q = mr[lrow0 + ai * HALF + m * 16]; const u32x4 x = xs[ai][m];
                    const f32x4 x0 = {__uint_as_float(x.x << 16), __uint_as_float(x.x & 0xffff0000u), __uint_as_float(x.y << 16), __uint_as_float(x.y & 0xffff0000u)};
                    const f32x4 x1 = {__uint_as_float(x.z << 16), __uint_as_float(x.z & 0xffff0000u), __uint_as_float(x.w << 16), __uint_as_float(x.w & 0xffff0000u)};
                    acc[ai][bj][m][0] = (x0 * c1[0] - c2[0] * q.x) * q.y + c3[0] + gv[0] * acc[ai][bj][m][0];
                    acc[ai][bj][m][1] = (x1 * c1[1] - c2[1] * q.x) * q.y + c3[1] + gv[1] * acc[ai][bj][m][1]; }
            asm volatile("" : "+v"(acc[0][bj][0][0]), "+v"(acc[0][bj][1][0]), "+v"(acc[0][bj][2][0]), "+v"(acc[0][bj][3][0]), "+v"(acc[1][bj][0][0]), "+v"(acc[1][bj][1][0]), "+v"(acc[1][bj][2][0]), "+v"(acc[1][bj][3][0]),
                              "+v"(acc[0][bj][0][1]), "+v"(acc[0][bj][1][1]), "+v"(acc[0][bj][2][1]), "+v"(acc[0][bj][3][1]), "+v"(acc[1][bj][0][1]), "+v"(acc[1][bj][1][1]), "+v"(acc[1][bj][2][1]), "+v"(acc[1][bj][3][1]) :: "memory");
        }
        unsigned rowb2 = rowb; asm volatile("" : "+v"(rowb2));
#pragma unroll
        for (int ai = 0; ai < 2; ++ai)
#pragma unroll
            for (int m = 0; m < 4; ++m) { const int lrow = lrow0 + ai * HALF + m * 16;
                float s_ = 0.f, q_ = 0.f;
#pragma unroll
                for (int bj = 0; bj < 2; ++bj)
#pragma unroll
                    for (int n = 0; n < 2; ++n) { const f32x4 v = acc[ai][bj][m][n]; s_ += (v[0] + v[1]) + (v[2] + v[3]); q_ += (v[0] * v[0] + v[1] * v[1]) + (v[2] * v[2] + v[3] * v[3]); }
                s_ += lane_xor<16>(s_); s_ = half_sum32(s_); q_ += lane_xor<16>(q_); q_ = half_sum32(q_);
                if (fq == 0) ps[lrow * 4 + wc] = (f32x2v){s_, q_}; }
        if (hb) {
            f32x4 gnv[2][2];
#pragma unroll
            for (int bj = 0; bj < 2; ++bj)
#pragma unroll
                for (int n = 0; n < 2; ++n) gnv[bj][n] = *(const f32x4*)(gnb + bj * HALF + 4 * n);
#pragma unroll
            for (int ai = 0; ai < 2; ++ai)
#pragma unroll
                for (int m = 0; m < 4; ++m) { const unsigned ob = rowb2 + (unsigned)(ai * 8 + m) * rstep;
#pragma unroll
                    for (int bj = 0; bj < 2; ++bj) *(u32x4*)((char*)hb + (ob + (unsigned)bj * 256u)) = pack_bf16x8(acc[ai][bj][m][0] * gnv[bj][0], acc[ai][bj][m][1] * gnv[bj][1]); }
        } else {
#pragma unroll
            for (int ai = 0; ai < 2; ++ai)
#pragma unroll
                for (int m = 0; m < 4; ++m) { const unsigned ob = (rowb2 + (unsigned)(ai * 8 + m) * rstep) * 2u;
#pragma unroll
                    for (int bj = 0; bj < 2; ++bj) { *(f32x4*)((char*)outf + (ob + (unsigned)bj * 512u)) = acc[ai][bj][m][0]; *(f32x4*)((char*)outf + (ob + (unsigned)bj * 512u + 16u)) = acc[ai][bj][m][1]; } }
        }
        asm volatile("s_waitcnt lgkmcnt(0)" ::: "memory"); __builtin_amdgcn_s_barrier(); asm volatile("" ::: "memory");
        if (t < 256) { const f32x2v a = ps[t * 4 + 0], b2 = ps[t * 4 + 1], c = ps[t * 4 + 2], d = ps[t * 4 + 3];
            *(f32x2v*)(st + 16 * (size_t)(u.pm * BM + t) + 2 * u.pn) = (f32x2v){(a.x + b2.x) + (c.x + d.x), (a.y + b2.y) + (c.y + d.y)}; }
    }
};

template <class Epi, class Sched, bool ALIGN_EPI = false, bool SP2 = false>
__device__ __forceinline__ void gemm_phase(PG8_LAS unsigned char* lds, const Gemm g, const Sched& S, const Epi& E) {
    const int tid = opaque_tid(), wid = __builtin_amdgcn_readfirstlane(tid >> 6), lane = tid & 63, wr = wid >> 2, wc = wid & 3, fr = lane & 15, fq = lane >> 4;
    const int K = g.K, nt = K / BK;
    unsigned voffA[2], voffB[2];
#pragma unroll
    for (int i = 0; i < 2; ++i) { int R, C; stage_rc(tid * 16 + i * 8192, R, C); const int Rb = Epi::PERM ? ((R & ~31) + perm32(R & 31)) : R;
        voffA[i] = (unsigned)(R * K + C) * 2u; voffB[i] = (unsigned)(Rb * K + C) * 2u; }
    const size_t kstep = (size_t)(BK * 2);
    const size_t hstep = (size_t)HALF * K * 2;
    const size_t tstep = 2 * hstep;
    const unsigned ldsw = (unsigned)wid * 1024u;
    const int aoff = lds_byte(wr * 64 + fr, fq * 8), boff = lds_byte(wc * 32 + fr, fq * 8);
#define PG8_SA(b, h) (((b) * 2 + (h)) * HTB)
#define PG8_SB(b, h) ((4 + (b) * 2 + (h)) * HTB)
#define PG8_STAGE(bufoff, gbase, voff) do { _Pragma("unroll") for (int _i = 0; _i < 2; ++_i) \
        __builtin_amdgcn_global_load_lds((const unsigned*)((const char*)(gbase) + (voff)[_i]), (PG8_LAS unsigned*)(lds + (bufoff) + ldsw + _i * 8192), 16, 0, 0); } while (0)
#define PG8_LDA(dst, b, h) do { _Pragma("unroll") for (int m = 0; m < 4; ++m) _Pragma("unroll") for (int k = 0; k < 2; ++k) dst[m][k] = *(const PG8_LAS bf16x8*)(lds + PG8_SA(b, h) + aoff + m * 2048 + k * 1024); } while (0)
#define PG8_LDB(dst, b, h) do { _Pragma("unroll") for (int n = 0; n < 2; ++n) _Pragma("unroll") for (int k = 0; k < 2; ++k) dst[n][k] = *(const PG8_LAS bf16x8*)(lds + PG8_SB(b, h) + boff + n * 2048 + k * 1024); } while (0)
#define PG8_MMA(ai, bj, At, Bt) do { __builtin_amdgcn_s_setprio(1); _Pragma("unroll") for (int m = 0; m < 4; ++m) _Pragma("unroll") for (int n = 0; n < 2; ++n) _Pragma("unroll") for (int k = 0; k < 2; ++k) \
        acc[ai][bj][m][n] = __builtin_amdgcn_mfma_f32_16x16x32_bf16(Bt[n][k], At[m][k], acc[ai][bj][m][n], 0, 0, 0); __builtin_amdgcn_s_setprio(0); } while (0)
#define PG8_WAIT_V(n) asm volatile("s_waitcnt vmcnt(" #n ")" ::: "memory")
#define PG8_WAIT_L(n) asm volatile("s_waitcnt lgkmcnt(" #n ")" ::: "memory")
#if PG8_RELAX
#define PG8_WAIT_VR() do { asm volatile("s_waitcnt vmcnt(%0)" :: "n"(8 + Epi::NSTORES) : "memory"); if (!PG8_RELAX || relax_ == 0) { PG8_WAIT_V(8); } } while (0)
#else
#define PG8_WAIT_VR() PG8_WAIT_V(8)
#endif
#define PG8_BAR __builtin_amdgcn_s_barrier()
#define PG8_SCHED __builtin_amdgcn_sched_barrier(0)
    Unit cur, nxt; int ui = 0;
    if (!S.next(0, cur)) return;
#if PG8_PROBE
    unsigned long long pr_tk = 0, pr_te = 0; const unsigned long long pr_r0 = __builtin_amdgcn_s_memrealtime(), pr_c0 = __builtin_amdgcn_s_memtime();
#endif
    f32x4 acc[2][2][4][2];
#pragma unroll
    for (int a = 0; a < 2; ++a)
#pragma unroll
        for (int b = 0; b < 2; ++b)
#pragma unroll
            for (int m = 0; m < 4; ++m)
#pragma unroll
                for (int n = 0; n < 2; ++n) acc[a][b][m][n] = (f32x4){0.f, 0.f, 0.f, 0.f};
    bf16x8 At[4][2], B0[2][2], B1[2][2];
    const char* cA = (const char*)g.A + (size_t)cur.pm * tstep; const char* cB = (const char*)g.Bt + (size_t)cur.pn * tstep;
    S.a_ready(cur);
    if constexpr (SP2) {
        PG8_STAGE(PG8_SB(0, 0), cB, voffB); PG8_STAGE(PG8_SB(0, 1), cB + hstep, voffB); PG8_STAGE(PG8_SA(0, 0), cA, voffA); PG8_STAGE(PG8_SA(0, 1), cA + hstep, voffA);
        if (wr == 1) PG8_BAR;
        PG8_WAIT_V(2); PG8_BAR;
        PG8_STAGE(PG8_SB(1, 0), cB + kstep, voffB); PG8_STAGE(PG8_SA(1, 0), cA + kstep, voffA); PG8_STAGE(PG8_SB(1, 1), cB + hstep + kstep, voffB);
        PG8_WAIT_V(6); PG8_BAR;
    } else {
        PG8_STAGE(PG8_SB(0, 0), cB, voffB); PG8_STAGE(PG8_SA(0, 0), cA, voffA); PG8_STAGE(PG8_SB(0, 1), cB + hstep, voffB); PG8_STAGE(PG8_SA(0, 1), cA + hstep, voffA);
        if (wr == 1) PG8_BAR;
        PG8_WAIT_V(4); PG8_BAR;
        PG8_STAGE(PG8_SB(1, 0), cB + kstep, voffB); PG8_STAGE(PG8_SA(1, 0), cA + kstep, voffA); PG8_STAGE(PG8_SB(1, 1), cB + hstep + kstep, voffB);
        PG8_WAIT_V(6); PG8_BAR;
    }
    for (;;) {
        const bool has_next = S.next(ui + 1, nxt);
        const char* nA = has_next ? (const char*)g.A + (size_t)nxt.pm * tstep : cA; const char* nB = has_next ? (const char*)g.Bt + (size_t)nxt.pn * tstep : cB;
#if PG8_PROBE
        const unsigned long long pr_ta = __builtin_amdgcn_s_memtime();
#endif
        for (int t = 0; t < nt; t += 2) {
            const bool last = (t == nt - 2);
#if PG8_PROBE >= 9 && PG8_PROBE <= 10
            int pr_tv = (PG8_PROBE == 9 ? 0 : 8); asm volatile("" : "+v"(pr_tv)); const bool pr_sel = (ui > 0) && (t == __builtin_amdgcn_readfirstlane(pr_tv)); const unsigned pr_i0 = (unsigned)__builtin_amdgcn_s_memtime();
#endif
#if PG8_RELAX
            int relax_v = ((t == 0) && (ui > 0)) ? 1 : 0; asm volatile("" : "+v"(relax_v)); const int relax_ = __builtin_amdgcn_readfirstlane(relax_v);
#endif
            const char* a1 = cA + (size_t)(t + 1) * kstep;
            const char* a2 = last ? nA : cA + (size_t)(t + 2) * kstep; const char* b2 = last ? nB : cB + (size_t)(t + 2) * kstep;
            const char* a3 = a2 + kstep; const char* b3 = b2 + kstep;
            if (last && has_next) S.a_ready(nxt);
            if constexpr (SP2) {
            PG8_LDB(B0, 0, 0); PG8_LDB(B1, 0, 1); PG8_SCHED; PG8_LDA(At, 0, 0); PG8_STAGE(PG8_SA(1, 1), a1 + hstep, voffA);
            PG8_WAIT_VR(); PG8_WAIT_L(0); PG8_BAR; PG8_MMA(0, 0, At, B0); PG8_MMA(0, 1, At, B1); PG8_BAR; PG8_SCHED;
            PG8_LDA(At, 0, 1); PG8_STAGE(PG8_SB(0, 0), b2, voffB); PG8_STAGE(PG8_SB(0, 1), b2 + hstep, voffB); PG8_STAGE(PG8_SA(0, 0), a2, voffA);
            PG8_WAIT_VR(); PG8_WAIT_L(0); PG8_BAR; PG8_MMA(1, 0, At, B0); PG8_MMA(1, 1, At, B1); PG8_BAR; PG8_SCHED;
            PG8_LDB(B0, 1, 0); PG8_LDB(B1, 1, 1); PG8_SCHED; PG8_LDA(At, 1, 0); PG8_STAGE(PG8_SA(0, 1), a2 + hstep, voffA);
            PG8_WAIT_V(8); PG8_WAIT_L(0); PG8_BAR; PG8_MMA(0, 0, At, B0); PG8_MMA(0, 1, At, B1); PG8_BAR; PG8_SCHED;
            PG8_LDA(At, 1, 1); PG8_STAGE(PG8_SB(1, 0), b3, voffB); PG8_STAGE(PG8_SB(1, 1), b3 + hstep, voffB); PG8_STAGE(PG8_SA(1, 0), a3, voffA);
            PG8_WAIT_V(8); PG8_WAIT_L(0); PG8_BAR; PG8_MMA(1, 0, At, B0); PG8_MMA(1, 1, At, B1); PG8_BAR; PG8_SCHED;
            } else {
            PG8_LDB(B0, 0, 0); PG8_SCHED; PG8_LDA(At, 0, 0); PG8_STAGE(PG8_SA(1, 1), a1 + hstep, voffA);
            PG8_WAIT_L(8); PG8_BAR; PG8_WAIT_L(0); PG8_MMA(0, 0, At, B0); PG8_BAR; PG8_SCHED;
            PG8_LDB(B1, 0, 1); PG8_STAGE(PG8_SB(0, 0), b2, voffB);
            PG8_BAR; PG8_WAIT_L(0); PG8_MMA(0, 1, At, B1); PG8_BAR;
            PG8_LDA(At, 0, 1); PG8_STAGE(PG8_SA(0, 0), a2, voffA);
            PG8_BAR; PG8_WAIT_L(0); PG8_MMA(1, 0, At, B0); PG8_BAR; PG8_SCHED;
            PG8_STAGE(PG8_SB(0, 1), b2 + hstep, voffB);
            PG8_WAIT_V(6); PG8_BAR; PG8_MMA(1, 1, At, B1); PG8_BAR;
            PG8_LDB(B0, 1, 0); PG8_SCHED; PG8_LDA(At, 1, 0); PG8_STAGE(PG8_SA(0, 1), a2 + hstep, voffA);
            PG8_WAIT_L(8); PG8_BAR; PG8_WAIT_L(0); PG8_MMA(0, 0, At, B0); PG8_BAR; PG8_SCHED;
            PG8_LDB(B1, 1, 1); PG8_STAGE(PG8_SB(1, 0), b3, voffB);
            PG8_BAR; PG8_WAIT_L(0); PG8_MMA(0, 1, At, B1); PG8_BAR;
            PG8_LDA(At, 1, 1); PG8_STAGE(PG8_SA(1, 0), a3, voffA);
            PG8_BAR; PG8_WAIT_L(0); PG8_MMA(1, 0, At, B0); PG8_BAR; PG8_SCHED;
            PG8_STAGE(PG8_SB(1, 1), b3 + hstep, voffB);
            PG8_WAIT_V(6); PG8_BAR; PG8_MMA(1, 1, At, B1); PG8_BAR;
            }
#if PG8_PROBE >= 9 && PG8_PROBE <= 10
            if (pr_sel) pr_tk += (unsigned)((unsigned)__builtin_amdgcn_s_memtime() - pr_i0);
#endif
        }
#if PG8_PROBE
        const unsigned long long pr_tb = __builtin_amdgcn_s_memtime(); if (!(PG8_PROBE >= 9 && PG8_PROBE <= 10)) pr_tk += pr_tb - pr_ta;
#endif
        if constexpr (ALIGN_EPI) { if (wr == 0) PG8_BAR; }
        if constexpr (!Epi::AFTER_DRAIN) { E(acc, cur, wr, wc, fr, fq); S.done(cur); }
#if PG8_PROBE
        { const unsigned long long pr_tc = __builtin_amdgcn_s_memtime(); pr_te += pr_tc - pr_tb; }
#endif
        if (!has_next) break;
#pragma unroll
        for (int a = 0; a < 2; ++a)
#pragma unroll
            for (int b = 0; b < 2; ++b)
#pragma unroll
                for (int m = 0; m < 4; ++m)
#pragma unroll
                    for (int n = 0; n < 2; ++n) acc[a][b][m][n] = (f32x4){0.f, 0.f, 0.f, 0.f};
        cur = nxt; cA = nA; cB = nB; ++ui;
        if constexpr (ALIGN_EPI) { if (wr == 1) PG8_BAR; }
    }
#if PG8_PROBE
    if (g.probe && blockIdx.x == 0 && tid == 0) { g.probe[0] = pr_tk; g.probe[1] = pr_te; g.probe[2] = (unsigned long long)(ui + 1); g.probe[3] = __builtin_amdgcn_s_memrealtime() - pr_r0; g.probe[4] = __builtin_amdgcn_s_memtime() - pr_c0; }
#endif
    PG8_WAIT_V(0);
    if constexpr (!ALIGN_EPI) { if (wr == 0) PG8_BAR; }
    PG8_BAR;
    if constexpr (Epi::AFTER_DRAIN) { E.fused(acc, cur, wr, wc, fr, fq, lds, wid, lane); S.done(cur); }
#undef PG8_SA
#undef PG8_SB
#undef PG8_STAGE
#undef PG8_LDA
#undef PG8_LDB
#undef PG8_MMA
#undef PG8_WAIT_V
#undef PG8_WAIT_L
#undef PG8_WAIT_VR
#undef PG8_BAR
#undef PG8_SCHED
}
}

namespace attA {
constexpr int D = 128;
constexpr int LDQ = NQKV_A, LDKV = NQKV_A, LDO = 2 * DM;
constexpr float THR = 8.f;
constexpr bool WSKIP = false;
constexpr float SCALE = 0.08838834764831845f;
constexpr int NW = 8, QBLK = 32, KVBLK = 64, QB = NW * QBLK;
constexpr int SHM_V = KVBLK * D * 2, SHM_K = KVBLK * D * 2;
constexpr int LDS_BYTES = 2 * SHM_V + 2 * SHM_K + NW * 64 * 4;
using bf16 = __hip_bfloat16;
typedef short bf16x8 __attribute__((ext_vector_type(8)));
typedef short s16x4 __attribute__((ext_vector_type(4)));
typedef float f32x16 __attribute__((ext_vector_type(16)));
typedef float f32x4 __attribute__((ext_vector_type(4)));
typedef unsigned u32x4 __attribute__((ext_vector_type(4)));
template <class A, class Bt> struct same_t { static constexpr bool v = false; };
template <class A> struct same_t<A, A> { static constexpr bool v = true; };

#define KSWZ(row, colB) ((row) * 256 + ((colB) ^ (((row) & 7) << 4)))
#define SBAR() __builtin_amdgcn_sched_barrier(0)
__device__ __forceinline__ int v_st(int k, int c) { const int kk = (k & ~0xC) | ((k & 4) << 1) | ((k & 8) >> 1); return ((kk >> 3) * 4 + (c >> 5)) * 512 + ((kk & 7) * 32 + (c & 31)) * 2; }
__device__ __forceinline__ int v_rd_base(int lane) { return ((lane & 3) << 3) | (((lane >> 2) & 3) << 6) | (((lane >> 4) & 1) << 5) | (((lane >> 5) & 1) << 8); }
constexpr int v_rd_off(int d0, int ks, int half) { return d0 * 512 + ks * 4096 + half * 2048; }
__device__ __forceinline__ int crow(int r, int hi) { return (r & 3) + 8 * (r >> 2) + 4 * hi; }
__device__ __forceinline__ unsigned cvtpk(float lo, float hi) {
    unsigned r; asm volatile("v_cvt_pk_bf16_f32 %0, %1, %2" : "=v"(r) : "v"(lo), "v"(hi)); return r;
}
__device__ __forceinline__ bf16x8 pack8(f32x4 a, f32x4 b) {
    u32x4 w = {cvtpk(a[0], a[1]), cvtpk(a[2], a[3]), cvtpk(b[0], b[1]), cvtpk(b[2], b[3])};
    return *reinterpret_cast<bf16x8*>(&w);
}
template <class T> __device__ __forceinline__ bf16x8 load8(const T* p) {
    if constexpr (same_t<T, float>::v) { return pack8(*(const f32x4*)p, *(const f32x4*)(p + 4)); }
    else { return *reinterpret_cast<const bf16x8*>(p); }
}
__device__ __forceinline__ void mask_tile(f32x16& p0, f32x16& p1, int dq, unsigned W) {
    const float NEG = -__builtin_inff();
#pragma unroll
    for (int r = 0; r < 16; ++r) {
        const int c = (r & 3) + 8 * (r >> 2);
        if ((unsigned)(dq - c) >= W) p0[r] = NEG;
        if ((unsigned)(dq - c - 32) >= W) p1[r] = NEG;
    }
}
__device__ __forceinline__ void partialSM(f32x16& p0, f32x16& p1, float& m_reg, float& mn, float& alpha) {
    float pmax = p0[0]; for (int r = 1; r < 16; ++r) pmax = fmaxf(pmax, p0[r]); for (int r = 0; r < 16; ++r) pmax = fmaxf(pmax, p1[r]);
    { auto rr = __builtin_amdgcn_permlane32_swap(__float_as_uint(pmax), __float_as_uint(pmax), false, false);
      pmax = fmaxf(__uint_as_float(rr[0]), __uint_as_float(rr[1])); }
    constexpr float C2 = 1.4426950408889634f * SCALE;
    if (__builtin_expect(__all((pmax - m_reg) * SCALE <= THR), 1)) { mn = m_reg; alpha = 1.f; }
    else { mn = fmaxf(m_reg, pmax); alpha = __builtin_amdgcn_exp2f((m_reg - mn) * C2); m_reg = mn; }
    const float mnL = -mn * C2;
    for (int r = 0; r < 16; ++r) p0[r] = fmaf(p0[r], C2, mnL); for (int r = 0; r < 16; ++r) p1[r] = fmaf(p1[r], C2, mnL);
    for (int r = 0; r < 16; ++r) p0[r] = __builtin_amdgcn_exp2f(p0[r]);
}
__device__ __forceinline__ void finishSM(f32x16& p0, f32x16& p1, float alpha, float& l_reg, bf16x8& pa0, bf16x8& pa1, bf16x8& pa2, bf16x8& pa3) {
    for (int r = 0; r < 16; ++r) p1[r] = __builtin_amdgcn_exp2f(p1[r]);
    float ps = 0; for (int r = 0; r < 16; ++r) ps += p0[r]; for (int r = 0; r < 16; ++r) ps += p1[r];
    { auto rr = __builtin_amdgcn_permlane32_swap(__float_as_uint(ps), __float_as_uint(ps), false, false);
      ps = __uint_as_float(rr[0]) + __uint_as_float(rr[1]); }
    l_reg = l_reg * alpha + ps;
#define PK4(P, B_, OUT) do { unsigned a0 = cvtpk(P[B_+0], P[B_+1]), a1 = cvtpk(P[B_+2], P[B_+3]);                          \
        unsigned b0 = cvtpk(P[B_+4], P[B_+5]), b1 = cvtpk(P[B_+6], P[B_+7]);                                             \
        auto r0 = __builtin_amdgcn_permlane32_swap(a0, b0, false, false); auto r1 = __builtin_amdgcn_permlane32_swap(a1, b1, false, false); \
        u32x4 w = {r0[0], r1[0], r0[1], r1[1]}; OUT = *reinterpret_cast<bf16x8*>(&w); } while (0)
    PK4(p0, 0, pa0); PK4(p0, 8, pa1); PK4(p1, 0, pa2); PK4(p1, 8, pa3);
#undef PK4
}
template <int KB, bool SK>
__device__ __forceinline__ void qkt(f32x16& p0, f32x16& p1, const char* K_lds, int r32, int hi, const bf16x8* qr, bool act) {
    if (SK && !act) { const float NEG = -__builtin_inff();
#pragma unroll
        for (int r = 0; r < 16; ++r) { p0[r] = NEG; p1[r] = NEG; } return; }
    p0 = f32x16{}; p1 = f32x16{};
    const char* kb[4];
#pragma unroll
    for (int dd = 0; dd < 4; ++dd) kb[dd] = K_lds + KB * SHM_K + KSWZ(r32, (dd * 16 + hi * 8) * 2);
#pragma unroll
    for (int d0 = 0; d0 < 8; ++d0) { const char* a = kb[d0 & 3] + (d0 >> 2) * 128;
        bf16x8 b0 = *reinterpret_cast<const bf16x8*>(a);
        bf16x8 b1 = *reinterpret_cast<const bf16x8*>(a + 32 * 256);
        p0 = __builtin_amdgcn_mfma_f32_32x32x16_bf16(b0, qr[d0], p0, 0, 0, 0);
        p1 = __builtin_amdgcn_mfma_f32_32x32x16_bf16(b1, qr[d0], p1, 0, 0, 0); }
}
template <int VB, bool SK>
__device__ __forceinline__ void pv_tile(f32x16* o, int vb0, bf16x8 pa0, bf16x8 pa1, bf16x8 pa2, bf16x8 pa3, bool act) {
    if (SK && !act) return;
#define TRRD(dst, off) asm volatile("ds_read_b64_tr_b16 %0, %1 offset:%2" : "=&v"(dst) : "v"(vb0), "i"(off) : "memory")
#define PV_D0(d0) do { s16x4 l0, l1, l2, l3, h0, h1, h2, h3; constexpr int b_ = VB * SHM_V + v_rd_off(d0, 0, 0);     \
        TRRD(l0, b_); TRRD(h0, b_ + 2048); TRRD(l1, b_ + 4096); TRRD(h1, b_ + 6144); TRRD(l2, b_ + 8192); TRRD(h2, b_ + 10240); TRRD(l3, b_ + 12288); TRRD(h3, b_ + 14336); \
        asm volatile("s_waitcnt lgkmcnt(0)" ::: "memory"); SBAR();                 \
        o[d0] = __builtin_amdgcn_mfma_f32_32x32x16_bf16(pa0, (bf16x8){l0[0], l0[1], l0[2], l0[3], h0[0], h0[1], h0[2], h0[3]}, o[d0], 0, 0, 0);   \
        o[d0] = __builtin_amdgcn_mfma_f32_32x32x16_bf16(pa1, (bf16x8){l1[0], l1[1], l1[2], l1[3], h1[0], h1[1], h1[2], h1[3]}, o[d0], 0, 0, 0);   \
        o[d0] = __builtin_amdgcn_mfma_f32_32x32x16_bf16(pa2, (bf16x8){l2[0], l2[1], l2[2], l2[3], h2[0], h2[1], h2[2], h2[3]}, o[d0], 0, 0, 0);   \
        o[d0] = __builtin_amdgcn_mfma_f32_32x32x16_bf16(pa3, (bf16x8){l3[0], l3[1], l3[2], l3[3], h3[0], h3[1], h3[2], h3[3]}, o[d0], 0, 0, 0); } while (0)
    PV_D0(0); PV_D0(1); PV_D0(2); PV_D0(3);
#undef PV_D0
#undef TRRD
}

template <class TIn, class TOut> struct BlockRef { const TIn* Q; const TIn* K; const TIn* V; TOut* O; int P0; };
template <class TIn> struct Seam {
    bf16x8 qr[8];
    bf16x8 st_v0, st_v1, st_k0, st_k1; f32x4 sf0, sf1, sf2, sf3;
    f32x4 tq[16];
};
__device__ __forceinline__ int swa_jlo(int P0, int W) { const int lowk = P0 - W + 1; return lowk > 0 ? lowk / KVBLK : 0; }
#define ROW(p, k0, rr) ((p) + (size_t)((k0) + (rr)) * LDKV + sc)
#define VMW() asm volatile("s_waitcnt vmcnt(0)" ::: "memory")
#define VMWN(n) asm volatile("s_waitcnt vmcnt(%0)" :: "i"(n) : "memory")
#define SLOAD_H(Kp, Vp, k0) do { S.st_v0 = load8<TIn>(ROW(Vp, k0, sr)); S.st_v1 = load8<TIn>(ROW(Vp, k0, 32 + sr));              \
                         S.st_k0 = load8<TIn>(ROW(Kp, k0, sr)); S.st_k1 = load8<TIn>(ROW(Kp, k0, 32 + sr)); } while (0)
#define SWRITE_HK(bf) do { *(bf16x8*)(K_lds + (bf) * SHM_K + kws) = S.st_k0; *(bf16x8*)(K_lds + (bf) * SHM_K + kws + 32 * 256) = S.st_k1; } while (0)
#define SWRITE_HV(bf) do { *(bf16x8*)(V_lds + (bf) * SHM_V + vst0) = S.st_v0; *(bf16x8*)(V_lds + (bf) * SHM_V + vst1) = S.st_v1; } while (0)
#define SWRITE_H(bf) do { SWRITE_HV(bf); SWRITE_HK(bf); } while (0)
#define SLOAD_F(p, k0) do { S.sf0 = *(const f32x4*)ROW(p, k0, sr); S.sf1 = *(const f32x4*)(ROW(p, k0, sr) + 4);                \
                            S.sf2 = *(const f32x4*)ROW(p, k0, 32 + sr); S.sf3 = *(const f32x4*)(ROW(p, k0, 32 + sr) + 4); } while (0)
#define SWRITE_KF(bf) do { *(bf16x8*)(K_lds + (bf) * SHM_K + kws) = pack8(S.sf0, S.sf1); *(bf16x8*)(K_lds + (bf) * SHM_K + kws + 32 * 256) = pack8(S.sf2, S.sf3); } while (0)
#define SWRITE_VF(bf) do { *(bf16x8*)(V_lds + (bf) * SHM_V + vst0) = pack8(S.sf0, S.sf1); *(bf16x8*)(V_lds + (bf) * SHM_V + vst1) = pack8(S.sf2, S.sf3); } while (0)
template <class TIn, class TOut>
__device__ __forceinline__ void causal_swa_prime(const BlockRef<TIn, TOut>& cur, int W, char* lds, Seam<TIn>& S) {
    constexpr bool F32 = same_t<TIn, float>::v;
    const int tid = opaque_tid(), wid = __builtin_amdgcn_readfirstlane(tid >> 6), lane = tid & 63, r32 = lane & 31, hi = lane >> 5;
    const int sr = tid >> 4, sc = (tid & 15) * 8, kws = KSWZ(sr, sc * 2); char* K_lds = lds + 2 * SHM_V;
    const int kb0 = swa_jlo(cur.P0, W) * KVBLK;
    for (int d0 = 0; d0 < 8; ++d0) S.qr[d0] = load8<TIn>(cur.Q + (size_t)(wid * QBLK + r32) * LDQ + d0 * 16 + hi * 8);
    if constexpr (F32) { SLOAD_F((const float*)cur.K, kb0); VMW(); SWRITE_KF(0); SBAR(); SLOAD_F((const float*)cur.V, kb0); }
    else { SLOAD_H(cur.K, cur.V, kb0); VMW(); SWRITE_HK(0); }
    __syncthreads();
}
template <class TIn, class TOut>
__device__ __forceinline__ void causal_swa_block(const BlockRef<TIn, TOut>& cur, const BlockRef<TIn, TOut>& nxt, int skv, int W, char* lds, Seam<TIn>& S) {
    constexpr bool F32 = same_t<TIn, float>::v;
    const int tid = opaque_tid(), wid = __builtin_amdgcn_readfirstlane(tid >> 6), lane = tid & 63, r32 = lane & 31, hi = lane >> 5;
    const int j_lo = swa_jlo(cur.P0, W);
    int j_hi = (cur.P0 + QB - 1) / KVBLK + 1; if (j_hi > skv / KVBLK) j_hi = skv / KVBLK;
    const int NT = j_hi - j_lo;
    const int kbn = swa_jlo(nxt.P0, W) * KVBLK;
    const int qlo = cur.P0 + wid * QBLK, qm = qlo + r32 - 4 * hi;
    char* V_lds = lds; char* K_lds = lds + 2 * SHM_V;
    float* ws = (float*)(lds + 2 * SHM_V + 2 * SHM_K) + wid * 64; float* li_l = ws, * al_l = ws + 32;
    float m_reg = -1e30f, l_reg = 0; f32x16 o[4] = {};
    const int sr = tid >> 4, sc = (tid & 15) * 8, vst0 = v_st(sr, sc), vst1 = v_st(32 + sr, sc), kws = KSWZ(sr, sc * 2);
    const int vb0 = (int)(uintptr_t)V_lds + v_rd_base(lane);
    const TIn* Kh = cur.K; const TIn* Vh = cur.V;
#define RESC(a) do { if (__any((a) < 1.f)) { if (hi == 0) al_l[r32] = (a); asm volatile("s_waitcnt lgkmcnt(0)" ::: "memory");              \
                     for (int d_ = 0; d_ < 4; ++d_) for (int r = 0; r < 16; ++r) o[d_][r] *= al_l[crow(r, hi)]; } } while (0)
#define KBASE(t) ((j_lo + (t)) * KVBLK)
#define ACT(t) (KBASE(t) <= qlo + QBLK - 1 && KBASE(t) + KVBLK - 1 >= qlo - W + 1)
#define MASKT(P0_, P1_, t) do { const int kb_ = KBASE(t); if ((!SK || ACT(t)) && (kb_ + KVBLK - 1 > qlo || kb_ <= qlo + QBLK - 1 - W)) mask_tile(P0_, P1_, qm - kb_, (unsigned)W); } while (0)
    constexpr int NQL = F32 ? 16 : 8;
    constexpr bool SK = WSKIP && !F32;
#define SEAM_K0() do { VMWN(NQL); if constexpr (F32) { SWRITE_KF(0); SBAR(); SLOAD_F((const float*)nxt.V, kbn); } else { SWRITE_HK(0); } SBAR(); } while (0)
    f32x16 pA0, pA1, pB0, pB1; float mnA, mnB, alA, alB; bf16x8 pa0, pa1, pa2, pa3;
    if constexpr (F32) { VMW(); SWRITE_VF(0); SBAR(); } else { SWRITE_HV(0); SBAR(); }
    if (NT > 1) { if constexpr (F32) SLOAD_F((const float*)Kh, KBASE(1)); else SLOAD_H(Kh, Vh, KBASE(1)); }
    SBAR(); qkt<0, SK>(pA0, pA1, K_lds, r32, hi, S.qr, ACT(0));
    if constexpr (F32) { if (NT > 1) { VMW(); SWRITE_KF(1); SBAR(); SLOAD_F((const float*)Vh, KBASE(1)); } }
    MASKT(pA0, pA1, 0); partialSM(pA0, pA1, m_reg, mnA, alA);
    if (NT > 1) { VMW(); if constexpr (F32) { SWRITE_VF(1); SBAR(); if (NT > 2) SLOAD_F((const float*)Kh, KBASE(2)); } else SWRITE_H(1); }
    __syncthreads();
#define HALF_STEP(PX0, PX1, mnX, alX, PY0, PY1, alY, t, KB, VB, SB) do {                                                      \
        SBAR(); qkt<KB, SK>(PX0, PX1, K_lds, r32, hi, S.qr, ACT(t));                                             \
        finishSM(PY0, PY1, alY, l_reg, pa0, pa1, pa2, pa3); SBAR();                                                           \
        if ((t) + 1 < NT) { if constexpr (F32) { VMW(); SWRITE_KF(SB); SBAR(); SLOAD_F((const float*)Vh, KBASE((t) + 1)); }  \
                            else { SLOAD_H(Kh, Vh, KBASE((t) + 1)); } SBAR(); }                                               \
        pv_tile<VB, SK>(o, vb0, pa0, pa1, pa2, pa3, ACT((t) - 1)); MASKT(PX0, PX1, (t)); partialSM(PX0, PX1, m_reg, mnX, alX);                                        \
        __syncthreads();                                                                                                      \
        if ((t) + 1 < NT) { VMW(); if constexpr (F32) { SWRITE_VF(SB); SBAR(); if ((t) + 2 < NT) SLOAD_F((const float*)Kh, KBASE((t) + 2)); } \
                            else { SWRITE_H(SB); } }                                                                          \
        RESC(alX); __syncthreads(); } while (0)
    for (int t = 1; t + 1 < NT; t += 2) {
        HALF_STEP(pB0, pB1, mnB, alB, pA0, pA1, alA, t, 1, 0, 0);
        HALF_STEP(pA0, pA1, mnA, alA, pB0, pB1, alB, t + 1, 0, 1, 1);
    }
    const bool even = (NT & 1) == 0;
    if (even) { SBAR(); qkt<1, SK>(pB0, pB1, K_lds, r32, hi, S.qr, ACT(NT - 1)); SBAR(); }
#define QROW(e) (nxt.Q + (size_t)(wid * QBLK + r32) * LDQ + ((e) >> 1) * 16 + hi * 8 + ((e) & 1) * 4)
    if constexpr (F32) { SLOAD_F((const float*)nxt.K, kbn); SBAR();
#pragma unroll
        for (int e = 0; e < 8; ++e) S.tq[e] = *(const f32x4*)QROW(e); }
    else { SLOAD_H(nxt.K, nxt.V, kbn); SBAR();
#pragma unroll
        for (int d0 = 0; d0 < 8; ++d0) S.qr[d0] = load8<TIn>(nxt.Q + (size_t)(wid * QBLK + r32) * LDQ + d0 * 16 + hi * 8); }
    SBAR();
    finishSM(pA0, pA1, alA, l_reg, pa0, pa1, pa2, pa3); SBAR();
    if constexpr (F32) {
#pragma unroll
        for (int e = 8; e < 16; ++e) S.tq[e] = *(const f32x4*)QROW(e); SBAR(); }
#undef QROW
    pv_tile<0, SK>(o, vb0, pa0, pa1, pa2, pa3, ACT(even ? NT - 2 : NT - 1));
    if (even) { MASKT(pB0, pB1, NT - 1); partialSM(pB0, pB1, m_reg, mnB, alB); __syncthreads(); RESC(alB);
        finishSM(pB0, pB1, alB, l_reg, pa0, pa1, pa2, pa3); SBAR(); pv_tile<1, SK>(o, vb0, pa0, pa1, pa2, pa3, ACT(NT - 1)); }
    SBAR(); SEAM_K0();
    if (hi == 0) li_l[r32] = l_reg; asm volatile("s_waitcnt lgkmcnt(0)" ::: "memory");
    float rli[16];
#pragma unroll
    for (int r = 0; r < 16; ++r) rli[r] = __builtin_amdgcn_rcpf(li_l[crow(r, hi)]);
    TOut* Ow = cur.O + (size_t)(wid * QBLK) * LDO;
#pragma unroll
    for (int r = 0; r < 16; ++r) { const int orow = crow(r, hi);
#pragma unroll
        for (int d0 = 0; d0 < 4; ++d0) { const float v = o[d0][r] * rli[r];
            if constexpr (same_t<TOut, float>::v) { Ow[(size_t)orow * LDO + d0 * 32 + r32] = v; }
            else { const float vn = __shfl_xor(v, 1);
                   if ((r32 & 1) == 0) *(unsigned*)(Ow + (size_t)orow * LDO + d0 * 32 + r32) = cvtpk(v, vn); } } }
    if constexpr (F32) {
#pragma unroll
        for (int d0 = 0; d0 < 8; ++d0) S.qr[d0] = pack8(S.tq[2 * d0], S.tq[2 * d0 + 1]); }
    __syncthreads();
#undef RESC
#undef KBASE
#undef ACT
#undef MASKT
#undef SEAM_K0
#undef HALF_STEP
}
#undef ROW
#undef VMW
#undef VMWN
#undef SLOAD_H
#undef SWRITE_HK
#undef SWRITE_HV
#undef SWRITE_H
#undef SLOAD_F
#undef SWRITE_KF
#undef SWRITE_VF

#ifndef ATTA_LATE_FROM
#define ATTA_LATE_FROM 4
#endif
#ifndef ATTA_LATE_ODD
#define ATTA_LATE_ODD 0
#endif
#ifndef ATTA_STAMP_WAVE
#define ATTA_STAMP_WAVE 7
#endif
#ifndef ATTA_STAMP_SEL
#define ATTA_STAMP_SEL 0
#endif
#ifndef ATTA_STAMP
#define ATTA_STAMP 0
#endif
#ifndef ATTA_PRIO
#define ATTA_PRIO 1
#endif
#ifndef ATTA_T64
#define ATTA_T64 0
#endif
#ifndef ATTA_VPF
#define ATTA_VPF 1
#endif
#ifndef ATTA_PINGPONG
#define ATTA_PINGPONG 0
#endif
constexpr int SHM_V2 = KVBLK * 256 * 2;
constexpr int NVB = 3;
constexpr int LDS2_BYTES = NVB * SHM_V2 + 2 * SHM_K;
struct Blk2 { const bf16* Q; const bf16* K; const bf16* V; bf16* O; int P0; unsigned long long* stamp; };

template <int HF>
__device__ __forceinline__ void pv_half(f32x16 (&o)[8], const bf16x8& pa0, const bf16x8& pa1, int vb) {
#define TRRD(dst, off) asm volatile("ds_read_b64_tr_b16 %0, %1 offset:%2" : "=&v"(dst) : "v"(vb), "i"(off) : "memory")
#define RD4(l0, h0, l1, h1, d0) do { constexpr int b_ = ((d0) >> 2) * 16384 + ((d0) & 3) * 512 + HF * 8192;     \
        TRRD(l0, b_); TRRD(h0, b_ + 2048); TRRD(l1, b_ + 4096); TRRD(h1, b_ + 6144); } while (0)
#define MM2(l0, h0, l1, h1, d0) do { if (ATTA_PRIO == 2) __builtin_amdgcn_s_setprio(1); \
        o[d0] = __builtin_amdgcn_mfma_f32_32x32x16_bf16(pa0, (bf16x8){l0[0], l0[1], l0[2], l0[3], h0[0], h0[1], h0[2], h0[3]}, o[d0], 0, 0, 0); \
        o[d0] = __builtin_amdgcn_mfma_f32_32x32x16_bf16(pa1, (bf16x8){l1[0], l1[1], l1[2], l1[3], h1[0], h1[1], h1[2], h1[3]}, o[d0], 0, 0, 0); if (ATTA_PRIO == 2) __builtin_amdgcn_s_setprio(0); } while (0)
#define LWAIT() do { asm volatile("s_waitcnt lgkmcnt(0)" ::: "memory"); SBAR(); } while (0)
#if ATTA_VPF == 2
#define LWAIT4() do { asm volatile("s_waitcnt lgkmcnt(4)" ::: "memory"); SBAR(); } while (0)
    s16x4 a0, a1, a2, a3, b0, b1, b2, b3, c0, c1, c2, c3;
    RD4(a0, a1, a2, a3, 0); RD4(b0, b1, b2, b3, 1);
    LWAIT4(); RD4(c0, c1, c2, c3, 2); SBAR(); MM2(a0, a1, a2, a3, 0); SBAR();
    LWAIT4(); RD4(a0, a1, a2, a3, 3); SBAR(); MM2(b0, b1, b2, b3, 1); SBAR();
    LWAIT4(); RD4(b0, b1, b2, b3, 4); SBAR(); MM2(c0, c1, c2, c3, 2); SBAR();
    LWAIT4(); RD4(c0, c1, c2, c3, 5); SBAR(); MM2(a0, a1, a2, a3, 3); SBAR();
    LWAIT4(); RD4(a0, a1, a2, a3, 6); SBAR(); MM2(b0, b1, b2, b3, 4); SBAR();
    LWAIT4(); RD4(b0, b1, b2, b3, 7); SBAR(); MM2(c0, c1, c2, c3, 5); SBAR();
    LWAIT4(); MM2(a0, a1, a2, a3, 6); SBAR();
    LWAIT(); MM2(b0, b1, b2, b3, 7);
#undef LWAIT4
#else
    s16x4 a0, a1, a2, a3, b0, b1, b2, b3;
    RD4(a0, a1, a2, a3, 0);
    LWAIT(); RD4(b0, b1, b2, b3, 1); SBAR(); MM2(a0, a1, a2, a3, 0); SBAR();
    LWAIT(); RD4(a0, a1, a2, a3, 2); SBAR(); MM2(b0, b1, b2, b3, 1); SBAR();
    LWAIT(); RD4(b0, b1, b2, b3, 3); SBAR(); MM2(a0, a1, a2, a3, 2); SBAR();
    LWAIT(); RD4(a0, a1, a2, a3, 4); SBAR(); MM2(b0, b1, b2, b3, 3); SBAR();
    LWAIT(); RD4(b0, b1, b2, b3, 5); SBAR(); MM2(a0, a1, a2, a3, 4); SBAR();
    LWAIT(); RD4(a0, a1, a2, a3, 6); SBAR(); MM2(b0, b1, b2, b3, 5); SBAR();
    LWAIT(); RD4(b0, b1, b2, b3, 7); SBAR(); MM2(a0, a1, a2, a3, 6); SBAR();
    LWAIT(); MM2(b0, b1, b2, b3, 7);
#endif
#undef LWAIT
#undef MM2
#undef RD4
#undef TRRD
}

template <int BF, bool LATE>
__device__ __forceinline__ void fullv_tile(f32x16 (&o)[8], float& m_reg, float& l_reg, const bf16x8 (&qr)[8], const char* K_lds, int vcur, int vprev, float* al_l, int t, int qlo, int qm, int r32, int hi,
                                           char* pp_l, unsigned long long (&st)[6]) {
    constexpr float C2 = 1.4426950408889634f * SCALE;
    const char* kb[4];
#pragma unroll
    for (int dd = 0; dd < 4; ++dd) kb[dd] = K_lds + BF * SHM_K + KSWZ(r32, (dd * 16 + hi * 8) * 2);
#pragma unroll
    for (int hf = 0; hf < 2; ++hf) {
        if constexpr (LATE) { const bf16x8 q0 = *(const bf16x8*)pp_l, q1 = *(const bf16x8*)(pp_l + 1024);
            if (hf == 0) pv_half<1>(o, q0, q1, vprev); else pv_half<0>(o, q0, q1, vcur); }
        const int kbase = t * KVBLK + hf * 32;
        if (kbase > qlo + QBLK - 1) { if constexpr (LATE) { *(bf16x8*)pp_l = bf16x8{}; *(bf16x8*)(pp_l + 1024) = bf16x8{}; } continue; }
#if ATTA_STAMP
        const unsigned long long ts0 = __builtin_amdgcn_s_memtime();
#endif
        f32x16 p = f32x16{};
#pragma unroll
        for (int d0 = 0; d0 < 8; ++d0) { const bf16x8 kf = *reinterpret_cast<const bf16x8*>(kb[d0 & 3] + (d0 >> 2) * 128 + hf * (32 * 256));
            p = __builtin_amdgcn_mfma_f32_32x32x16_bf16(kf, qr[d0], p, 0, 0, 0); }
        if (kbase + 31 > qlo) {
            const float NEG = -__builtin_inff(); const int dq = qm - kbase;
#pragma unroll
            for (int r = 0; r < 16; ++r) { const int c = (r & 3) + 8 * (r >> 2); if (dq - c < 0) p[r] = NEG; } }
#if ATTA_STAMP
        asm volatile("" :: "v"(p[0]), "v"(p[15]) : "memory"); const unsigned long long ts1 = __builtin_amdgcn_s_memtime();
#endif
        float pmax = p[0];
#pragma unroll
        for (int r = 1; r < 16; ++r) pmax = fmaxf(pmax, p[r]);
        { auto rr = __builtin_amdgcn_permlane32_swap(__float_as_uint(pmax), __float_as_uint(pmax), false, false); pmax = fmaxf(__uint_as_float(rr[0]), __uint_as_float(rr[1])); }
        float mn = m_reg, alpha = 1.f;
        if (!__builtin_expect(__all((pmax - m_reg) * SCALE <= THR), 1)) { mn = fmaxf(m_reg, pmax); alpha = __builtin_amdgcn_exp2f((m_reg - mn) * C2); m_reg = mn; }
        if (__any(alpha < 1.f)) { if (hi == 0) al_l[r32] = alpha; asm volatile("s_waitcnt lgkmcnt(0)" ::: "memory");
#pragma unroll
            for (int d_ = 0; d_ < 8; ++d_)
#pragma unroll
                for (int r = 0; r < 16; ++r) { const float a_ = al_l[crow(r, hi)]; asm volatile("v_mul_f32 %0, %0, %1" : "+v"(o[d_][r]) : "v"(a_)); } }
        const float mnL = -mn * C2; float ps = 0.f;
#pragma unroll
        for (int r = 0; r < 16; ++r) { p[r] = __builtin_amdgcn_exp2f(fmaf(p[r], C2, mnL)); ps += p[r]; }
        { auto rr = __builtin_amdgcn_permlane32_swap(__float_as_uint(ps), __float_as_uint(ps), false, false); ps = __uint_as_float(rr[0]) + __uint_as_float(rr[1]); }
        l_reg = l_reg * alpha + ps;
        bf16x8 pa0, pa1;
#define PK4(P, B_, OUT) do { unsigned a0 = cvtpk(P[B_+0], P[B_+1]), a1 = cvtpk(P[B_+2], P[B_+3]); unsigned b0 = cvtpk(P[B_+4], P[B_+5]), b1 = cvtpk(P[B_+6], P[B_+7]); \
        auto r0 = __builtin_amdgcn_permlane32_swap(a0, b0, false, false); auto r1 = __builtin_amdgcn_permlane32_swap(a1, b1, false, false); \
        u32x4 w = {r0[0], r1[0], r0[1], r1[1]}; OUT = *reinterpret_cast<bf16x8*>(&w); } while (0)
        PK4(p, 0, pa0); PK4(p, 8, pa1);
#undef PK4
#if ATTA_STAMP
        asm volatile("" :: "v"(pa0), "v"(pa1) : "memory"); const unsigned long long ts2 = __builtin_amdgcn_s_memtime();
#endif
        if constexpr (LATE) { *(bf16x8*)pp_l = pa0; *(bf16x8*)(pp_l + 1024) = pa1; }
        else { if (hf == 0) pv_half<0>(o, pa0, pa1, vcur); else pv_half<1>(o, pa0, pa1, vcur); }
#if ATTA_STAMP
        { const unsigned long long ts3 = __builtin_amdgcn_s_memtime(); st[0] += ts1 - ts0; st[1] += ts2 - ts1; st[2] += ts3 - ts2; }
#endif
    }
}

template <int BF>
__device__ __forceinline__ void fullv_tile64(f32x16 (&o)[8], float& m_reg, float& l_reg, const bf16x8 (&qr)[8], const char* K_lds, int vcur, float* al_l, int t, int qlo, int qm, int r32, int hi) {
    constexpr float C2 = 1.4426950408889634f * SCALE;
    const int kbase = t * KVBLK;
    if (kbase > qlo + QBLK - 1) return;
    const char* kb[4];
#pragma unroll
    for (int dd = 0; dd < 4; ++dd) kb[dd] = K_lds + BF * SHM_K + KSWZ(r32, (dd * 16 + hi * 8) * 2);
    f32x16 p0 = f32x16{}, p1 = f32x16{};
#pragma unroll
    for (int d0 = 0; d0 < 8; ++d0) { const bf16x8 kf0 = *reinterpret_cast<const bf16x8*>(kb[d0 & 3] + (d0 >> 2) * 128), kf1 = *reinterpret_cast<const bf16x8*>(kb[d0 & 3] + (d0 >> 2) * 128 + 32 * 256);
        p0 = __builtin_amdgcn_mfma_f32_32x32x16_bf16(kf0, qr[d0], p0, 0, 0, 0); p1 = __builtin_amdgcn_mfma_f32_32x32x16_bf16(kf1, qr[d0], p1, 0, 0, 0); }
    if (kbase + 63 > qlo) {
        const float NEG = -__builtin_inff(); const int dq = qm - kbase;
#pragma unroll
        for (int r = 0; r < 16; ++r) { const int c = (r & 3) + 8 * (r >> 2); if (dq - c < 0) p0[r] = NEG; if (dq - 32 - c < 0) p1[r] = NEG; } }
    float pmax = fmaxf(p0[0], p1[0]);
#pragma unroll
    for (int r = 1; r < 16; ++r) pmax = fmaxf(pmax, fmaxf(p0[r], p1[r]));
    { auto rr = __builtin_amdgcn_permlane32_swap(__float_as_uint(pmax), __float_as_uint(pmax), false, false); pmax = fmaxf(__uint_as_float(rr[0]), __uint_as_float(rr[1])); }
    float mn = m_reg, alpha = 1.f;
    if (!__builtin_expect(__all((pmax - m_reg) * SCALE <= THR), 1)) { mn = fmaxf(m_reg, pmax); alpha = __builtin_amdgcn_exp2f((m_reg - mn) * C2); m_reg = mn; }
    if (__any(alpha < 1.f)) { if (hi == 0) al_l[r32] = alpha; asm volatile("s_waitcnt lgkmcnt(0)" ::: "memory");
#pragma unroll
        for (int d_ = 0; d_ < 8; ++d_)
#pragma unroll
            for (int r = 0; r < 16; ++r) { const float a_ = al_l[crow(r, hi)]; asm volatile("v_mul_f32 %0, %0, %1" : "+v"(o[d_][r]) : "v"(a_)); } }
    const float mnL = -mn * C2; float ps0 = 0.f, ps1 = 0.f;
#pragma unroll
    for (int r = 0; r < 16; ++r) { p0[r] = __builtin_amdgcn_exp2f(fmaf(p0[r], C2, mnL)); ps0 += p0[r]; p1[r] = __builtin_amdgcn_exp2f(fmaf(p1[r], C2, mnL)); ps1 += p1[r]; }
    float ps = ps0 + ps1;
    { auto rr = __builtin_amdgcn_permlane32_swap(__float_as_uint(ps), __float_as_uint(ps), false, false); ps = __uint_as_float(rr[0]) + __uint_as_float(rr[1]); }
    l_reg = l_reg * alpha + ps;
    bf16x8 pa0, pa1, pa2, pa3;
#define PK4(P, B_, OUT) do { unsigned a0 = cvtpk(P[B_+0], P[B_+1]), a1 = cvtpk(P[B_+2], P[B_+3]); unsigned b0 = cvtpk(P[B_+4], P[B_+5]), b1 = cvtpk(P[B_+6], P[B_+7]); \
        auto r0 = __builtin_amdgcn_permlane32_swap(a0, b0, false, false); auto r1 = __builtin_amdgcn_permlane32_swap(a1, b1, false, false); \
        u32x4 w = {r0[0], r1[0], r0[1], r1[1]}; OUT = *reinterpret_cast<bf16x8*>(&w); } while (0)
    PK4(p0, 0, pa0); PK4(p0, 8, pa1); PK4(p1, 0, pa2); PK4(p1, 8, pa3);
#undef PK4
    pv_half<0>(o, pa0, pa1, vcur); pv_half<1>(o, pa2, pa3, vcur);
}

template <bool LATE_>
__device__ __forceinline__ void causal_fullv_block_impl(const Blk2& cur, char* lds) {
    const int tid = opaque_tid(), wid = __builtin_amdgcn_readfirstlane(tid >> 6), lane = tid & 63, r32 = lane & 31, hi = lane >> 5;
    char* V_lds = lds; char* K_lds = lds + NVB * SHM_V2;
    float* ws = (float*)(lds + 132096) + wid * 64; float* li_l = ws; float* al_l = ws + 32;
    const int NT = (cur.P0 + QB) / KVBLK;
    const int qlo = cur.P0 + wid * QBLK, qm = qlo + r32 - 4 * hi;
    const int vb0 = (int)(uintptr_t)V_lds + v_rd_base(lane);
    unsigned koff[2];
#pragma unroll
    for (int e = 0; e < 2; ++e) { const int rl = 4 * e + (lane >> 4), c = (lane & 15) ^ (rl & 7); koff[e] = (unsigned)((8 * wid + rl) * LDKV + c * 8) * 2u; }
    const int kkl = (lane & 31) >> 2, klane = ((kkl >> 2) << 3) | (kkl & 3);
    const unsigned voff = (unsigned)((klane + 16 * (wid >> 1) + 4 * (wid & 1)) * LDKV + 32 * (lane >> 5) + 8 * (lane & 3)) * 2u;
    typedef __attribute__((address_space(3))) unsigned las_u32;
    las_u32* const lds3 = (las_u32*)lds;
#define GLDS(gp, lo) __builtin_amdgcn_global_load_lds((const unsigned*)(gp), (las_u32*)((__attribute__((address_space(3))) char*)lds3 + (lo)), 16, 0, 0)
#define DMA_TILE(k0, bf, vo) do { const char* kp_ = (const char*)(cur.K + (size_t)(k0) * LDKV); const char* vp_ = (const char*)(cur.V + (size_t)(k0) * LDKV) + voff; \
        GLDS(kp_ + koff[0], NVB * SHM_V2 + (bf) * SHM_K + 2048 * wid); GLDS(kp_ + koff[1], NVB * SHM_V2 + (bf) * SHM_K + 2048 * wid + 1024); \
        GLDS(vp_, (vo) + 2048 * wid); GLDS(vp_ + 128, (vo) + 2048 * wid + 1024); GLDS(vp_ + 256, (vo) + 16384 + 2048 * wid); GLDS(vp_ + 384, (vo) + 16384 + 2048 * wid + 1024); } while (0)
#define DMA_WAIT() asm volatile("s_waitcnt vmcnt(0)" ::: "memory")
    bf16x8 qr[8];
#pragma unroll
    for (int d0 = 0; d0 < 8; ++d0) qr[d0] = load8<bf16>(cur.Q + (size_t)(wid * QBLK + r32) * LDQ + d0 * 16 + hi * 8);
    DMA_TILE(0, 0, 0); DMA_WAIT();
    __syncthreads();
    float m_reg = -1e30f, l_reg = 0.f; f32x16 o[8];
#pragma unroll
    for (int d_ = 0; d_ < 8; ++d_) o[d_] = f32x16{};
    constexpr bool late = LATE_;
    char* pp_l = lds + 134144 + (ATTA_LATE_ODD ? (wid >> 1) : (wid & 3)) * 2048 + lane * 16;
    if (late) { *(bf16x8*)pp_l = bf16x8{}; *(bf16x8*)(pp_l + 1024) = bf16x8{}; }
    unsigned long long st[6] = {0, 0, 0, 0, 0, 0};
#if ATTA_STAMP
    const unsigned long long tb0 = __builtin_amdgcn_s_memtime();
#endif
    int vo_p = 0, vo_c = 0;
    if (!ATTA_PINGPONG && ATTA_PRIO == 1 && wid >= 4) __builtin_amdgcn_s_setprio(1);
#define NEXT_VO(v) ((v) == (NVB - 1) * SHM_V2 ? 0 : (v) + SHM_V2)
    for (int t = 0; t < NT; t += 2) {
        const int vo_n = NEXT_VO(vo_c), vo_nn = NEXT_VO(vo_n);
        DMA_TILE((t + 1) * KVBLK, 1, vo_n);
#if ATTA_T64
        fullv_tile64<0>(o, m_reg, l_reg, qr, K_lds, vb0 + vo_c, al_l, t, qlo, qm, r32, hi);
#else
        fullv_tile<0, LATE_>(o, m_reg, l_reg, qr, K_lds, vb0 + vo_c, vb0 + vo_p, al_l, t, qlo, qm, r32, hi, pp_l, st);
#endif
#if ATTA_STAMP
        { const unsigned long long tw0 = __builtin_amdgcn_s_memtime(); DMA_WAIT(); const unsigned long long tw1 = __builtin_amdgcn_s_memtime(); __syncthreads(); const unsigned long long tw2 = __builtin_amdgcn_s_memtime(); st[3] += tw1 - tw0; st[5] += tw2 - tw1; }
#else
        DMA_WAIT();
        __syncthreads();
#endif
        if (t + 2 < NT) DMA_TILE((t + 2) * KVBLK, 0, vo_nn);
#if ATTA_T64
        fullv_tile64<1>(o, m_reg, l_reg, qr, K_lds, vb0 + vo_n, al_l, t + 1, qlo, qm, r32, hi);
#else
        fullv_tile<1, LATE_>(o, m_reg, l_reg, qr, K_lds, vb0 + vo_n, vb0 + vo_c, al_l, t + 1, qlo, qm, r32, hi, pp_l, st);
#endif
#if ATTA_STAMP
        { const unsigned long long tw0 = __builtin_amdgcn_s_memtime(); DMA_WAIT(); const unsigned long long tw1 = __builtin_amdgcn_s_memtime(); __syncthreads(); const unsigned long long tw2 = __builtin_amdgcn_s_memtime(); st[3] += tw1 - tw0; st[5] += tw2 - tw1; }
#else
        DMA_WAIT();
        __syncthreads();
#endif
        vo_p = vo_n; vo_c = vo_nn;
    }
    if (late) { const bf16x8 q0 = *(const bf16x8*)pp_l, q1 = *(const bf16x8*)(pp_l + 1024); pv_half<1>(o, q0, q1, vb0 + vo_p); }
#undef NEXT_VO
#undef DMA_TILE
#undef DMA_WAIT
#undef GLDS
#undef NEXT_VO
    __builtin_amdgcn_s_setprio(0);
#if ATTA_STAMP
    if (blockIdx.x == 0 && wid == ATTA_STAMP_WAVE && lane == 0) { atomicAdd(cur.stamp + 0, st[0]); atomicAdd(cur.stamp + 1, st[1]); atomicAdd(cur.stamp + 2, st[2]); atomicAdd(cur.stamp + 3, st[3]); atomicAdd(cur.stamp + 5, st[5]); atomicAdd(cur.stamp + 4, __builtin_amdgcn_s_memtime() - tb0); }
#endif
    if (ATTA_PINGPONG) __syncthreads();
    if (hi == 0) li_l[r32] = l_reg; asm volatile("s_waitcnt lgkmcnt(0)" ::: "memory");
    char* stg = lds + wid * 16384;
#pragma unroll
    for (int r = 0; r < 16; ++r) { const float rl = __builtin_amdgcn_rcpf(li_l[crow(r, hi)]); const int orow = crow(r, hi);
#pragma unroll
        for (int d0 = 0; d0 < 8; ++d0) { const float v = o[d0][r] * rl; *(unsigned short*)(stg + orow * 512 + (d0 * 32 + r32) * 2) = (unsigned short)cvtpk(v, v); } }
    asm volatile("s_waitcnt lgkmcnt(0)" ::: "memory");
    bf16* Ow = cur.O + (size_t)(wid * QBLK) * LDO;
#pragma unroll
    for (int i = 0; i < 16; ++i) { const int row = 2 * i + (lane >> 5), ch = lane & 31;
        const u32x4 v = *(const u32x4*)(stg + row * 512 + ch * 16); store16_wt(Ow + (size_t)row * LDO + ch * 8, v); }
    __syncthreads();
}
__device__ __forceinline__ void causal_fullv_block(const Blk2& cur, char* lds) {
    const int wid_ = __builtin_amdgcn_readfirstlane(opaque_tid() >> 6);
    if (ATTA_PINGPONG && (ATTA_LATE_ODD ? (wid_ & 1) != 0 : wid_ >= ATTA_LATE_FROM)) causal_fullv_block_impl<true>(cur, lds); else causal_fullv_block_impl<false>(cur, lds);
}
#undef KSWZ
#undef SBAR
}

namespace attB {
typedef short bf16x8 __attribute__((ext_vector_type(8)));
typedef short s16x4 __attribute__((ext_vector_type(4)));
typedef float f32x16 __attribute__((ext_vector_type(16)));
typedef unsigned u32x4 __attribute__((ext_vector_type(4)));
typedef unsigned short bf16_t;
constexpr int HD = 64, LD = NQKV_B, KOFF = 2048, VOFF = 2304, LDO = DM;
constexpr int LDS_K = 0, LDS_V = 32768, LDS_S = 65536, LDS_O = 69632, LDS_BYTES = LDS_O + 8 * 4096;
constexpr float C2 = 0.125f * 1.4426950408889634f;
__device__ __forceinline__ int crow(int r, int hi) { return (r & 3) + 8 * (r >> 2) + 4 * hi; }
__device__ __forceinline__ unsigned cvtpk(float lo, float hi) { unsigned r; asm volatile("v_cvt_pk_bf16_f32 %0, %1, %2" : "=v"(r) : "v"(lo), "v"(hi)); return r; }
typedef short v4i16_t __attribute__((ext_vector_type(4)));
__device__ __forceinline__ s16x4 vtr(LAS const unsigned char* p) { return __builtin_bit_cast(s16x4, __builtin_amdgcn_ds_read_tr16_b64_v4i16((LAS v4i16_t*)p)); }

__device__ __forceinline__ void swa_unit(int b, int kvh, int n, const bf16_t* __restrict__ QKV, const float* __restrict__ sinks, bf16_t* __restrict__ O, LAS unsigned char* lds) {
    const int tid = opaque_tid(), lane = tid & 63, r32 = lane & 31, hi = lane >> 5, wid = __builtin_amdgcn_readfirstlane(tid >> 6);
    __syncthreads();
    const size_t tok0 = (size_t)b * SEQ;
#pragma unroll
    for (int i = 0; i < 4; ++i) {
        const int c = tid + 512 * i, row = c >> 3, ch = c & 7, t = n * 128 - 128 + row;
        u32x4 kv = {0u, 0u, 0u, 0u}, vv = {0u, 0u, 0u, 0u};
        if (t >= 0) { const bf16_t* p = QKV + (tok0 + (size_t)t) * LD + kvh * HD + ch * 8; kv = *(const u32x4*)(p + KOFF); vv = *(const u32x4*)(p + VOFF); }
        *(LAS u32x4*)(lds + LDS_K + row * 128 + ((ch ^ ((row >> 1) & 7)) << 4)) = kv;
        *(LAS u32x4*)(lds + LDS_V + row * 128 + (ch << 4)) = vv;
    }
    __syncthreads();
    const int hq = kvh * 8 + wid;
    const float sink2 = sinks[hq] * 1.4426950408889634f;
    LAS float* scr = (LAS float*)(lds + LDS_S) + wid * 32;
    const int vq = (lane & 15) >> 2, vp = lane & 3, vg1 = (lane >> 4) & 1;
    LAS const unsigned char* vbase = lds + LDS_V + (4 * hi + vq) * 128 + (16 * vg1 + 4 * vp) * 2;
    const float NEG = -__builtin_inff();
    for (int qs = 0; qs < 4; ++qs) {
        const size_t tq = tok0 + (size_t)(n * 128 + 32 * qs + r32);
        bf16x8 qr[4];
#pragma unroll
        for (int d0 = 0; d0 < 4; ++d0) qr[d0] = *(const bf16x8*)(QKV + tq * LD + hq * HD + d0 * 16 + hi * 8);
        f32x16 p[5];
#pragma unroll
        for (int tt = 0; tt < 5; ++tt) {
            const int kt = qs + tt; const bool dead = (n == 0) && (kt < 4);
            p[tt] = f32x16{};
            if (!dead) { const int krow = kt * 32 + r32;
#pragma unroll
                for (int d0 = 0; d0 < 4; ++d0) { const bf16x8 kf = *(LAS const bf16x8*)(lds + LDS_K + krow * 128 + (((d0 * 2 + hi) ^ ((krow >> 1) & 7)) << 4));
                    p[tt] = __builtin_amdgcn_mfma_f32_32x32x16_bf16(kf, qr[d0], p[tt], 0, 0, 0); } }
#pragma unroll
            for (int r = 0; r < 16; ++r) { const int c = crow(r, hi); bool valid = !dead;
                if (tt == 0) valid = valid && (c > r32);
                if (tt == 4) valid = valid && (c <= r32);
                p[tt][r] = valid ? p[tt][r] * C2 : NEG; }
        }
        float mx = sink2;
#pragma unroll
        for (int tt = 0; tt < 5; ++tt)
#pragma unroll
            for (int r = 0; r < 16; ++r) mx = fmaxf(mx, p[tt][r]);
        mx = half_max32(mx);
        float sum = 0.f;
#pragma unroll
        for (int tt = 0; tt < 5; ++tt)
#pragma unroll
            for (int r = 0; r < 16; ++r) { const float e = __builtin_amdgcn_exp2f(p[tt][r] - mx); p[tt][r] = e; sum += e; }
        sum = half_sum32(sum);
        sum += __builtin_amdgcn_exp2f(sink2 - mx);
        if (hi == 0) scr[r32] = 1.0f / sum;
        f32x16 o[2]; o[0] = f32x16{}; o[1] = f32x16{};
#pragma unroll
        for (int tt = 0; tt < 5; ++tt) {
            const int kt = qs + tt; const bool dead = (n == 0) && (kt < 4);
            if (!dead) {
#pragma unroll
                for (int s = 0; s < 2; ++s) {
                    u32x4 w; w.x = cvtpk(p[tt][8 * s + 0], p[tt][8 * s + 1]); w.y = cvtpk(p[tt][8 * s + 2], p[tt][8 * s + 3]); w.z = cvtpk(p[tt][8 * s + 4], p[tt][8 * s + 5]); w.w = cvtpk(p[tt][8 * s + 6], p[tt][8 * s + 7]);
                    const bf16x8 pa = __builtin_bit_cast(bf16x8, w);
#pragma unroll
                    for (int d0 = 0; d0 < 2; ++d0) { LAS const unsigned char* vp_ = vbase + (kt * 32 + 16 * s) * 128 + d0 * 64;
                        const s16x4 lo = vtr(vp_), hh = vtr(vp_ + 8 * 128);
                        const bf16x8 vf = {lo[0], lo[1], lo[2], lo[3], hh[0], hh[1], hh[2], hh[3]};
                        o[d0] = __builtin_amdgcn_mfma_f32_32x32x16_bf16(pa, vf, o[d0], 0, 0, 0); }
                }
            }
        }
        bf16_t* Ow = O + (tok0 + (size_t)(n * 128 + 32 * qs)) * LDO + hq * HD;
        LAS unsigned char* stg = lds + LDS_O + wid * 4096;
#pragma unroll
        for (int r = 0; r < 16; ++r) { const int orow = crow(r, hi); const float ri = scr[orow];
#pragma unroll
            for (int d0 = 0; d0 < 2; ++d0) { const float v = o[d0][r] * ri; *(LAS unsigned short*)(stg + orow * 128 + (d0 * 32 + r32) * 2) = (unsigned short)cvtpk(v, v); } }
        asm volatile("s_waitcnt lgkmcnt(0)" ::: "memory");
#pragma unroll
        for (int i = 0; i < 4; ++i) { const int row = 8 * i + (lane >> 3), ch = lane & 7;
            const u32x4 v = *(LAS const u32x4*)(stg + row * 128 + ch * 16); store16_wt(Ow + (size_t)row * LDO + ch * 8, v); }
    }
}
}

constexpr int NWAVES = 8;
#ifndef MK_PER_PHASE
#define MK_PER_PHASE 0
#endif
constexpr int N_PHASES = 3 + 8 * DEPTH;

constexpr size_t MiB = 1u << 20;
constexpr size_t WS_CTL = 0, CTL_ZERO_BYTES = 1 * MiB;
constexpr size_t WS_STATS = 1198 * MiB;
constexpr size_t WS_MOD = 2 * MiB;
constexpr size_t WS_TABA = 3 * MiB;
constexpr size_t WS_TABB = 5 * MiB;
constexpr size_t WS_BPERM = 6 * MiB;
constexpr size_t WS_WUP = 8 * MiB, WS_WDN = 40 * MiB, WS_WMLP_STRIDE = 64 * MiB;
constexpr size_t WS_WQKVA = 264 * MiB, WS_WOA = 288 * MiB, WS_WA_STRIDE = 32 * MiB;
constexpr size_t WS_WQKVB = 328 * MiB, WS_WOB = 338 * MiB, WS_WB_STRIDE = 18 * MiB;
constexpr size_t WS_X = 364 * MiB;
constexpr size_t WS_HB = 492 * MiB;
constexpr size_t WS_QKV = 556 * MiB;
constexpr size_t WS_AO = 748 * MiB;
constexpr size_t WS_AC = 876 * MiB;
constexpr size_t WS_HID = 940 * MiB;
constexpr size_t WS_CS = 1196 * MiB, WS_CB = 1197 * MiB;
constexpr size_t WS_GN = 6 * MiB + 64 * 1024;
constexpr int CSTRIDE = 8192;
constexpr size_t WS_ZEROS = 768 * 1024;
constexpr size_t WS_ONES = 6 * MiB + 32 * 1024;
constexpr size_t WS_IDENT = 6 * MiB + 48 * 1024;
constexpr size_t WS_IG = 6 * MiB + 640 * 1024;
constexpr size_t WS_NEUTRAL = 1 * MiB;
constexpr size_t WS_PROBE = 7 * MiB;
constexpr size_t WS_QKVB = 1206 * MiB;
constexpr size_t WS_END = 1286 * MiB;
constexpr int CW_TMO = 0, CW_CODE = 1, CW_BAR = 4096;
constexpr int CW_PSUB = 16384, CW_PGEN = 20480;
constexpr int CW_XMASK = 8192, CW_LSUB = 8192 + 1024, CW_LGEN = 8192 + 2048;

constexpr int RING_OFF = 0, RING_BYTES = 131072;
constexpr int LDSCTL_OFF = RING_BYTES, MISC_OFF = LDSCTL_OFF + 320, STATTBL_OFF = LDSCTL_OFF + 1024;
constexpr int LDS_BYTES = 147456;
static_assert(attA::LDS_BYTES <= RING_BYTES && attA::LDS2_BYTES <= RING_BYTES && attB::LDS_BYTES <= RING_BYTES, "attention scratch fits the ring region");

struct Frame {
    LAS unsigned char* lds;
    volatile LAS unsigned* MISC;
    gu32* ctl;
    int vcu, G;
};
#define FR_IDS() const int f_tid = opaque_tid(), f_lane = f_tid & 63, f_wave = __builtin_amdgcn_readfirstlane(f_tid >> 6); (void)f_tid; (void)f_lane; (void)f_wave

__device__ __forceinline__ float wave_sum(float v) {
    v += lane_xor<1>(v); v += lane_xor<2>(v); v += lane_xor<4>(v); v += lane_xor<8>(v); v += lane_xor<16>(v);
    return half_sum32(v);
}
__device__ __forceinline__ float bf2f(unsigned short u) { return __uint_as_float((unsigned)u << 16); }

__device__ __forceinline__ int dest_row(int n, int mode) {
    if (mode == 1 && n < 4096) { const int j = n & 127; return (n & ~127) + (((j & 63) << 1) | (j >> 6)); }
    if (mode == 2 && n < 2304) { const int j = n & 63; return (n & ~63) + (((j & 31) << 1) | (j >> 5)); }
    return n;
}
struct ConvDesc { bf16* dst; int K, mode, n0, k0; };
__device__ __forceinline__ int kpos(int k, int mode) { return mode == 3 ? ((k & ~255) | (((((k >> 5) & 3) << 1) | ((k >> 7) & 1)) << 5) | (k & 31)) : k; }
#ifndef CONV_SHAPE
#define CONV_SHAPE 0
#endif
#if CONV_SHAPE == 0
__device__ __forceinline__ void conv_issue(const float* W, int K, int N, bf16* WT, int mode, int item, int lane, ConvDesc& D, float (&wv)[32]) {
    const int nblk = N / 32, kb = item / nblk, nb = item % nblk, k0 = 64 * kb, n0 = 32 * nb;
    const float* p = W + (size_t)(k0 + (lane >> 5)) * N + n0 + (lane & 31);
#pragma unroll
    for (int i = 0; i < 32; ++i) wv[i] = p[(size_t)(2 * i) * N];
    D.dst = WT; D.K = K; D.mode = mode; D.n0 = n0; D.k0 = k0;
}
__device__ __forceinline__ void conv_finish(const ConvDesc& D, const float (&wv)[32], LAS float* scr, int lane) {
#pragma unroll
    for (int i = 0; i < 32; ++i) { const int kk = 2 * i + (lane >> 5); scr[kk * 33 + (lane & 31)] = wv[i]; }
    LDS_WAIT(); asm volatile("" ::: "memory");
    const int c = lane & 7;
#pragma unroll
    for (int j = 0; j < 4; ++j) { const int n = (lane >> 3) + 8 * j; const LAS float* s = scr + (8 * c) * 33 + n;
        v4u o; o.x = pk2(s[0 * 33], s[1 * 33]); o.y = pk2(s[2 * 33], s[3 * 33]); o.z = pk2(s[4 * 33], s[5 * 33]); o.w = pk2(s[6 * 33], s[7 * 33]);
        *(GAS v4u*)(D.dst + (size_t)dest_row(D.n0 + n, D.mode) * D.K + kpos(D.k0 + 8 * c, D.mode)) = o; }
    LDS_WAIT(); asm volatile("" ::: "memory");
}
#else
__device__ __forceinline__ void conv_issue(const float* W, int K, int N, bf16* WT, int mode, int item, int lane, ConvDesc& D, float (&wv)[32]) {
    const int nblk = N / 64, kb = item / nblk, nb = item % nblk, k0 = 32 * kb, n0 = 64 * nb;
    const float* p = W + (size_t)k0 * N + n0 + lane;
#pragma unroll
    for (int i = 0; i < 32; ++i) wv[i] = p[(size_t)i * N];
    D.dst = WT; D.K = K; D.mode = mode; D.n0 = n0; D.k0 = k0;
}
__device__ __forceinline__ void conv_finish(const ConvDesc& D, const float (&wv)[32], LAS float* scr, int lane) {
#pragma unroll
    for (int i = 0; i < 32; ++i) scr[i * 65 + lane] = wv[i];
    LDS_WAIT(); asm volatile("" ::: "memory");
    const int c = lane & 3;
#pragma unroll
    for (int j = 0; j < 4; ++j) { const int n = (lane >> 2) + 16 * j; const LAS float* s = scr + (8 * c) * 65 + n;
        v4u o; o.x = pk2(s[0 * 65], s[1 * 65]); o.y = pk2(s[2 * 65], s[3 * 65]); o.z = pk2(s[4 * 65], s[5 * 65]); o.w = pk2(s[6 * 65], s[7 * 65]);
        *(GAS v4u*)(D.dst + (size_t)dest_row(D.n0 + n, D.mode) * D.K + kpos(D.k0 + 8 * c, D.mode)) = o; }
    LDS_WAIT(); asm volatile("" ::: "memory");
}
#endif
__device__ __forceinline__ void sincos_d(double x, double& sn, double& cs) {
    const double k = __builtin_rint(x * 0.63661977236758134308);
    double r = __builtin_fma(-k, 1.57079632673412561417e+00, x); r = __builtin_fma(-k, 6.07710050650619224932e-11, r);
    const double r2 = r * r;
    double ps = -1.0 / 1307674368000.0; ps = ps * r2 + 1.0 / 6227020800.0; ps = ps * r2 - 1.0 / 39916800.0; ps = ps * r2 + 1.0 / 362880.0; ps = ps * r2 - 1.0 / 5040.0; ps = ps * r2 + 1.0 / 120.0; ps = ps * r2 - 1.0 / 6.0; ps = ps * r2 * r + r;
    double pc = 1.0 / 20922789888000.0; pc = pc * r2 - 1.0 / 87178291200.0; pc = pc * r2 + 1.0 / 479001600.0; pc = pc * r2 - 1.0 / 3628800.0; pc = pc * r2 + 1.0 / 40320.0; pc = pc * r2 - 1.0 / 720.0; pc = pc * r2 + 1.0 / 24.0; pc = pc * r2 - 0.5; pc = pc * r2 + 1.0;
    const int q = (int)k & 3;
    sn = (q == 0) ? ps : (q == 1) ? pc : (q == 2) ? -ps : -pc;
    cs = (q == 0) ? pc : (q == 1) ? -ps : (q == 2) ? -pc : ps;
}
__device__ __forceinline__ void rope_entry(float* tab, int idx, int half, double base_ratio) {
    const int s = idx / half, j = idx % half;
    double inv = 1.0, rr = base_ratio;
    for (int t = j; t; t >>= 1) { if (t & 1) inv *= rr; rr *= rr; }
    const float invf = (float)inv, angf = (float)s * invf;
    double sn, cs; sincos_d((double)angf, sn, cs);
    tab[2 * (size_t)idx] = (float)cs; tab[2 * (size_t)idx + 1] = (float)sn;
}

struct Args { const float* in[22]; float* out; unsigned char* ws; int ph_lo, ph_hi; };
typedef __attribute__((address_space(4))) const Args CArgs;

constexpr int CONV_ITEMS = 4 * 16384 + 2 * 8192 + 2 * 4608;
constexpr int CONV_NOW = 16384 + 8192 + 4608;
constexpr int CONV_LATER = CONV_ITEMS - CONV_NOW;
__device__ __forceinline__ int now_item(int d) { return d < 16384 ? d : d < 24576 ? 65536 + (d - 16384) : 81920 + (d - 24576); }
__device__ __forceinline__ void convert_issue(CArgs* ap, int it, int lane, ConvDesc& D, float (&wv)[32]) {
    unsigned char* ws = ap->ws;
    int r = it; const float* W; bf16* WT; int K, N, mode = 0, item;
    if (r < 65536) { const int L = r >> 14, rr = r & 16383;
        if (rr < 8192) { W = ap->in[8] + (size_t)L * DM * DFF; K = DM; N = DFF; WT = (bf16*)(ws + WS_WUP + L * WS_WMLP_STRIDE); item = rr; }
        else { W = ap->in[9] + (size_t)L * DFF * DM; K = DFF; N = DM; WT = (bf16*)(ws + WS_WDN + L * WS_WMLP_STRIDE); item = rr - 8192; mode = HID_PERM ? 3 : 0; } }
    else { r -= 65536;
        if (r < 16384) { const int j = r >> 13, rr = r & 8191;
            if (rr < 6144) { W = ap->in[10] + (size_t)j * DM * NQKV_A; K = DM; N = NQKV_A; WT = (bf16*)(ws + WS_WQKVA + j * WS_WA_STRIDE); mode = 1; item = rr; }
            else { W = ap->in[11] + (size_t)j * DM * DM; K = DM; N = DM; WT = (bf16*)(ws + WS_WOA + j * WS_WA_STRIDE); item = rr - 6144; } }
        else { r -= 16384; const int j = r / 4608, rr = r % 4608;
            if (rr < 2560) { W = ap->in[17] + (size_t)j * DM * NQKV_B; K = DM; N = NQKV_B; WT = (bf16*)(ws + WS_WQKVB + j * WS_WB_STRIDE); mode = 2; item = rr; }
            else { W = ap->in[20] + (size_t)j * DM * DM; K = DM; N = DM; WT = (bf16*)(ws + WS_WOB + j * WS_WB_STRIDE); item = rr - 2560; } } }
    conv_issue(W, K, N, WT, mode, item, lane, D, wv);
}
#ifndef CONV_DMA
#define CONV_DMA 1
#endif
__device__ __forceinline__ void convert_decode(CArgs* ap, int it, const float*& Wo_, int& No_, ConvDesc& D) {
    unsigned char* ws = ap->ws;
    int r = it; const float* W; bf16* WT; int K, N, mode = 0, item;
    if (r < 65536) { const int L = r >> 14, rr = r & 16383;
        if (rr < 8192) { W = ap->in[8] + (size_t)L * DM * DFF; K = DM; N = DFF; WT = (bf16*)(ws + WS_WUP + L * WS_WMLP_STRIDE); item = rr; }
        else { W = ap->in[9] + (size_t)L * DFF * DM; K = DFF; N = DM; WT = (bf16*)(ws + WS_WDN + L * WS_WMLP_STRIDE); item = rr - 8192; mode = HID_PERM ? 3 : 0; } }
    else { r -= 65536;
        if (r < 16384) { const int j = r >> 13, rr = r & 8191;
            if (rr < 6144) { W = ap->in[10] + (size_t)j * DM * NQKV_A; K = DM; N = NQKV_A; WT = (bf16*)(ws + WS_WQKVA + j * WS_WA_STRIDE); mode = 1; item = rr; }
            else { W = ap->in[11] + (size_t)j * DM * DM; K = DM; N = DM; WT = (bf16*)(ws + WS_WOA + j * WS_WA_STRIDE); item = rr - 6144; } }
        else { r -= 16384; const int j = r / 4608, rr = r % 4608;
            if (rr < 2560) { W = ap->in[17] + (size_t)j * DM * NQKV_B; K = DM; N = NQKV_B; WT = (bf16*)(ws + WS_WQKVB + j * WS_WB_STRIDE); mode = 2; item = rr; }
            else { W = ap->in[20] + (size_t)j * DM * DM; K = DM; N = DM; WT = (bf16*)(ws + WS_WOB + j * WS_WB_STRIDE); item = rr - 2560; } } }
    const int nblk = N / 32, kb = item / nblk, nb = item % nblk;
    Wo_ = W; No_ = N; D.dst = WT; D.K = K; D.mode = mode; D.n0 = 32 * nb; D.k0 = 64 * kb;
}
__device__ __forceinline__ void conv_dma_issue(const float* W, int N, const ConvDesc& D, LAS unsigned char* buf, int lane) {
#pragma unroll
    for (int j = 0; j < 8; ++j) { const float* p = W + (size_t)(D.k0 + 8 * j + (lane >> 3)) * N + D.n0 + 4 * ((lane & 7) ^ j);
        __builtin_amdgcn_global_load_lds((const unsigned*)p, (LAS unsigned*)(buf + 1024 * j), 16, 0, 0); }
}
__device__ __forceinline__ void conv_dma_finish(const ConvDesc& D, LAS const float* buf, int lane) {
    const int c = lane & 7;
#pragma unroll
    for (int jj = 0; jj < 4; ++jj) { const int n = (lane >> 3) + 8 * jj; const LAS float* s = buf + (8 * c) * 32 + (((n >> 2) ^ c) << 2) + (n & 3);
        v4u o; o.x = pk2(s[0 * 32], s[1 * 32]); o.y = pk2(s[2 * 32], s[3 * 32]); o.z = pk2(s[4 * 32], s[5 * 32]); o.w = pk2(s[6 * 32], s[7 * 32]);
        *(GAS v4u*)(D.dst + (size_t)dest_row(D.n0 + n, D.mode) * D.K + kpos(D.k0 + 8 * c, D.mode)) = o; }
    LDS_WAIT(); asm volatile("" ::: "memory");
}
__device__ __forceinline__ void convert_item(CArgs* ap, int it, LAS float* scr, int lane) {
    ConvDesc D; float wv[32]; convert_issue(ap, it, lane, D, wv); conv_finish(D, wv, scr, lane);
}
#ifndef CONV_NCH
#define CONV_NCH 4
#endif
constexpr int CONV_CHUNKS = CONV_NCH;
__device__ __forceinline__ int deferred_item(int d) { return d < 49152 ? 16384 + d : d < 57344 ? 73728 + (d - 49152) : 86528 + (d - 57344); }
__device__ __forceinline__ void convert_chunk(CArgs* ap, char* ring, int q) {
    FR_IDS();
#if CONV_PROBE
    if (f_tid == 0) *(unsigned long long*)(ring + 140000) = __builtin_amdgcn_s_memrealtime();
#endif
    LAS float* scr = (LAS float*)(ring + f_wave * 16384);
    const int gw = (int)blockIdx.x * NWAVES + f_wave, NGW = (int)gridDim.x * NWAVES;
    constexpr int PER = (CONV_LATER + 2048 * CONV_CHUNKS - 1) / (2048 * CONV_CHUNKS);
    const int per = (NGW == 2048) ? PER : (CONV_LATER + NGW * CONV_CHUNKS - 1) / (NGW * CONV_CHUNKS);
    const int d0 = gw + NGW * (q * per);
#if CONV_DMA
    {
        LAS unsigned char* bufs = (LAS unsigned char*)scr;
        ConvDesc dc[2]; const float* Wp; int Np;
        bool h0_ = d0 < CONV_LATER, h1_ = false;
        if (h0_) { convert_decode(ap, deferred_item(d0), Wp, Np, dc[0]); conv_dma_issue(Wp, Np, dc[0], bufs, f_lane); }
#pragma unroll 1
        for (int jj = 0; jj < per; jj += 2) {
            const int d1 = d0 + NGW * (jj + 1), d2 = d0 + NGW * (jj + 2);
            h1_ = (jj + 1 < per) && d1 < CONV_LATER;
            if (h1_) { convert_decode(ap, deferred_item(d1), Wp, Np, dc[1]); conv_dma_issue(Wp, Np, dc[1], bufs + 8192, f_lane); }
            if (h0_) { if (h1_) { if (jj == 0) asm volatile("s_waitcnt vmcnt(8)" ::: "memory"); else asm volatile("s_waitcnt vmcnt(12)" ::: "memory"); } else asm volatile("s_waitcnt vmcnt(0)" ::: "memory");
                       conv_dma_finish(dc[0], (LAS const float*)bufs, f_lane); }
            h0_ = (jj + 2 < per) && d2 < CONV_LATER;
            if (h0_) { convert_decode(ap, deferred_item(d2), Wp, Np, dc[0]); conv_dma_issue(Wp, Np, dc[0], bufs, f_lane); }
            if (h1_) { if (h0_) asm volatile("s_waitcnt vmcnt(12)" ::: "memory"); else asm volatile("s_waitcnt vmcnt(0)" ::: "memory");
                       conv_dma_finish(dc[1], (LAS const float*)(bufs + 8192), f_lane); }
        }
        asm volatile("s_waitcnt vmcnt(0)" ::: "memory");
    }
#else
    ConvDesc da, db; float va[32], vb[32];
    bool ha = d0 < CONV_LATER, hb = false;
    if (ha) convert_issue(ap, deferred_item(d0), f_lane, da, va);
    for (int jj = 0; jj < per; jj += 2) {
        const int d1 = d0 + NGW * (jj + 1), d2 = d0 + NGW * (jj + 2);
        hb = (jj + 1 < per) && d1 < CONV_LATER;
        if (hb) convert_issue(ap, deferred_item(d1), f_lane, db, vb);
        if (ha) conv_finish(da, va, scr, f_lane);
        ha = (jj + 2 < per) && d2 < CONV_LATER;
        if (ha) convert_issue(ap, deferred_item(d2), f_lane, da, va);
        if (hb) conv_finish(db, vb, scr, f_lane);
    }
#endif
    __syncthreads();
#if CONV_PROBE
    if (blockIdx.x == PROBE_WG && f_tid == 0) atomicAdd((unsigned long long*)(ap->ws + 512 * 1024 + 64), __builtin_amdgcn_s_memrealtime() - *(unsigned long long*)(ring + 140000));
#endif
}
__device__ __forceinline__ void p0_prologue(Frame& F, CArgs* ap) {
    FR_IDS();
    unsigned char* ws = ap->ws;
    {
        LAS float* cact = (LAS float*)F.lds;
        LAS float* part = (LAS float*)(F.lds + 32768);
        const float* cin = ap->in[1];
        for (int i = f_tid; i < NB * DM; i += NWAVES * 64) { const float c = cin[i]; cact[i] = c / (1.0f + expf(-c)); }
        __syncthreads();
        float* mod = (float*)(ws + WS_MOD);
        for (int it = F.vcu; it < 256; it += F.G) {
            const int L = it >> 6, cb = it & 63;
            if (f_lane < 48) {
                const float* Wp = ap->in[2] + ((size_t)L * DM + 256 * f_wave) * (NMOD * DM) + 192 * cb + 4 * f_lane;
                f32x4 a0 = {0.f, 0.f, 0.f, 0.f}, a1 = a0, a2 = a0, a3 = a0;
#pragma unroll 8
                for (int kk = 0; kk < 256; ++kk) { const f32x4 w = *(const f32x4*)(Wp + (size_t)kk * (NMOD * DM)); const int k = 256 * f_wave + kk;
                    a0 += w * cact[k]; a1 += w * cact[DM + k]; a2 += w * cact[2 * DM + k]; a3 += w * cact[3 * DM + k]; }
                LAS f32x4* pp = (LAS f32x4*)(part + (f_wave * NB) * 192) + f_lane;
                pp[0] = a0; pp[48] = a1; pp[96] = a2; pp[144] = a3;
            }
            __syncthreads();
            for (int o = f_tid; o < NB * 192; o += NWAVES * 64) { const int b = o / 192, cc = o % 192; float s = 0.f;
#pragma unroll
                for (int w = 0; w < 8; ++w) s += part[(w * NB + b) * 192 + cc];
                mod[((size_t)L * NB + b) * (NMOD * DM) + 192 * cb + cc] = s + ap->in[3][(size_t)L * (NMOD * DM) + 192 * cb + cc]; }
            __syncthreads();
        }
    }
    {
        LAS float* scr = (LAS float*)(F.lds + RING_OFF + f_wave * 16384);
        const int gw = F.vcu * NWAVES + f_wave, NGW = F.G * NWAVES;
#if CONV_DEFER
        for (int d = gw; d < CONV_NOW; d += NGW) convert_item(ap, now_item(d), scr, f_lane);
#else
        for (int d = gw; d < CONV_ITEMS; d += NGW) convert_item(ap, d, scr, f_lane);
#endif
    }
    {
        const int gt = F.vcu * (NWAVES * 64) + f_tid, NGT = F.G * NWAVES * 64;
        float* tabA = (float*)(ws + WS_TABA); float* tabB = (float*)(ws + WS_TABB);
        for (int idx = gt; idx < SEQ * 64; idx += NGT) rope_entry(tabA, idx, 64, 0.86596432336006535);
        for (int idx = gt; idx < SEQ * 32; idx += NGT) rope_entry(tabB, idx, 32, 0.74989420933245582);
        for (int idx = gt; idx < DM; idx += NGT) ((float*)(ws + WS_ONES))[idx] = 1.0f;
        if (gt < 8) ((float*)(ws + WS_IDENT))[gt] = (gt & 1) ? 0.f : 1.f;
        for (int idx = gt; idx < MTOK * 16; idx += NGT) ((float*)(ws + WS_NEUTRAL))[idx] = ((idx & 15) == 1) ? 2048.0f * (1.0f - LN_EPS) : 0.f;
        float* bp = (float*)(ws + WS_BPERM);
        for (int idx = gt; idx < 2 * NQKV_B; idx += NGT) { const int j = idx / NQKV_B, n = idx % NQKV_B;
            int src = n; if (n < 2304) { const int p = n & 63; src = (n & ~63) + (p >> 1) + 32 * (p & 1); }
            bp[idx] = ap->in[18][(size_t)j * NQKV_B + src]; }
    }
}
__device__ __forceinline__ void h0_phase(Frame& F, const float* x, const float* sc, const float* sh, bf16* hb, bf16* xb) {
    FR_IDS();
    const int m0 = 256 * (8 * ((int)blockIdx.x & 7) + (((int)blockIdx.x >> 3) & 7)) + ((int)blockIdx.x >> 6) * 64 + f_wave * 8;
    for (int m = m0; m < m0 + 8; ++m) {
        const int b = m / SEQ;
        const GAS f32x4* xr = (const GAS f32x4*)(x + (size_t)m * DM) + f_lane;
        const f32x4* scp = (const f32x4*)(sc + (size_t)b * (NMOD * DM)) + f_lane; const f32x4* shp = (const f32x4*)(sh + (size_t)b * (NMOD * DM)) + f_lane;
        GAS unsigned long long* o8 = (GAS unsigned long long*)(hb + (size_t)m * DM) + f_lane; GAS unsigned long long* x8 = (GAS unsigned long long*)(xb + (size_t)m * DM) + f_lane;
#pragma unroll
        for (int j = 0; j < 8; ++j) { const f32x4 xv = xr[64 * j]; const f32x4 v = xv * (scp[64 * j] + 1.0f) + shp[64 * j];
            o8[64 * j] = (unsigned long long)pk2(v.x, v.y) | ((unsigned long long)pk2(v.z, v.w) << 32);
            x8[64 * j] = (unsigned long long)pk2(xv.x, xv.y) | ((unsigned long long)pk2(xv.z, xv.w) << 32); }
    }
}
__device__ __forceinline__ void final_ln_phase(Frame& F, const float* vin, const float* st, float* xout, const float* g, const float* bln) {
    FR_IDS();
    const int m0 = 256 * (8 * ((int)blockIdx.x & 7) + (((int)blockIdx.x >> 3) & 7)) + ((int)blockIdx.x >> 6) * 64 + f_wave * 8;
    for (int m = m0; m < m0 + 8; ++m) {
        float mu, r; pg8::row_mu_r(st, m, mu, r);
        const GAS f32x4* xr = (const GAS f32x4*)(vin + (size_t)m * DM) + f_lane;
        const f32x4* gp = (const f32x4*)g + f_lane; const f32x4* bp = (const f32x4*)bln + f_lane;
        GAS f32x4* xo = (GAS f32x4*)(xout + (size_t)m * DM) + f_lane;
#pragma unroll
        for (int j = 0; j < 8; ++j) xo[64 * j] = (xr[64 * j] - mu) * r * gp[64 * j] + bp[64 * j];
    }
}
__device__ __forceinline__ void fold_phase(Frame& F, CArgs* ap, int s_lo, int s_hi, bool gn) {
    FR_IDS();
    unsigned char* ws = ap->ws;
    LAS float* GL = (LAS float*)F.lds;
    const float* mod = (const float*)(ws + WS_MOD);
    for (int s = 0; s < 7; ++s) {
        const bool do_c = s >= s_lo && s < s_hi, do_g = gn && F.vcu == s;
        if (!do_c && !do_g) continue;
        const int L = s >> 1, odd = s & 1, Lc = L + odd;
        const float* g = (odd ? ap->in[6] : ap->in[4]) + (size_t)L * DM; const float* bl = (odd ? ap->in[7] : ap->in[5]) + (size_t)L * DM;
        const float* mc = mod + (size_t)Lc * NB * NMOD * DM + (odd ? 0 : 3 * DM);
        __syncthreads();
        {
            const int k = 4 * f_tid;
            const f32x4 gv = *(const f32x4*)(g + k), blv = *(const f32x4*)(bl + k);
            f32x4 scv[NB], shv[NB];
#pragma unroll
            for (int b = 0; b < NB; ++b) { scv[b] = *(const f32x4*)(mc + (size_t)b * NMOD * DM + DM + k) + 1.0f; shv[b] = *(const f32x4*)(mc + (size_t)b * NMOD * DM + k); }
#pragma unroll
            for (int b = 0; b < NB; ++b) { const f32x4 G = gv * scv[b];
                *(LAS f32x4*)(GL + b * DM + k) = G; *(LAS f32x4*)(GL + (4 + b) * DM + k) = blv * scv[b] + shv[b];
                if (do_g) { *(f32x4*)((float*)(ws + WS_GN) + ((size_t)s * NB + b) * DM + k) = G;
                    *(f32x4*)((float*)(ws + WS_IG) + ((size_t)s * NB + b) * DM + k) = (f32x4){1.0f / scv[b][0], 1.0f / scv[b][1], 1.0f / scv[b][2], 1.0f / scv[b][3]}; } }
        }
        __syncthreads();
        if (!do_c) continue;
        const bf16* Wt; int N;
        if (!odd) { Wt = (const bf16*)(ws + WS_WUP + Lc * WS_WMLP_STRIDE); N = DFF; }
        else if (Lc & 1) { Wt = (const bf16*)(ws + WS_WQKVB + (Lc >> 1) * WS_WB_STRIDE); N = NQKV_B; }
        else { Wt = (const bf16*)(ws + WS_WQKVA + (Lc >> 1) * WS_WA_STRIDE); N = NQKV_A; }
        float* cs = (float*)(ws + WS_CS) + (size_t)s * NB * CSTRIDE; float* cb = (float*)(ws + WS_CB) + (size_t)s * NB * CSTRIDE;
        const int n0 = F.vcu * NWAVES + f_wave, NGW = F.G * NWAVES;
        for (int nb = n0; nb < N; nb += 4 * NGW) {
            v4u wv[4][4];
#pragma unroll
            for (int j = 0; j < 4; ++j) { const int n = nb + j * NGW < N ? nb + j * NGW : nb;
#pragma unroll
                for (int i = 0; i < 4; ++i) wv[j][i] = *(const GAS v4u*)(Wt + (size_t)n * DM + 8 * (f_lane + 64 * i)); }
#pragma unroll
            for (int j = 0; j < 4; ++j) { const int n = nb + j * NGW; if (n >= N) break;
                asm volatile("" ::: "memory");
                float a[8] = {0.f, 0.f, 0.f, 0.f, 0.f, 0.f, 0.f, 0.f};
#pragma unroll
                for (int i = 0; i < 4; ++i) { const int k0 = 8 * (f_lane + 64 * i); const v4u w4 = wv[j][i];
                    float w[8]; w[0] = __uint_as_float(w4.x << 16); w[1] = __uint_as_float(w4.x & 0xffff0000u); w[2] = __uint_as_float(w4.y << 16); w[3] = __uint_as_float(w4.y & 0xffff0000u);
                    w[4] = __uint_as_float(w4.z << 16); w[5] = __uint_as_float(w4.z & 0xffff0000u); w[6] = __uint_as_float(w4.w << 16); w[7] = __uint_as_float(w4.w & 0xffff0000u);
#pragma unroll
                    for (int v = 0; v < 8; ++v) { const f32x4 g0 = *(const LAS f32x4*)(GL + v * DM + k0), g1 = *(const LAS f32x4*)(GL + v * DM + k0 + 4);
                        a[v] += (w[0] * g0[0] + w[1] * g0[1]) + (w[2] * g0[2] + w[3] * g0[3]) + (w[4] * g1[0] + w[5] * g1[1]) + (w[6] * g1[2] + w[7] * g1[3]); } }
#pragma unroll
                for (int v = 0; v < 8; ++v) a[v] = wave_sum(a[v]);
                if (f_lane == 0) {
#pragma unroll
                    for (int b = 0; b < 4; ++b) { cs[(size_t)b * CSTRIDE + n] = a[b]; cb[(size_t)b * CSTRIDE + n] = a[4 + b]; } }
            }
        }
    }
    __syncthreads();
}
__device__ __forceinline__ void combine_phase(Frame& F, const bf16* AO, bf16* AC, const float* lq1, const float* lk1, const float* lq2, const float* lk2, const float* gsub, float lam_init) {
    FR_IDS();
    const float d1 = wave_sum(lq1[f_lane] * lk1[f_lane] + lq1[f_lane + 64] * lk1[f_lane + 64]);
    const float d2 = wave_sum(lq2[f_lane] * lk2[f_lane] + lq2[f_lane + 64] * lk2[f_lane + 64]);
    const float lam = expf(d1) - expf(d2) + lam_init;
    const f32x4 gs = *((const f32x4*)gsub + f_lane) * (1.0f - lam_init);
    const int m0 = 256 * (8 * ((int)blockIdx.x & 7) + (((int)blockIdx.x >> 3) & 7)) + ((int)blockIdx.x >> 6) * 64 + f_wave * 8;
    for (int m = m0; m < m0 + 8; ++m) {
        const GAS unsigned long long* ip = (const GAS unsigned long long*)(AO + (size_t)m * (2 * DM)) + f_lane;
        GAS unsigned long long* op = (GAS unsigned long long*)(AC + (size_t)m * DM) + f_lane;
        unsigned long long r1[8], r2[8];
#pragma unroll
        for (int h = 0; h < 8; ++h) { r1[h] = ip[(2 * h) * 64]; r2[h] = ip[(2 * h + 1) * 64]; }
#pragma unroll
        for (int h = 0; h < 8; ++h) {
            f32x4 d;
            d.x = bf2f((unsigned short)(r1[h])) - lam * bf2f((unsigned short)(r2[h]));
            d.y = bf2f((unsigned short)(r1[h] >> 16)) - lam * bf2f((unsigned short)(r2[h] >> 16));
            d.z = bf2f((unsigned short)(r1[h] >> 32)) - lam * bf2f((unsigned short)(r2[h] >> 32));
            d.w = bf2f((unsigned short)(r1[h] >> 48)) - lam * bf2f((unsigned short)(r2[h] >> 48));
            const float ss = wave_sum((d.x * d.x + d.y * d.y) + (d.z * d.z + d.w * d.w));
            const float r = 1.f / sqrtf(ss * (1.f / 256.f) + LN_EPS);
            const f32x4 o = d * r * gs;
            op[h * 64] = (unsigned long long)pk2(o.x, o.y) | ((unsigned long long)pk2(o.z, o.w) << 32);
        }
    }
}
typedef attA::bf16 abf;
typedef attA::BlockRef<abf, abf> ARef;
__device__ __forceinline__ ARef attA_ref(const bf16* QKV, bf16* AO, int L, int pass) {
    const int k = L >> 3, xcd = L & 7, gi = k >> 5, r = k & 31;
    const int grp = gi * 8 + xcd, b = grp >> 3, hp = grp & 7;
    const int hq = 2 * hp + (r & 1), vh = (r >> 1) & 1, x = r >> 2;
    const int qb = pass ? 15 - x : x;
    const abf* base = (const abf*)QKV + (size_t)b * SEQ * NQKV_A;
    ARef R; R.Q = base + (size_t)qb * 256 * NQKV_A + hq * 128; R.K = base + DM + hq * 128; R.V = base + 2 * DM + hp * 256 + vh * 128;
    R.O = (abf*)AO + ((size_t)b * SEQ + (size_t)qb * 256) * (2 * DM) + hq * 256 + vh * 128; R.P0 = qb * 256;
    return R;
}
__device__ __forceinline__ void attnA_phase(char* lds, const bf16* QKV, bf16* AO) {
    const int total = 1024, stride = (int)gridDim.x;
    int L = blockIdx.x; if (L >= total) return;
    int pass = 0;
    ARef cur = attA_ref(QKV, AO, L, 0);
    attA::Seam<abf> S;
    attA::causal_swa_prime<abf, abf>(cur, SEQ, lds, S);
    for (;;) {
        const bool more_pass = pass == 0, more_item = L + stride < total, last = !more_pass && !more_item;
        int passn = pass + 1, Ln = L;
        if (!more_pass) { passn = 0; Ln = more_item ? L + stride : L; }
        const ARef nxt = last ? cur : attA_ref(QKV, AO, Ln, passn);
        attA::causal_swa_block<abf, abf>(cur, nxt, SEQ, SEQ, lds, S);
        if (last) break;
        cur = nxt; pass = passn; L = Ln;
    }
}
constexpr int CW_READY = 24576;
constexpr int CW_FOLD2 = CW_READY + 16 * 64 * DEPTH;
constexpr int CW_QDONE = CW_FOLD2 + 16;
constexpr int CW_TDONE = CW_QDONE + 16 * 64 * DEPTH;
__device__ __forceinline__ void wait_panels(unsigned* base, int npan, unsigned expected, unsigned* bar) {
    const int t = opaque_tid();
    if (t < 64) {
        unsigned sp = 0;
        for (;;) { const unsigned c = t < npan ? xb_ld(base + 16 * t) : expected;
            if (__builtin_amdgcn_ballot_w64(c < expected) == 0ull) break;
            __builtin_amdgcn_s_sleep(1);
            if ((++sp & 255u) == 0u) { if (xb_ld(&bar[XB_TMO])) break; if (sp > XB_SPIN_CAP) { if (t == 0) atomicAdd(&bar[XB_TMO], 1u); break; } } }
        if (t == 0) { __builtin_amdgcn_fence(__ATOMIC_ACQUIRE, "agent"); asm volatile("s_waitcnt vmcnt(0)" ::: "memory"); }
    }
    __syncthreads();
}
__device__ __forceinline__ void signal_ready2(unsigned* cnt, unsigned* cnt2) {
    asm volatile("s_waitcnt vmcnt(0)" ::: "memory");
    __syncthreads();
    if (threadIdx.x == 0) { (void)xb_add(cnt, 1u); if (cnt2) (void)xb_add(cnt2, 1u); }
}
__device__ __forceinline__ void signal_ready(unsigned* cnt) {
    asm volatile("s_waitcnt vmcnt(0)" ::: "memory");
    __syncthreads();
    if (threadIdx.x == 0) (void)xb_add(cnt, 1u);
}
__device__ __forceinline__ void signal_ready_fenced(unsigned* cnt) {
    asm volatile("s_waitcnt vmcnt(0)" ::: "memory");
    __syncthreads();
    if (threadIdx.x == 0) { __builtin_amdgcn_fence(__ATOMIC_RELEASE, "agent"); asm volatile("s_waitcnt vmcnt(0)" ::: "memory"); (void)xb_add(cnt, 1u); }
}
__device__ __forceinline__ void wait_ready(unsigned* cnt, unsigned expected, unsigned* bar) {
    if (threadIdx.x == 0) { XB_SPIN(xb_ld(cnt) < expected, bar); __builtin_amdgcn_fence(__ATOMIC_ACQUIRE, "agent"); asm volatile("s_waitcnt vmcnt(0)" ::: "memory"); }
    __syncthreads();
}
__device__ __forceinline__ void attnA2_phase(char* lds, const bf16* QKV, bf16* AO, CArgs* ap, bool defer, unsigned* ready, unsigned* qdone, unsigned* tdone, unsigned* bar) {
    const int total = 512, stride = (int)gridDim.x;
    int cq = 0;
    for (int L = blockIdx.x; L < total; L += stride) {
        const int k = L >> 3, xcd = L & 7, r = k & 15, grp = (k >> 4) * 8 + xcd, b = grp >> 3, hp = grp & 7, hq = 2 * hp + (r & 1), x = r >> 1;
        const abf* base = (const abf*)QKV + (size_t)b * SEQ * NQKV_A;
#pragma unroll 1
        for (int pass = 0; pass < 2; ++pass) { const int qb = pass ? 15 - x : x;
            attA::Blk2 B; B.Q = base + (size_t)qb * 256 * NQKV_A + hq * 128; B.K = base + DM + hq * 128; B.V = base + 2 * DM + hp * 256;
            B.O = (abf*)AO + ((size_t)b * SEQ + (size_t)qb * 256) * (2 * DM) + hq * 256; B.P0 = qb * 256; B.stamp = (unsigned long long*)(ap->ws + 512 * 1024 + 128);
            if (qdone) wait_panels(qdone + 16 * 16 * b, qb + 1, 4u, bar);
            attA::causal_fullv_block(B, lds);
            if (ready) signal_ready2(ready + 16 * (b * 16 + qb), tdone ? tdone + 16 * b : (unsigned*)nullptr);
            if (defer && (CONV_CHUNKS == 4 || pass == 0) && cq < CONV_CHUNKS) { convert_chunk(ap, lds, cq); ++cq; }
        }
    }
    if (defer) for (; cq < CONV_CHUNKS; ++cq) convert_chunk(ap, lds, cq);
}
__device__ __forceinline__ void attnB_phase(Frame& F, const bf16* QKV, const float* sinks, bf16* AC, unsigned* ready, unsigned* qdone, unsigned* tdone, unsigned* bar) {
    for (int u = F.vcu; u < NB * 4 * 32; u += F.G) { const int n = u & 31, kvh = (u >> 5) & 3, b = u >> 7;
        if (qdone) { const int p1 = n >> 1, p0 = n > 0 ? (n - 1) >> 1 : p1; wait_panels(qdone + 16 * (16 * b + p0), p1 - p0 + 1, 4u, bar); }
        attB::swa_unit(b, kvh, n, QKV, sinks, AC, F.lds);
        if (ready) signal_ready2(ready + 16 * (b * 16 + (n >> 1)), tdone ? tdone + 16 * b : (unsigned*)nullptr); }
    __syncthreads();
}

#ifndef SITES
#define SITES 0xffff
#endif
#ifndef PG8_PROBE
#define PG8_PROBE 0
#endif
#ifndef PROBE_LAYER
#define PROBE_LAYER 1
#endif
#ifndef PROBE_SITE
#define PROBE_SITE 0
#endif
#define PROBE_KT (PROBE_SITE == 1 ? 128 : 32)
#ifndef PROBE_DUP
#define PROBE_DUP 0
#endif
#ifndef PROBE_NREP
#define PROBE_NREP 2
#endif
#define NREP(bit) ((PROBE_DUP & (bit)) ? PROBE_NREP : 1)
#define DUMMY_F32 ((float*)WSP(WS_AO))
__device__ __forceinline__ CArgs* kargs() { CArgs* p = (CArgs*)__builtin_amdgcn_kernarg_segment_ptr(); asm volatile("" : "+s"(p)); return p; }
#define AIN(i) (kargs()->in[i])
#define WSP(off) (kargs()->ws + (off))
__host__ __device__ __forceinline__ int panel_of(int c) { return 8 * (c & 7) + ((c >> 3) & 7); }
__device__ __forceinline__ int stage_panel(const float* st, LAS float* mrt) {
    const int pm = panel_of((int)blockIdx.x);
    pg8::stage_mu_r((LAS pg8::f32x2v*)mrt, st, pm, opaque_tid()); return pm;
}
#ifndef STAGGER_TICKS
#define STAGGER_TICKS 0
#endif
__device__ __forceinline__ void phase_stagger() {
    const unsigned long long want = (unsigned long long)(blockIdx.x >> 5) * STAGGER_TICKS, t0 = __builtin_amdgcn_s_memrealtime();
    while (__builtin_amdgcn_s_memrealtime() - t0 < want) __builtin_amdgcn_s_sleep(4);
}
__device__ __forceinline__ void xcc_local_barrier(unsigned* ctl, unsigned x, unsigned* bar) {
    asm volatile("s_waitcnt vmcnt(0)" ::: "memory");
    __syncthreads();
    if (threadIdx.x == 0) {
        __builtin_amdgcn_s_waitcnt(0);
        const unsigned old = xb_add(&ctl[CW_LSUB + 64 * x], 1u), gen = old >> 5;
        if ((old & 31u) == 31u) xb_add(&ctl[CW_LGEN + 64 * x], 1u);
        else XB_SPIN(xb_ld(&ctl[CW_LGEN + 64 * x]) == gen, bar);
        __builtin_amdgcn_fence(__ATOMIC_ACQUIRE, "agent");
        asm volatile("s_waitcnt vmcnt(0)" ::: "memory");
    }
    __syncthreads();
}
__device__ __forceinline__ void panel_barrier(unsigned* ctl, unsigned pm, unsigned* bar) {
    asm volatile("s_waitcnt vmcnt(0)" ::: "memory");
    __syncthreads();
    if (threadIdx.x == 0) {
        __builtin_amdgcn_s_waitcnt(0);
        const unsigned old = xb_add(&ctl[CW_PSUB + 64 * pm], 1u), gen = old >> 2;
        if ((old & 3u) == 3u) xb_add(&ctl[CW_PGEN + 64 * pm], 1u);
        else XB_SPIN(xb_ld(&ctl[CW_PGEN + 64 * pm]) == gen, bar);
        __builtin_amdgcn_fence(__ATOMIC_ACQUIRE, "agent");
        asm volatile("s_waitcnt vmcnt(0)" ::: "memory");
    }
    __syncthreads();
}
#ifndef CHAIN_STAGGER_TICKS
#define CHAIN_STAGGER_TICKS 0
#endif
__device__ __forceinline__ void chain_stagger() {
    const unsigned long long want = (unsigned long long)((blockIdx.x >> 3) & 7) * CHAIN_STAGGER_TICKS, t0 = __builtin_amdgcn_s_memrealtime();
    while (__builtin_amdgcn_s_memrealtime() - t0 < want) __builtin_amdgcn_s_sleep(2);
}
__global__ void __launch_bounds__(NWAVES * 64, 2) fwd_kernel(Args args_unused) {
    extern __shared__ __attribute__((aligned(16))) unsigned char lds[];
    Frame F;
    F.lds = (LAS unsigned char*)lds;
    F.MISC = (volatile LAS unsigned*)(F.lds + MISC_OFF);
    F.G = gridDim.x; { const int bx = blockIdx.x; F.vcu = (F.G % 8 == 0) ? (bx % 8) * (F.G / 8) + bx / 8 : bx; }
    F.ctl = (gu32*)WSP(WS_CTL);
    for (int u = threadIdx.x; u < (LDS_BYTES - LDSCTL_OFF) / 4; u += NWAVES * 64) ((LAS unsigned*)(F.lds + LDSCTL_OFF))[u] = 0u;
    __syncthreads();
    const int lo = kargs()->ph_lo, hi = kargs()->ph_hi;
    XcdBarrier bar; bar.bar = (unsigned*)(F.ctl + CW_BAR); bar.x = 0; bar.st = nullptr;
    if (hi - lo > 1) bar = xcd_barrier_post((unsigned*)(F.ctl + CW_BAR), F.MISC + 8);
    if (hi - lo > 1 && threadIdx.x == 0) (void)__hip_atomic_fetch_or((unsigned*)F.ctl + CW_XMASK + 64 * bar.x, 1u << (blockIdx.x & 7), __ATOMIC_RELAXED, __HIP_MEMORY_SCOPE_AGENT);
    bool local_ok = false;
#define IN(k) (lo <= (k) && (k) < hi)
#if PG8_PROBE == 5
    unsigned long long pr_bar = 0;
#ifndef PROBE_BARSET
#define PROBE_BARSET 0xff
#endif
#define SEAM(k) do { if ((k) + 1 < hi) { const unsigned long long t0_ = __builtin_amdgcn_s_memrealtime(); xcd_barrier(bar); const int k_ = (k); const int cls_ = k_ < 2 ? k_ : (((k_ - 2) & 7) == 0 ? 2 : ((k_ - 2) & 7) == 1 ? 3 : ((k_ - 2) & 7) == 2 ? 4 : ((k_ - 2) & 7) == 3 ? 5 : ((k_ - 2) & 7) == 5 ? 6 : 7); const unsigned long long dt_ = __builtin_amdgcn_s_memrealtime() - t0_; if ((PROBE_BARSET >> cls_) & 1) pr_bar += dt_; if (threadIdx.x == 0) atomicMax((unsigned*)WSP(520 * 1024) + k_, ~(unsigned)dt_); } } while (0)
#else
#define SEAM(k) do { if ((k) + 1 < hi) xcd_barrier(bar); } while (0)
#endif

#define MOD_ ((float*)WSP(WS_MOD))
#define X_ ((float*)WSP(WS_X))
#define HB_ ((bf16*)WSP(WS_HB))
#define QKV_ ((bf16*)WSP(WS_QKV))
#define QKVB_ ((bf16*)WSP(WS_QKVB))
#define READY_(L) ((unsigned*)F.ctl + CW_READY + 16 * 64 * (L))
#define QDONE_(L) ((unsigned*)F.ctl + CW_QDONE + 16 * 64 * (L))
#define TDONE_(L) ((unsigned*)F.ctl + CW_TDONE + 16 * NB * (L))
#define AO_ ((bf16*)WSP(WS_AO))
#define AC_ ((bf16*)WSP(WS_AC))
#define HID_ ((bf16*)WSP(WS_HID))
#define STATS_(s) ((float*)WSP(WS_STATS) + (size_t)(s) * MTOK * 16)
#define MRT_ ((LAS float*)(F.lds + STATTBL_OFF))
#define CS_(s) ((const float*)WSP(WS_CS) + (size_t)(s) * NB * CSTRIDE)
#define CB_(s) ((const float*)WSP(WS_CB) + (size_t)(s) * NB * CSTRIDE)
#define GN_(s) ((const float*)WSP(WS_GN) + (size_t)(s) * NB * DM)
#define ZEROS_ ((const float*)WSP(WS_ZEROS))
#define ONES_ ((const float*)WSP(WS_ONES))
#define IG_(s) ((const float*)WSP(WS_IG) + (size_t)(s) * NB * DM)
#define NEUTRAL_ ((const float*)WSP(WS_NEUTRAL))
#define XB_ ((bf16*)WSP(WS_X))
    constexpr size_t MODL = (size_t)NB * NMOD * DM;
    constexpr int MODB = NMOD * DM;

#if SITES & 1
    if (IN(0)) { for (int rep = 0; rep < NREP(1); ++rep) { p0_prologue(F, kargs()); if (NREP(1) > 1) __syncthreads(); } SEAM(0); }
    if (lo == 0 && hi > 1 && F.G == 256) {
        if (threadIdx.x == 0) { unsigned seen = 0u, good = 1u;
            for (unsigned j = 0; j < 16; ++j) { const unsigned c = xb_ld(&bar.bar[XB_XCNT(j)]), m = xb_ld((unsigned*)F.ctl + CW_XMASK + 64 * j);
                if (c == 0u && m == 0u) continue; if (c != 32u || (m & (m - 1u)) != 0u || (seen & m) != 0u) good = 0u; seen |= m; }
            F.MISC[12] = (good && seen == 0xffu) ? 1u : 0u; }
        __syncthreads(); local_ok = F.MISC[12] != 0u; __syncthreads();
    }
#ifdef NO_LOCAL_BARRIERS
    local_ok = false;
#endif
#define SEAM_L(k) do { if ((k) + 1 < hi) { if (local_ok) panel_barrier((unsigned*)F.ctl, (unsigned)panel_of((int)blockIdx.x), bar.bar); else xcd_barrier(bar); } } while (0)
#endif
#if SITES & 4096
    if (IN(1)) { for (int rep = 0; rep < NREP(4096); ++rep) { h0_phase(F, AIN(0), MOD_ + 1 * DM, MOD_ + 0 * DM, HB_, XB_); fold_phase(F, kargs(), 0, CONV_DEFER ? 2 : 7, true); } SEAM_L(1); }
#endif

    for (int L = 0; L < DEPTH; ++L) {
        const int pb = 2 + 8 * L, j = L >> 1;
#define MODL_ (MOD_ + (size_t)L * MODL)
        if ((L & 1) == 0) {
#if SITES & 8
            if (IN(pb + 0)) for (int rep = 0; rep < NREP(2); ++rep) {
                if (QKV_DATAFLOW && L >= 2 && rep == 0) wait_ready(TDONE_(L - 2) + 16 * (panel_of((int)blockIdx.x) >> 4), 256u, bar.bar);
                pg8::Gemm g{HB_, (const bf16*)WSP(WS_WQKVA + j * WS_WA_STRIDE), MTOK, NQKV_A, DM};
#if PG8_PROBE
                if (L == PROBE_LAYER && PROBE_SITE == 2) g.probe = (unsigned long long*)WSP(WS_PROBE);
#endif
                pg8::StaticOrder S; S.init(MTOK, NQKV_A, F.G, (int)blockIdx.x);
                pg8::EpiQKV<128> E{QKV_, NQKV_A, ZEROS_, (const float*)WSP(WS_TABA), (const float*)WSP(WS_IDENT), 16, SEQ - 1, L == 0 ? (const float*)WSP(WS_NEUTRAL) : (const float*)STATS_(2 * L - 1), L == 0 ? ZEROS_ : CS_(2 * L - 1), L == 0 ? ZEROS_ : CB_(2 * L - 1), L == 0 ? 0 : CSTRIDE, 12, MRT_, stage_panel(L == 0 ? (const float*)WSP(WS_NEUTRAL) : (const float*)STATS_(2 * L - 1), MRT_)};
                if (STAGGER_TICKS) phase_stagger();
            pg8::gemm_phase<pg8::EpiQKV<128>, pg8::StaticOrder, true, true>(F.lds + RING_OFF, g, S, E);
                if (rep == NREP(2) - 1) { if (QKV_DATAFLOW) signal_ready(QDONE_(L) + 16 * panel_of((int)blockIdx.x)); else SEAM(pb + 0); }
            }
#endif
#if SITES & 2
            if (IN(pb + 1)) { for (int rep = 0; rep < NREP(4); ++rep) {
#if ATTA_FULLV
#if PG8_PROBE == 7 || PG8_PROBE == 8
                const unsigned long long pa_r0 = __builtin_amdgcn_s_memrealtime(), pa_c0 = __builtin_amdgcn_s_memtime();
#endif
                attnA2_phase((char*)lds + RING_OFF, QKV_, AO_, kargs(), CONV_DEFER && L == 0 && rep == 0, (DATAFLOW && rep == NREP(4) - 1) ? READY_(L) : (unsigned*)nullptr, QKV_DATAFLOW ? QDONE_(L) : (unsigned*)nullptr, QKV_DATAFLOW ? TDONE_(L) : (unsigned*)nullptr, bar.bar);
#if PG8_PROBE == 7 || PG8_PROBE == 8
                if (L == 2 && blockIdx.x == 0 && threadIdx.x == 0) { unsigned long long* pr = (unsigned long long*)WSP(WS_PROBE); pr[3] = __builtin_amdgcn_s_memrealtime() - pa_r0; pr[4] = __builtin_amdgcn_s_memtime() - pa_c0; }
#endif
#else
                attnA_phase((char*)lds + RING_OFF, QKV_, AO_);
#endif
            } if (!DATAFLOW || (L0_ATT_GLOBAL && L == 0)) SEAM(pb + 1); }
#endif
#if SITES & 512
            if (IN(pb + 2)) {
                if (CONV_DEFER && FOLD2_AT_C0 && L == 0) { fold_phase(F, kargs(), 2, 7, false); signal_ready_fenced((unsigned*)F.ctl + CW_FOLD2); }
                if (DATAFLOW) wait_ready(READY_(L) + 16 * panel_of((int)blockIdx.x), 16u, bar.bar);
                if (DATAFLOW && XCC_ALIGN && local_ok) xcc_local_barrier((unsigned*)F.ctl, (unsigned)blockIdx.x & 7u, bar.bar);
                if (local_ok && CHAIN_STAGGER_TICKS) chain_stagger();
                const float lam_init = (L == 0) ? 0.2f : 0.47071301658633585f;
                for (int rep = 0; rep < NREP(8); ++rep) combine_phase(F, AO_, AC_, AIN(12) + j * 128, AIN(13) + j * 128, AIN(14) + j * 128, AIN(15) + j * 128, AIN(16) + j * 256, lam_init);
                SEAM_L(pb + 2);
            }
#endif
#if SITES & 16
            if (IN(pb + 3)) for (int rep = 0; rep < NREP(16); ++rep) {
                pg8::Gemm g{AC_, (const bf16*)WSP(WS_WOA + j * WS_WA_STRIDE), MTOK, DM, DM};
#if PG8_PROBE
                if (L == PROBE_LAYER && PROBE_SITE == 3) g.probe = (unsigned long long*)WSP(WS_PROBE);
#endif
                pg8::StaticOrder S; S.init(MTOK, DM, F.G, (int)blockIdx.x);
                pg8::EpiResid E{L == 0 ? (const bf16*)XB_ : (const bf16*)HB_, L == 0 ? ONES_ : IG_(2 * L - 1), L == 0 ? 0 : DM, L == 0 ? NEUTRAL_ : (const float*)STATS_(2 * L - 1), L == 0 ? ONES_ : AIN(6) + (L - 1) * DM, L == 0 ? ZEROS_ : AIN(7) + (L - 1) * DM,
                                 (float*)nullptr, STATS_(2 * L), HB_, GN_(2 * L), DM, DM, MODL_ + 2 * DM, MODB, ZEROS_, ALPHA, 12, MRT_, stage_panel(L == 0 ? NEUTRAL_ : (const float*)STATS_(2 * L - 1), MRT_)};
                if (STAGGER_TICKS) phase_stagger();
            pg8::gemm_phase<pg8::EpiResid, pg8::StaticOrder, true, true>(F.lds + RING_OFF, g, S, E);
                if (rep == NREP(16) - 1) SEAM_L(pb + 3);
            }
#endif
        } else {
#if SITES & 32
            if (IN(pb + 0)) for (int rep = 0; rep < NREP(32); ++rep) {
                if (QKV_DATAFLOW && L >= 2 && rep == 0) wait_ready(TDONE_(L - 2) + 16 * (panel_of((int)blockIdx.x) >> 4), 128u, bar.bar);
                pg8::Gemm g{HB_, (const bf16*)WSP(WS_WQKVB + j * WS_WB_STRIDE), MTOK, NQKV_B, DM}; pg8::StaticOrder S; S.init(MTOK, NQKV_B, F.G, (int)blockIdx.x);
                pg8::EpiQKV<64> E{QKVB_, NQKV_B, (const float*)WSP(WS_BPERM) + j * NQKV_B, (const float*)WSP(WS_TABB), (const float*)WSP(WS_IDENT), 9, SEQ - 1, (const float*)STATS_(2 * L - 1), CS_(2 * L - 1), CB_(2 * L - 1), CSTRIDE, 12, MRT_, stage_panel((const float*)STATS_(2 * L - 1), MRT_)};
                if (STAGGER_TICKS) phase_stagger();
            pg8::gemm_phase<pg8::EpiQKV<64>, pg8::StaticOrder, true, true>(F.lds + RING_OFF, g, S, E);
                if (rep == NREP(32) - 1) { if (QKV_DATAFLOW) signal_ready(QDONE_(L) + 16 * panel_of((int)blockIdx.x)); else SEAM(pb + 0); }
            }
#endif
#if SITES & 4
            if (IN(pb + 1) && CONV_DEFER && L == 1 && !FOLD2_AT_C0) {
                fold_phase(F, kargs(), 2, 7, false); signal_ready_fenced((unsigned*)F.ctl + CW_FOLD2); }
            if (IN(pb + 1)) { for (int rep = 0; rep < NREP(64); ++rep) attnB_phase(F, QKVB_, AIN(19) + j * 32, AC_, (DATAFLOW && rep == NREP(64) - 1) ? READY_(L) : (unsigned*)nullptr, QKV_DATAFLOW ? QDONE_(L) : (unsigned*)nullptr, QKV_DATAFLOW ? TDONE_(L) : (unsigned*)nullptr, bar.bar); if (!DATAFLOW) SEAM(pb + 1); }
#endif
#if SITES & 64
            if (IN(pb + 3)) for (int rep = 0; rep < NREP(128); ++rep) {
                if (DATAFLOW && rep == 0) wait_ready(READY_(L) + 16 * panel_of((int)blockIdx.x), 8u, bar.bar);
                if (DATAFLOW && XCC_ALIGN && local_ok && rep == 0) xcc_local_barrier((unsigned*)F.ctl, (unsigned)blockIdx.x & 7u, bar.bar);
                if (local_ok && CHAIN_STAGGER_TICKS) chain_stagger();
                pg8::Gemm g{AC_, (const bf16*)WSP(WS_WOB + j * WS_WB_STRIDE), MTOK, DM, DM}; pg8::StaticOrder S; S.init(MTOK, DM, F.G, (int)blockIdx.x);
                pg8::EpiResid E{(const bf16*)HB_, IG_(2 * L - 1), DM, (const float*)STATS_(2 * L - 1), AIN(6) + (L - 1) * DM, AIN(7) + (L - 1) * DM,
                                 (float*)nullptr, STATS_(2 * L), HB_, GN_(2 * L), DM, DM, MODL_ + 2 * DM, MODB, AIN(21) + j * DM, ALPHA, 12, MRT_, stage_panel((const float*)STATS_(2 * L - 1), MRT_)};
                if (STAGGER_TICKS) phase_stagger();
            pg8::gemm_phase<pg8::EpiResid, pg8::StaticOrder, true, true>(F.lds + RING_OFF, g, S, E);
                if (rep == NREP(128) - 1) SEAM_L(pb + 3);
            }
#endif
        }
#if SITES & 128
        if (IN(pb + 5)) for (int rep = 0; rep < NREP(512); ++rep) {
            if (CONV_DEFER && L == 1 && rep == 0) wait_ready((unsigned*)F.ctl + CW_FOLD2, gridDim.x, bar.bar);
            pg8::Gemm g{HB_, (const bf16*)WSP(WS_WUP + L * WS_WMLP_STRIDE), MTOK, DFF, DM};
#if PG8_PROBE
            if (L == PROBE_LAYER && PROBE_SITE == 0) g.probe = (unsigned long long*)WSP(WS_PROBE);
#endif
            pg8::StaticOrder S; S.init(MTOK, DFF, F.G, (int)blockIdx.x);
            pg8::EpiRelu2 E{HID_, DFF, (const float*)STATS_(2 * L), CS_(2 * L), CB_(2 * L), CSTRIDE, 12, MRT_, stage_panel((const float*)STATS_(2 * L), MRT_), QKV_};
            if (STAGGER_TICKS) phase_stagger();
            pg8::gemm_phase<pg8::EpiRelu2, pg8::StaticOrder, true, true>(F.lds + RING_OFF, g, S, E);
            if (rep == NREP(512) - 1) SEAM_L(pb + 5);
        }
#endif
#if SITES & 256
        if (IN(pb + 6)) for (int rep = 0; rep < NREP(1024); ++rep) {
            pg8::Gemm g{HID_, (const bf16*)WSP(WS_WDN + L * WS_WMLP_STRIDE), MTOK, DM, DFF};
#if PG8_PROBE
            if (L == PROBE_LAYER && PROBE_SITE == 1) g.probe = (unsigned long long*)WSP(WS_PROBE);
#endif
            pg8::StaticOrder S; S.init(MTOK, DM, F.G, (int)blockIdx.x);
            pg8::EpiResid E{(const bf16*)HB_, IG_(2 * L), DM, (const float*)STATS_(2 * L), AIN(4) + L * DM, AIN(5) + L * DM,
                             L == DEPTH - 1 ? X_ : (float*)nullptr, STATS_(2 * L + 1), L == DEPTH - 1 ? (bf16*)nullptr : HB_, GN_(2 * L + 1), DM, DM, MODL_ + 5 * DM, MODB, ZEROS_, ALPHA, 12, MRT_, stage_panel((const float*)STATS_(2 * L), MRT_)};
            if (STAGGER_TICKS) phase_stagger();
            pg8::gemm_phase<pg8::EpiResid, pg8::StaticOrder, true, true>(F.lds + RING_OFF, g, S, E);
            if (rep == NREP(1024) - 1) { if (CONV_DEFER && (!DATAFLOW || L0_DOWN_GLOBAL) && L == 0) SEAM(pb + 6); else SEAM_L(pb + 6); }
        }
#endif
    }
    if (IN(2 + 8 * DEPTH)) final_ln_phase(F, X_, STATS_(2 * DEPTH - 1), kargs()->out, AIN(6) + (DEPTH - 1) * DM, AIN(7) + (DEPTH - 1) * DM);
#if PG8_PROBE == 5
    if (threadIdx.x == 0) atomicAdd((unsigned long long*)WSP(512 * 1024), pr_bar);
#endif
#if ATTA_STAMP
    if (blockIdx.x == 0 && threadIdx.x == 0) { const unsigned long long t0 = __builtin_amdgcn_s_memrealtime(), ticks = ((const unsigned long long*)WSP(512 * 1024 + 128))[ATTA_STAMP_SEL] / 8ull;
        while (__builtin_amdgcn_s_memrealtime() - t0 < ticks) __builtin_amdgcn_s_sleep(8); }
#endif
#if CONV_PROBE
    if (blockIdx.x == PROBE_WG && threadIdx.x == 0) { const unsigned long long t0 = __builtin_amdgcn_s_memrealtime(), ticks = 5ull * *(const unsigned long long*)WSP(512 * 1024 + 64);
        while (__builtin_amdgcn_s_memrealtime() - t0 < ticks) __builtin_amdgcn_s_sleep(8); }
#endif
#if PG8_PROBE
    if (IN(2 + 8 * DEPTH)) { xcd_barrier(bar);
        if (blockIdx.x == 0 && threadIdx.x == 0) { const unsigned long long* pr = (const unsigned long long*)WSP(WS_PROBE); float v = 0.f;
            if (PG8_PROBE == 1) v = ((float)pr[4] * 100.0f / (float)pr[3] - 1000.0f) * 0.1f;
            if (PG8_PROBE == 2) v = ((float)pr[0] / (float)(pr[2] * (unsigned long long)PROBE_KT) - 2000.0f) * 0.1f;
            if (PG8_PROBE == 3) v = (float)pr[1] / (float)pr[2] * 0.01f;
            if (PG8_PROBE == 5) v = (float)(*(const unsigned long long*)WSP(512 * 1024)) / (float)gridDim.x * 0.001f;
            if (PG8_PROBE == 5 && PROBE_BARSET == 0) { unsigned sum = 0; for (int i = 0; i < N_PHASES; ++i) { const unsigned w = ((const unsigned*)WSP(520 * 1024))[i]; if (w) sum += ~w; } v = (float)sum * 0.001f; }
            if (PG8_PROBE == 7) v = ((float)pr[4] * 100.0f / (float)pr[3] - 1000.0f) * 0.1f;
            if (PG8_PROBE == 8) v = (float)pr[3] * 0.001f;
            if (PG8_PROBE == 9 || PG8_PROBE == 10) v = ((float)pr[0] / (float)(pr[2] - 1) - 4000.0f) * 0.05f;
            if (PG8_PROBE == 11) v = (float)(*(const unsigned long long*)WSP(512 * 1024 + 64)) * 0.01f;
            if (PG8_PROBE == 4) v = (float)pr[3] * 0.001f;
            { const unsigned long long t0 = __builtin_amdgcn_s_memrealtime(); const unsigned long long ticks = (unsigned long long)(fmaxf(v, 0.f) * 500.0f);
              while (__builtin_amdgcn_s_memrealtime() - t0 < ticks) __builtin_amdgcn_s_sleep(8); } } }
#endif
#undef IN
#undef SEAM
}

extern "C" void kernel_launch(void* const* d_in, const int* in_sizes, int n_in, void* d_out, int out_size, void* d_ws, size_t ws_size, hipStream_t stream) {
    static int grid = 0;
    if (grid == 0) {
        if (n_in != 22 || in_sizes[0] != MTOK * DM || out_size != MTOK * DM || ws_size < WS_END) {
            fprintf(stderr, "kernel_launch: unexpected shapes (n_in %d, in0 %d, out %d, ws %zu; need ws >= %zu); nothing launched\n", n_in, n_in > 0 ? in_sizes[0] : -1, out_size, ws_size, (size_t)WS_END); grid = -1; return; }
        int dev = 0, cus = 0, per_cu = 0;
        if (hipGetDevice(&dev) != hipSuccess || hipDeviceGetAttribute(&cus, hipDeviceAttributeMultiprocessorCount, dev) != hipSuccess) { fprintf(stderr, "kernel_launch: device query failed\n"); grid = -1; return; }
        if (hipFuncSetAttribute((const void*)fwd_kernel, hipFuncAttributeMaxDynamicSharedMemorySize, LDS_BYTES) != hipSuccess) { fprintf(stderr, "kernel_launch: hipFuncSetAttribute failed\n"); grid = -1; return; }
        if (hipOccupancyMaxActiveBlocksPerMultiprocessor(&per_cu, (const void*)fwd_kernel, NWAVES * 64, LDS_BYTES) != hipSuccess || per_cu < 1)
            fprintf(stderr, "kernel_launch: note: occupancy query reports %d workgroups per CU\n", per_cu);
        (void)hipGetLastError();
        grid = cus;
        { const int Ns[5] = {NQKV_A, NQKV_B, DM, DFF, DM}; bool ok = true;
          if (grid != 256) ok = false;
          for (int gi = 0; gi < 5 && ok; ++gi) for (int c = 0; c < grid && ok; ++c) { pg8::StaticOrder S; S.init(MTOK, Ns[gi], grid, c); pg8::Unit u;
              for (int i = 0; S.next(i, u); ++i) if (u.pm != panel_of(c)) { ok = false; break; } }
          if (!ok) { fprintf(stderr, "kernel_launch: unit order does not keep a workgroup on one row panel for a grid of %d; nothing launched\n", grid); grid = -1; return; } }
    }
    if (grid < 0) return;
    if (hipMemsetAsync((char*)d_ws + WS_CTL, 0, CTL_ZERO_BYTES, stream) != hipSuccess) { fprintf(stderr, "kernel_launch: memset failed\n"); return; }
    Args a{};
    for (int i = 0; i < 22; ++i) a.in[i] = (const float*)d_in[i];
    a.out = (float*)d_out; a.ws = (unsigned char*)d_ws;
#if MK_PER_PHASE
    for (int p = 0; p < N_PHASES; ++p) {
        if (p >= 2 && p < 2 + 8 * DEPTH) { const int sl = (p - 2) & 7, Lp = (p - 2) >> 3; if (sl == 4 || sl == 7 || (sl == 2 && (Lp & 1))) continue; }
        a.ph_lo = p; a.ph_hi = p + 1;
        hipLaunchKernelGGL(fwd_kernel, dim3(grid), dim3(NWAVES * 64), LDS_BYTES, stream, a);
    }
#else
    a.ph_lo = 0; a.ph_hi = N_PHASES;
    hipLaunchKernelGGL(fwd_kernel, dim3(grid), dim3(NWAVES * 64), LDS_BYTES, stream, a);
#endif
    const hipError_t le = hipPeekAtLastError();
    if (le != hipSuccess) fprintf(stderr, "kernel_launch: launch failed: %s\n", hipGetErrorName(le));
}
```
